# Optimizing an MI355X kernel written in HIP

```python
import math, functools
import jax, jax.numpy as jnp
from jax import lax
import numpy as np

D_MODEL = 1024
BATCH = 4
SEQ = 8192
DEPTH = 2

GRID_W = 64
CTX_LEN = 256
HEAD_DIM = 64
N_FREQ = HEAD_DIM // 4
ROPE_THETA = 10000.0
Q_BLOCK = 128
A_HEADS = 8
A_KV_HEADS = 2
LRU_WIDTH = 512
LRU_BLOCKS = 8
LRU_BW = LRU_WIDTH // LRU_BLOCKS
CONV_WIDTH = 4
LRU_C = 8.0
C_HEADS = 4
C_VDIM = 2 * HEAD_DIM
N_BRANCH = 3
BRANCH_W = 512
N_EXPERTS = 16
EC_FACTOR = 2
D_EXPERT = 2752
DN_ALPHA = (2 * DEPTH) ** 0.25
DN_BETA = (8 * DEPTH) ** -0.25
LN_EPS = 1e-5
RMS_EPS = 1e-6

A_Q = A_HEADS * HEAD_DIM
A_KV = A_KV_HEADS * HEAD_DIM
C_QK = C_HEADS * 2 * HEAD_DIM
C_V = C_HEADS * C_VDIM
SPLITS = (A_Q, A_KV, A_KV, LRU_WIDTH, LRU_WIDTH, C_QK, C_QK, C_V, N_BRANCH * D_MODEL)
SPLIT_IDX = tuple(sum(SPLITS[:i + 1]) for i in range(len(SPLITS) - 1))
D_IN = sum(SPLITS)

kernel_name = "hybrid_gqa_rglru_diffattn_ecmoe_dit"


def layer_norm(x, g, b):
    xf = x.astype(jnp.float32)
    mu = jnp.mean(xf, -1, keepdims=True)
    var = jnp.mean(jnp.square(xf - mu), -1, keepdims=True)
    return ((xf - mu) * lax.rsqrt(var + LN_EPS)).astype(x.dtype) * g + b


def rms_norm(x, g):
    xf = x.astype(jnp.float32)
    return (xf * lax.rsqrt(jnp.mean(jnp.square(xf), -1, keepdims=True) + RMS_EPS)).astype(x.dtype) * g


def rope_tables(seq, dtype):
    rows = seq // GRID_W
    row = jnp.repeat(jnp.arange(rows, dtype=jnp.int32), GRID_W)
    col = jnp.tile(jnp.arange(GRID_W, dtype=jnp.int32), rows)
    inv = ROPE_THETA ** (-jnp.arange(N_FREQ, dtype=jnp.float32) / N_FREQ)
    ang = jnp.stack([row, col], -1).astype(jnp.float32)[..., None] * inv
    return jnp.cos(ang).astype(dtype), jnp.sin(ang).astype(dtype)


def apply_rope(x, cos, sin):
    b, s, h, _ = x.shape
    xr = x.reshape(b, s, h, 2, 2, N_FREQ)
    x1, x2 = xr[..., 0, :], xr[..., 1, :]
    cs, sn = cos[None, :, None], sin[None, :, None]
    out = jnp.stack([x1 * cs - x2 * sn, x2 * cs + x1 * sn], axis=-2)
    return out.reshape(x.shape)


def gqa_chunk(q, k, v):
    s = jnp.einsum("bqkgd,bnkd->bkgqn", q, k).astype(jnp.float32)
    p = jax.nn.softmax(s, axis=-1).astype(v.dtype)
    return jnp.einsum("bkgqn,bnkd->bqkgd", p, v)


def diff_chunk(q, k, v, lam):
    s = jnp.einsum("bqhjd,bnhjd->bhjqn", q, k).astype(jnp.float32)
    p = jax.nn.softmax(s, axis=-1)
    a = (p[:, :, 0] - lam * p[:, :, 1]).astype(v.dtype)
    return jnp.einsum("bhqn,bnhe->bqhe", a, v)


def blockwise(chunk_fn, q, *kv):
    b, s = q.shape[:2]
    qb = jnp.moveaxis(q.reshape((b, s // Q_BLOCK, Q_BLOCK) + q.shape[2:]), 1, 0)
    o = lax.map(lambda qi: chunk_fn(qi, *kv), qb)
    o = jnp.moveaxis(o, 0, 1)
    return o.reshape((b, s) + o.shape[3:])


def depthwise_conv(x, w, bias):
    left = CONV_WIDTH // 2
    y = lax.conv_general_dilated(
        x, w[:, None, :], window_strides=(1,), padding=[(left, CONV_WIDTH - 1 - left)],
        dimension_numbers=("NWC", "WIO", "NWC"), feature_group_count=x.shape[-1])
    return y + bias


def lru_gates(u, w_a, b_a, w_x, b_x, lam):
    ub = u.reshape(u.shape[:-1] + (LRU_BLOCKS, LRU_BW))
    r = jax.nn.sigmoid(jnp.einsum("btgi,gij->btgj", ub, w_a).reshape(u.shape) + b_a)
    i = jax.nn.sigmoid(jnp.einsum("btgi,gij->btgj", ub, w_x).reshape(u.shape) + b_x)
    log_a = -LRU_C * r.astype(jnp.float32) * jax.nn.softplus(-lam.astype(jnp.float32))
    a = jnp.exp(log_a)
    bterm = jnp.sqrt(-jnp.expm1(2.0 * log_a)) * (i * u).astype(jnp.float32)
    return a, bterm


def linear_scan(a, b, h0, reverse):
    if reverse:
        a, b = jnp.flip(a, 1), jnp.flip(b, 1)
    comb = lambda l, r: (l[0] * r[0], r[0] * l[1] + r[1])
    acum, hz = lax.associative_scan(comb, (a, b), axis=1)
    h = hz + acum * h0[:, None, :]
    return jnp.flip(h, 1) if reverse else h


def rglru(x, xc, conv_w, conv_b, w_a, b_a, w_x, b_x, lam, need_ctx):
    u = depthwise_conv(x, conv_w, conv_b)
    uc = depthwise_conv(xc, conv_w, conv_b)
    h0 = jnp.zeros((x.shape[0], x.shape[-1]), jnp.float32)
    hs_l, hs_c = [], []
    for d, rev in ((0, False), (1, True)):
        a_c, b_c = lru_gates(uc, w_a[d], b_a[d], w_x[d], b_x[d], lam[d])
        h_c = linear_scan(a_c, b_c, h0, rev)
        a_l, b_l = lru_gates(u, w_a[d], b_a[d], w_x[d], b_x[d], lam[d])
        hs_l.append(linear_scan(a_l, b_l, h_c[:, 0] if rev else h_c[:, -1], rev))
        hs_c.append(h_c)
    y = (hs_l[0] + hs_l[1]).astype(x.dtype)
    yc = (hs_c[0] + hs_c[1]).astype(x.dtype) if need_ctx else None
    return y, yc


def diff_post(y, g, lam_init):
    y = rms_norm(y, g) * (1.0 - lam_init)
    return y.reshape(y.shape[:2] + (-1,))


def merge_branches(ya, yb, yc, gm, w_branch, w_out):
    br = jnp.stack([ya, yb, yc], axis=-2)
    p = jnp.einsum("btni,nid->btnd", br, w_branch)
    gates = jax.nn.sigmoid(gm.reshape(gm.shape[:-1] + (N_BRANCH, D_MODEL)))
    return jnp.sum(gates * p, axis=-2) @ w_out


def token_mixer(h, hc, cos, sin, w_in, a_q_norm, a_k_norm, conv_w, conv_b, lw_a, lb_a, lw_x, lb_x,
                llam, diff_lambda, diff_subln, w_branch, w_out, lam_init, need_ctx):
    b, s, _ = h.shape
    lc = hc.shape[1]
    grp = A_HEADS // A_KV_HEADS
    scale = HEAD_DIM ** -0.5
    qa, ka, va, xb, gb, qc, kc, vc, gm = jnp.split(h @ w_in, SPLIT_IDX, axis=-1)
    qa_c, ka_c, va_c, xb_c, gb_c, qc_c, kc_c, vc_c, gm_c = jnp.split(hc @ w_in, SPLIT_IDX, axis=-1)

    qa = apply_rope(rms_norm(qa.reshape(b, s, A_HEADS, HEAD_DIM), a_q_norm), cos, sin) * scale
    ka = apply_rope(rms_norm(ka.reshape(b, s, A_KV_HEADS, HEAD_DIM), a_k_norm), cos, sin)
    ka_c = rms_norm(ka_c.reshape(b, lc, A_KV_HEADS, HEAD_DIM), a_k_norm)
    va_c = va_c.reshape(b, lc, A_KV_HEADS, HEAD_DIM)
    ka_all = jnp.concatenate([ka_c, ka], axis=1)
    va_all = jnp.concatenate([va_c, va.reshape(b, s, A_KV_HEADS, HEAD_DIM)], axis=1)
    ya = blockwise(gqa_chunk, qa.reshape(b, s, A_KV_HEADS, grp, HEAD_DIM), ka_all, va_all)
    ya = ya.reshape(b, s, A_Q)

    hb, hb_c = rglru(xb, xb_c, conv_w, conv_b, lw_a, lb_a, lw_x, lb_x, llam, need_ctx)
    yb = hb * jax.nn.gelu(gb)

    lq1, lk1, lq2, lk2 = diff_lambda.astype(jnp.float32)
    lam = jnp.exp(jnp.sum(lq1 * lk1)) - jnp.exp(jnp.sum(lq2 * lk2)) + lam_init
    qc = apply_rope(qc.reshape(b, s, 2 * C_HEADS, HEAD_DIM), cos, sin).reshape(b, s, C_HEADS, 2, HEAD_DIM) * scale
    kc = apply_rope(kc.reshape(b, s, 2 * C_HEADS, HEAD_DIM), cos, sin).reshape(b, s, C_HEADS, 2, HEAD_DIM)
    kc_c = kc_c.reshape(b, lc, C_HEADS, 2, HEAD_DIM)
    vc_c = vc_c.reshape(b, lc, C_HEADS, C_VDIM)
    kc_all = jnp.concatenate([kc_c, kc], axis=1)
    vc_all = jnp.concatenate([vc_c, vc.reshape(b, s, C_HEADS, C_VDIM)], axis=1)
    yc = diff_post(blockwise(functools.partial(diff_chunk, lam=lam), qc, kc_all, vc_all), diff_subln, lam_init)

    o = merge_branches(ya, yb, yc, gm, w_branch, w_out)
    if not need_ctx:
        return o, None

    qa_c = rms_norm(qa_c.reshape(b, lc, A_HEADS, HEAD_DIM), a_q_norm) * scale
    ya_c = gqa_chunk(qa_c.reshape(b, lc, A_KV_HEADS, grp, HEAD_DIM), ka_c, va_c).reshape(b, lc, A_Q)
    yb_c = hb_c * jax.nn.gelu(gb_c)
    qc_c = qc_c.reshape(b, lc, C_HEADS, 2, HEAD_DIM) * scale
    yc_c = diff_post(diff_chunk(qc_c, kc_c, vc_c, lam), diff_subln, lam_init)
    oc = merge_branches(ya_c, yb_c, yc_c, gm_c, w_branch, w_out)
    return o, oc


def expert_choice(h, w_router, w_gate, w_up, w_down):
    b, n, d = h.shape
    cap = EC_FACTOR * n // N_EXPERTS
    aff = jax.nn.softmax((h @ w_router).astype(jnp.float32), axis=-1)
    vals, idx = lax.top_k(jnp.swapaxes(aff, 1, 2), cap)
    flat_idx = idx.reshape(b, -1)
    xg = jax.vmap(lambda hb, ib: hb[ib])(h, flat_idx).reshape(b, N_EXPERTS, cap, d)
    act = jax.nn.silu(jnp.einsum("becd,edf->becf", xg, w_gate)) * jnp.einsum("becd,edf->becf", xg, w_up)
    out = jnp.einsum("becf,efd->becd", act, w_down) * vals[..., None].astype(h.dtype)
    return jax.vmap(lambda ob, ib: jnp.zeros((n, d), h.dtype).at[ib].add(ob))(out.reshape(b, -1, d), flat_idx)


def setup_inputs(seed: int = 0) -> dict:
    key = jax.random.key(seed)
    ks = jax.random.split(key, 32)
    L, D, E, F = DEPTH, D_MODEL, N_EXPERTS, D_EXPERT
    nrm = lambda k, shape, sd: jax.random.normal(k, shape, jnp.float32) * sd
    u = jax.random.uniform(ks[13], (L, 2, LRU_WIDTH), jnp.float32, 0.9, 0.999)
    a = u ** (1.0 / LRU_C)
    return {
        "x": nrm(ks[0], (BATCH, SEQ, D), 1.0),
        "c": nrm(ks[1], (BATCH, D), 1.0),
        "ctx": nrm(ks[2], (BATCH, CTX_LEN, D), 1.0),
        "c_ctx": nrm(ks[3], (D,), 1.0),
        "w_ada": nrm(ks[4], (L, D, 6 * D), 0.5 * D ** -0.5),
        "b_ada": nrm(ks[5], (L, 6 * D), 0.02),
        "w_in": nrm(ks[6], (L, D, D_IN), D ** -0.5),
        "a_q_norm": 1.0 + nrm(ks[7], (L, HEAD_DIM), 0.02),
        "a_k_norm": 1.0 + nrm(ks[8], (L, HEAD_DIM), 0.02),
        "lru_conv_w": nrm(ks[9], (L, CONV_WIDTH, LRU_WIDTH), CONV_WIDTH ** -0.5),
        "lru_conv_b": nrm(ks[10], (L, LRU_WIDTH), 0.02),
        "lru_w_a": nrm(ks[11], (L, 2, LRU_BLOCKS, LRU_BW, LRU_BW), LRU_BW ** -0.5),
        "lru_b_a": nrm(ks[12], (L, 2, LRU_WIDTH), 0.02),
        "lru_w_x": nrm(ks[14], (L, 2, LRU_BLOCKS, LRU_BW, LRU_BW), LRU_BW ** -0.5),
        "lru_b_x": nrm(ks[15], (L, 2, LRU_WIDTH), 0.02),
        "lru_lambda": jnp.log(a) - jnp.log1p(-a),
        "diff_lambda": nrm(ks[16], (L, 4, HEAD_DIM), 0.1),
        "diff_subln": 1.0 + nrm(ks[17], (L, C_VDIM), 0.02),
        "w_branch": nrm(ks[18], (L, N_BRANCH, BRANCH_W, D), BRANCH_W ** -0.5 * DN_BETA),
        "w_out": nrm(ks[19], (L, D, D), D ** -0.5 * DN_BETA),
        "ln1_g": 1.0 + nrm(ks[20], (L, D), 0.02),
        "ln1_b": nrm(ks[21], (L, D), 0.02),
        "w_router": nrm(ks[22], (L, D, E), D ** -0.5),
        "w_gate": nrm(ks[23], (L, E, D, F), D ** -0.5),
        "w_up": nrm(ks[24], (L, E, D, F), D ** -0.5),
        "w_down": nrm(ks[25], (L, E, F, D), F ** -0.5 * DN_BETA),
        "ln2_g": 1.0 + nrm(ks[26], (L, D), 0.02),
        "ln2_b": nrm(ks[27], (L, D), 0.02),
    }


def reference(x, c, ctx, c_ctx, w_ada, b_ada, w_in, a_q_norm, a_k_norm, lru_conv_w, lru_conv_b,
              lru_w_a, lru_b_a, lru_w_x, lru_b_x, lru_lambda, diff_lambda, diff_subln, w_branch, w_out,
              ln1_g, ln1_b, w_router, w_gate, w_up, w_down, ln2_g, ln2_b):
    cos, sin = rope_tables(x.shape[1], x.dtype)
    for l in range(DEPTH):
        need_ctx = l < DEPTH - 1
        lam_init = 0.8 - 0.6 * math.exp(-0.3 * l)
        mod = jax.nn.silu(c) @ w_ada[l] + b_ada[l]
        mod_c = jax.nn.silu(c_ctx) @ w_ada[l] + b_ada[l]
        sh1, sc1, g1, sh2, sc2, g2 = jnp.split(mod[:, None, :], 6, axis=-1)
        sh1c, sc1c, g1c, sh2c, sc2c, g2c = jnp.split(mod_c, 6, axis=-1)

        o, oc = token_mixer(x * (1.0 + sc1) + sh1, ctx * (1.0 + sc1c) + sh1c, cos, sin,
                            w_in[l], a_q_norm[l], a_k_norm[l], lru_conv_w[l], lru_conv_b[l],
                            lru_w_a[l], lru_b_a[l], lru_w_x[l], lru_b_x[l], lru_lambda[l],
                            diff_lambda[l], diff_subln[l], w_branch[l], w_out[l], lam_init, need_ctx)
        x = layer_norm(DN_ALPHA * x + g1 * o, ln1_g[l], ln1_b[l])
        moe = expert_choice(x * (1.0 + sc2) + sh2, w_router[l], w_gate[l], w_up[l], w_down[l])
        x = layer_norm(DN_ALPHA * x + g2 * moe, ln2_g[l], ln2_b[l])
        if need_ctx:
            ctx = layer_norm(DN_ALPHA * ctx + g1c * oc, ln1_g[l], ln1_b[l])
            moe_c = expert_choice(ctx * (1.0 + sc2c) + sh2c, w_router[l], w_gate[l], w_up[l], w_down[l])
            ctx = layer_norm(DN_ALPHA * ctx + g2c * moe_c, ln2_g[l], ln2_b[l])
    return x
```

```cpp
#include <hip/hip_runtime.h>
#include <hip/hip_bf16.h>
#include <cstdio>
#include <cstdint>
#include <cmath>

#ifndef MK_PER_PHASE
#define MK_PER_PHASE 0
#endif

constexpr int D = 1024, NB = 4, SEQ = 8192, CTX = 256, DEPTH = 2;
constexpr int T = NB * SEQ;
constexpr int TC = NB * CTX;
constexpr int R = T + TC;
constexpr int KVL = CTX + SEQ;
constexpr int DIN = 6400;
constexpr int NE = 16, FF = 2752, FFP = 2816, CAP = 1024, CAPC = 32;
constexpr int EROWS = 4352;
constexpr int MROWS = NE * EROWS;
constexpr float LN_EPS = 1e-5f, RMS_EPS = 1e-6f;
constexpr float DN_ALPHA = 1.41421356237309515f;
constexpr float WSC_GU = 32.0f, WSC_D = 128.0f;
constexpr float C2 = 0.125f * 1.4426950408889634f;

constexpr size_t al256(size_t x) { return (x + 255) & ~(size_t)255; }
constexpr size_t WS_CTL = 0, CTL_BYTES = 65536;
constexpr size_t WS_MOD  = WS_CTL + CTL_BYTES;
constexpr size_t WS_LRUW = al256(WS_MOD + (size_t)2 * 5 * 6144 * 4);
constexpr size_t WS_AGG  = al256(WS_LRUW + (size_t)2 * 2 * 2 * 8 * 4096 * 2);
constexpr size_t WS_AFF  = al256(WS_AGG + (size_t)4 * 2 * 66 * 512 * 8);
constexpr size_t WS_SLOT = al256(WS_AFF + (size_t)R * 16 * 4);
constexpr size_t WS_SRC  = al256(WS_SLOT + (size_t)R * 16 * 4);
constexpr size_t WS_WIN  = al256(WS_SRC + (size_t)MROWS * 4);
constexpr size_t WS_WBR  = al256(WS_WIN + (size_t)2 * DIN * D * 2);
constexpr size_t WS_WOUT = al256(WS_WBR + (size_t)2 * 3 * 1024 * 512 * 2);
constexpr size_t WS_WGU  = al256(WS_WOUT + (size_t)2 * D * D * 2);
constexpr size_t WS_WD   = al256(WS_WGU + (size_t)NE * 5632 * D * 2);
constexpr size_t WS_X1   = al256(WS_WD + (size_t)NE * D * FFP * 2);
constexpr size_t WS_X2   = al256(WS_X1 + (size_t)R * D * 4);
constexpr size_t WS_SA   = al256(WS_X2 + (size_t)R * D * 4);
constexpr size_t WS_OV   = al256(WS_SA + (size_t)R * D * 2);
constexpr size_t WS_QA = WS_OV;
constexpr size_t WS_KA = al256(WS_QA + (size_t)R * 512 * 2);
constexpr size_t WS_VA = al256(WS_KA + (size_t)R * 128 * 2);
constexpr size_t WS_XB = al256(WS_VA + (size_t)R * 128 * 2);
constexpr size_t WS_GB = al256(WS_XB + (size_t)R * 512 * 2);
constexpr size_t WS_QC = al256(WS_GB + (size_t)R * 512 * 2);
constexpr size_t WS_KC = al256(WS_QC + (size_t)R * 512 * 2);
constexpr size_t WS_VC = al256(WS_KC + (size_t)R * 512 * 2);
constexpr size_t WS_GM = al256(WS_VC + (size_t)R * 512 * 2);
constexpr size_t WS_BR = al256(WS_GM + (size_t)R * 3072 * 2);
constexpr size_t WS_DO = al256(WS_BR + (size_t)3 * R * 512 * 2);
constexpr size_t WS_MM32 = al256(WS_DO + (size_t)2 * R * 512 * 2);
constexpr size_t WS_MIX_END = al256(WS_MM32 + (size_t)R * D * 4);
constexpr size_t WS_XH8 = WS_MIX_END - al256((size_t)R * D);
constexpr size_t WS_XG  = WS_OV;
constexpr size_t WS_ACT = al256(WS_XG + (size_t)MROWS * D * 2);
constexpr size_t WS_EO  = al256(WS_ACT + (size_t)MROWS * FFP * 2);
constexpr size_t WS_MOE_END = al256(WS_EO + (size_t)MROWS * D * 2);
constexpr size_t WS_END = WS_MIX_END > WS_MOE_END ? WS_MIX_END : WS_MOE_END;
static_assert(WS_END <= (size_t)1442840576, "d_ws map exceeds 4 x largest tensor");
static_assert(WS_XH8 >= WS_MOE_END, "XH8 is written while the MoE outputs are read");
static_assert((size_t)R * D * 4 <= (size_t)R * 3072 * 2, "O32 fits in GM's place");

constexpr int CW_TMO = 0, CW_BAR = 1024, CW_NRM = 8192;

constexpr int RING_OFF = 0, RING_BYTES = 131072;
constexpr int LDSCTL_OFF = RING_BYTES, MISC_OFF = LDSCTL_OFF + 320;
constexpr int LDS_BYTES = 147456;
constexpr int NWAVES = 8;

#define GAS __attribute__((address_space(1)))
#define LAS __attribute__((address_space(3)))
typedef unsigned short bf16;
typedef unsigned v4u __attribute__((ext_vector_type(4)));
typedef unsigned v2u __attribute__((ext_vector_type(2)));
typedef float f32x4 __attribute__((ext_vector_type(4)));
typedef float f32x2 __attribute__((ext_vector_type(2)));
typedef short bf16x8 __attribute__((ext_vector_type(8)));
typedef GAS unsigned gu32;
#define RLX_AGENT __ATOMIC_RELAXED, __HIP_MEMORY_SCOPE_AGENT
#define LDS_WAIT() asm volatile("s_waitcnt lgkmcnt(0)" ::: "memory")
#define VM_WAIT() asm volatile("s_waitcnt vmcnt(0)" ::: "memory")
typedef float f32x2_cv __attribute__((ext_vector_type(2))); typedef __bf16 bf16x2_cv __attribute__((ext_vector_type(2)));
__device__ __forceinline__ unsigned cvt_pk_bf16(float lo, float hi) { const f32x2_cv v = {lo, hi}; const bf16x2_cv b = __builtin_convertvector(v, bf16x2_cv); return __builtin_bit_cast(unsigned, b); }
__device__ __forceinline__ float bf_lo(unsigned w) { return __uint_as_float(w << 16); }
__device__ __forceinline__ float bf_hi(unsigned w) { return __uint_as_float(w & 0xffff0000u); }
__device__ __forceinline__ float fast_exp(float x) { return __builtin_amdgcn_exp2f(x * 1.4426950408889634f); }
__device__ __forceinline__ float sigmoid_f(float x) { return __builtin_amdgcn_rcpf(1.0f + fast_exp(-x)); }
__device__ __forceinline__ float silu_f(float x) { return x * sigmoid_f(x); }
__device__ __forceinline__ float gelu_tanh_f(float x) { const float z = 0.7978845608028654f * (x + 0.044715f * x * x * x); return x * sigmoid_f(2.0f * z); }
__device__ __forceinline__ float wave_sum(float v) {
#pragma unroll
    for (int o = 1; o < 64; o <<= 1) v += __shfl_xor(v, o);
    return v;
}
template <class Tp> __device__ __forceinline__ Tp* uni(Tp* p) { const unsigned long long v = (unsigned long long)p;
    const unsigned lo = __builtin_amdgcn_readfirstlane((unsigned)v), hi = __builtin_amdgcn_readfirstlane((unsigned)(v >> 32));
    return (Tp*)(GAS Tp*)(((unsigned long long)hi << 32) | lo); }
namespace pg8 {
#define PG8_LAS __attribute__((address_space(3)))
typedef unsigned short bf16_t;
typedef short bf16x8 __attribute__((ext_vector_type(8)));
typedef float f32x4 __attribute__((ext_vector_type(4)));
typedef unsigned u32x4 __attribute__((ext_vector_type(4)));
constexpr int BM = 256, BK = 64, HALF = 128, HTB = HALF * BK * 2  , STAGE_BYTES = 8 * HTB, NXCD = 8, WGM = 8;

__host__ __device__ __forceinline__ int lds_byte(int r, int c) { const int st = (r >> 4) * 2 + (c >> 5), rr = r & 15, cc = c & 31, ob = rr * 64 + cc * 2; return st * 1024 + (ob ^ (((ob >> 9) & 1) << 5)); }
__host__ __device__ __forceinline__ void stage_rc(int b, int& R, int& C) { const int st = b / 1024, sb = b % 1024, swz = sb ^ (((sb >> 9) & 1) << 5); R = (st >> 1) * 16 + swz / 64; C = (st & 1) * 32 + (swz % 64) / 2; }
__host__ __device__ __forceinline__ int perm32(int rho) { const int n = rho >> 4, i = rho & 15; return 8 * (i >> 2) + 4 * n + (i & 3); }

struct Unit { int pm, pn, aux; };
struct Gemm { const bf16_t* A; const bf16_t* Bt; int M, N, K; const int* rowsrc; };

struct StaticOrder {
    int nM, nN, nwg, G, c;
    __host__ __device__ void init(int M, int N, int G_, int c_) { nM = M / BM; nN = N / BM; nwg = nM * nN; G = G_; c = c_; }
    __host__ __device__ bool next(int i, Unit& u) const {
        const long L = (long)i * G + c; if (L >= nwg) return false;
        int wgid = (int)L; { const int q = nwg / NXCD, r = nwg % NXCD, xcd = wgid % NXCD, off = wgid / NXCD; wgid = (xcd < r ? xcd * (q + 1) : r * (q + 1) + (xcd - r) * q) + off; }
        const int nig = WGM * nN, gid = wgid / nig, fm = gid * WGM, gsz = (nM - fm) < WGM ? (nM - fm) : WGM;
        u.pm = fm + ((wgid % nig) % gsz); u.pn = (wgid % nig) / gsz; return true;
    }
    __device__ __forceinline__ void a_ready(const Unit&) const {}
    __device__ __forceinline__ void done(const Unit&) const {}
};

typedef float f32x2 __attribute__((ext_vector_type(2)));

template <class Epi, class Sched, bool ALIGN_EPI = false, bool SP2 = false, bool F8 = false, bool GATHER = false>
__device__ __forceinline__ void gemm_phase(PG8_LAS unsigned char* lds, const Gemm g, const Sched& S, const Epi& E, const int tid_in) {
    int tid_ = tid_in; asm volatile("" : "+v"(tid_));
    const int tid = tid_, wid = __builtin_amdgcn_readfirstlane(tid >> 6), lane = tid & 63, wr = wid >> 2, wc = wid & 3, fr = lane & 15, fq = lane >> 4;
    const int K = g.K, nt = K / BK;
    unsigned voffA[2], voffB[2];
#pragma unroll
    for (int i = 0; i < 2; ++i) { int R, C; stage_rc(tid * 16 + i * 8192, R, C); const int Rb = Epi::PERM ? ((R & ~31) + perm32(R & 31)) : R;
        voffA[i] = (unsigned)(R * K + C) * 2u; voffB[i] = (unsigned)(Rb * K + C) * 2u; }
    const size_t kstep = (size_t)(BK * 2);
    static_assert(!GATHER || SP2, "GATHER is written for the SP2 loop");
    int grow[2]; { int R0, C0, R1, C1; stage_rc(tid * 16, R0, C0); stage_rc(tid * 16 + 8192, R1, C1); grow[0] = R0; grow[1] = R1; }
    unsigned gcol[2]; { gcol[0] = voffA[0] - (unsigned)(grow[0] * K) * 2u; gcol[1] = voffA[1] - (unsigned)(grow[1] * K) * 2u; }
    unsigned vC[2][2], vN[2][2];
    constexpr int GIDX_OFF = STAGE_BYTES + 1024;
    const size_t hstep = (size_t)HALF * K * 2;
    const size_t tstep = 2 * hstep;
    const unsigned ldsw = (unsigned)wid * 1024u;
    const int aoff = lds_byte(wr * 64 + fr, fq * 8), boff = lds_byte(wc * 32 + fr, fq * 8);
#define PG8_SA(b, h) (((b) * 2 + (h)) * HTB)
#define PG8_SB(b, h) ((4 + (b) * 2 + (h)) * HTB)
#define PG8_STAGE(bufoff, gbase, voff) do { _Pragma("unroll") for (int _i = 0; _i < 2; ++_i) \
        __builtin_amdgcn_global_load_lds((const unsigned*)((const char*)(gbase) + (voff)[_i]), (PG8_LAS unsigned*)(lds + (bufoff) + ldsw + _i * 8192), 16, 0, 0); } while (0)
#define PG8_LDA(dst, b, h) do { if constexpr (F8) { _Pragma("unroll") for (int m = 0; m < 4; ++m) dst##8[m] = __builtin_shufflevector(*(const PG8_LAS v4i_*)(lds + PG8_SA(b, h) + aoff + m * 2048), *(const PG8_LAS v4i_*)(lds + PG8_SA(b, h) + aoff + m * 2048 + 1024), 0, 1, 2, 3, 4, 5, 6, 7); } \
        else { _Pragma("unroll") for (int m = 0; m < 4; ++m) _Pragma("unroll") for (int k = 0; k < 2; ++k) dst[m][k] = *(const PG8_LAS bf16x8*)(lds + PG8_SA(b, h) + aoff + m * 2048 + k * 1024); } } while (0)
#define PG8_LDB(dst, b, h) do { if constexpr (F8) { _Pragma("unroll") for (int n = 0; n < 2; ++n) dst##8[n] = __builtin_shufflevector(*(const PG8_LAS v4i_*)(lds + PG8_SB(b, h) + boff + n * 2048), *(const PG8_LAS v4i_*)(lds + PG8_SB(b, h) + boff + n * 2048 + 1024), 0, 1, 2, 3, 4, 5, 6, 7); } \
        else { _Pragma("unroll") for (int n = 0; n < 2; ++n) _Pragma("unroll") for (int k = 0; k < 2; ++k) dst[n][k] = *(const PG8_LAS bf16x8*)(lds + PG8_SB(b, h) + boff + n * 2048 + k * 1024); } } while (0)
#define PG8_MMA(ai, bj, At, Bt) do { if constexpr (F8) __builtin_amdgcn_sched_barrier(0); __builtin_amdgcn_s_setprio(1); \
        if constexpr (F8) { _Pragma("unroll") for (int m = 0; m < 4; ++m) _Pragma("unroll") for (int n = 0; n < 2; ++n) \
            acc[ai][bj][m][n] = __builtin_amdgcn_mfma_scale_f32_16x16x128_f8f6f4(Bt##8[n], At##8[m], acc[ai][bj][m][n], 0, 0, 0, 0x7f7f7f7f, 0, 0x7f7f7f7f); } \
        else { _Pragma("unroll") for (int m = 0; m < 4; ++m) _Pragma("unroll") for (int n = 0; n < 2; ++n) _Pragma("unroll") for (int k = 0; k < 2; ++k) \
            acc[ai][bj][m][n] = __builtin_amdgcn_mfma_f32_16x16x32_bf16(Bt[n][k], At[m][k], acc[ai][bj][m][n], 0, 0, 0); } \
        __builtin_amdgcn_s_setprio(0); \
        if constexpr (F8) { _Pragma("unroll") for (int m = 0; m < 4; ++m) asm volatile("" : "+v"(acc[ai][bj][m][0]), "+v"(acc[ai][bj][m][1]));     \
            __builtin_amdgcn_sched_barrier(0); } } while (0)
#define PG8_WAIT_V(n) asm volatile("s_waitcnt vmcnt(" #n ")" ::: "memory")
#define PG8_WAIT_L(n) asm volatile("s_waitcnt lgkmcnt(" #n ")" ::: "memory")
#define PG8_BAR __builtin_amdgcn_s_barrier()
#define PG8_SCHED __builtin_amdgcn_sched_barrier(0)
    Unit cur, nxt; int ui = 0;
    if (!S.next(0, cur)) return;
    f32x4 acc[2][2][4][2];
#pragma unroll
    for (int a = 0; a < 2; ++a)
#pragma unroll
        for (int b = 0; b < 2; ++b)
#pragma unroll
            for (int m = 0; m < 4; ++m)
#pragma unroll
                for (int n = 0; n < 2; ++n) acc[a][b][m][n] = (f32x4){0.f, 0.f, 0.f, 0.f};
    typedef int v4i_ __attribute__((ext_vector_type(4))); typedef int v8i_ __attribute__((ext_vector_type(8)));
    bf16x8 At[4][2], B0[2][2], B1[2][2]; v8i_ At8[4], B08[2], B18[2];
    const char* cA = (const char*)g.A + (GATHER ? (size_t)0 : (size_t)cur.pm * tstep); const char* cB = (const char*)g.Bt + (size_t)cur.pn * tstep;
    if constexpr (GATHER) {
#pragma unroll
        for (int h = 0; h < 2; ++h)
#pragma unroll
            for (int i = 0; i < 2; ++i) { int r = g.rowsrc[cur.pm * BM + h * HALF + grow[i]]; r = r < 0 ? 0 : r; vC[h][i] = (unsigned)r * (unsigned)(K * 2) + gcol[i]; vN[h][i] = vC[h][i]; }
    }
#define PG8_STAGEA(bufoff, gbase, h, vsel) do { if constexpr (GATHER) { PG8_STAGE(bufoff, gbase, vsel[h]); } else { PG8_STAGE(bufoff, (gbase) + (h) * hstep, voffA); } } while (0)
    S.a_ready(cur);
    if constexpr (SP2) {
        PG8_STAGE(PG8_SB(0, 0), cB, voffB); PG8_STAGE(PG8_SB(0, 1), cB + hstep, voffB); PG8_STAGEA(PG8_SA(0, 0), cA, 0, vC); PG8_STAGEA(PG8_SA(0, 1), cA, 1, vC);
        if (wr == 1) PG8_BAR;
        PG8_WAIT_V(2); PG8_BAR;
        PG8_STAGE(PG8_SB(1, 0), cB + kstep, voffB); PG8_STAGEA(PG8_SA(1, 0), cA + kstep, 0, vC); PG8_STAGE(PG8_SB(1, 1), cB + hstep + kstep, voffB);
        PG8_WAIT_V(6); PG8_BAR;
    } else {
        PG8_STAGE(PG8_SB(0, 0), cB, voffB); PG8_STAGE(PG8_SA(0, 0), cA, voffA); PG8_STAGE(PG8_SB(0, 1), cB + hstep, voffB); PG8_STAGE(PG8_SA(0, 1), cA + hstep, voffA);
        if (wr == 1) PG8_BAR;
        PG8_WAIT_V(4); PG8_BAR;
        PG8_STAGE(PG8_SB(1, 0), cB + kstep, voffB); PG8_STAGE(PG8_SA(1, 0), cA + kstep, voffA); PG8_STAGE(PG8_SB(1, 1), cB + hstep + kstep, voffB);
        PG8_WAIT_V(6); PG8_BAR;
    }
    for (;;) {
        const bool has_next = S.next(ui + 1, nxt);
        const char* nA = (has_next && !GATHER) ? (const char*)g.A + (size_t)nxt.pm * tstep : cA; const char* nB = has_next ? (const char*)g.Bt + (size_t)nxt.pn * tstep : cB;
        if constexpr (GATHER) { if (has_next) {
#pragma unroll
            for (int h = 0; h < 2; ++h)
#pragma unroll
                for (int i = 0; i < 2; ++i) __builtin_amdgcn_global_load_lds((const unsigned*)(g.rowsrc + (nxt.pm * BM + h * HALF + grow[i])), (PG8_LAS unsigned*)(lds + GIDX_OFF + ((h * 2 + i) * 8 + wid) * 256), 4, 0, 0); } }
        for (int t = 0; t < nt; t += 2) {
            const bool last = (t == nt - 2);
            const char* a1 = cA + (size_t)(t + 1) * kstep;
            const char* a2 = last ? nA : cA + (size_t)(t + 2) * kstep; const char* b2 = last ? nB : cB + (size_t)(t + 2) * kstep;
            const char* a3 = a2 + kstep; const char* b3 = b2 + kstep;
            if (last && has_next) S.a_ready(nxt);
            unsigned vS[2][2];
            if constexpr (GATHER) {
                if (last && has_next) {
                    asm volatile("s_waitcnt vmcnt(8)" ::: "memory");
#pragma unroll
                    for (int h = 0; h < 2; ++h)
#pragma unroll
                        for (int i = 0; i < 2; ++i) { int r = *(const volatile PG8_LAS int*)(lds + GIDX_OFF + ((h * 2 + i) * 8 + wid) * 256 + lane * 4); r = r < 0 ? 0 : r; vN[h][i] = (unsigned)r * (unsigned)(K * 2) + gcol[i]; }
                }
#pragma unroll
                for (int h = 0; h < 2; ++h)
#pragma unroll
                    for (int i = 0; i < 2; ++i) vS[h][i] = (last && has_next) ? vN[h][i] : vC[h][i];
            }
            if constexpr (SP2) {
            PG8_LDB(B0, 0, 0); PG8_LDB(B1, 0, 1); PG8_SCHED; PG8_LDA(At, 0, 0); PG8_STAGEA(PG8_SA(1, 1), a1, 1, vC);
            PG8_WAIT_V(8); PG8_WAIT_L(0); PG8_BAR; PG8_MMA(0, 0, At, B0); PG8_MMA(0, 1, At, B1); PG8_BAR; PG8_SCHED;
            PG8_LDA(At, 0, 1); PG8_STAGE(PG8_SB(0, 0), b2, voffB); PG8_STAGE(PG8_SB(0, 1), b2 + hstep, voffB); PG8_STAGEA(PG8_SA(0, 0), a2, 0, vS);
            PG8_WAIT_V(8); PG8_WAIT_L(0); PG8_BAR; PG8_MMA(1, 0, At, B0); PG8_MMA(1, 1, At, B1); PG8_BAR; PG8_SCHED;
            PG8_LDB(B0, 1, 0); PG8_LDB(B1, 1, 1); PG8_SCHED; PG8_LDA(At, 1, 0); PG8_STAGEA(PG8_SA(0, 1), a2, 1, vS);
            PG8_WAIT_V(8); PG8_WAIT_L(0); PG8_BAR; PG8_MMA(0, 0, At, B0); PG8_MMA(0, 1, At, B1); PG8_BAR; PG8_SCHED;
            PG8_LDA(At, 1, 1); PG8_STAGE(PG8_SB(1, 0), b3, voffB); PG8_STAGE(PG8_SB(1, 1), b3 + hstep, voffB); PG8_STAGEA(PG8_SA(1, 0), a3, 0, vS);
            PG8_WAIT_V(8); PG8_WAIT_L(0); PG8_BAR; PG8_MMA(1, 0, At, B0); PG8_MMA(1, 1, At, B1); PG8_BAR; PG8_SCHED;
            } else {
            PG8_LDB(B0, 0, 0); PG8_SCHED; PG8_LDA(At, 0, 0); PG8_STAGE(PG8_SA(1, 1), a1 + hstep, voffA);
            PG8_WAIT_L(8); PG8_BAR; PG8_WAIT_L(0); PG8_MMA(0, 0, At, B0); PG8_BAR; PG8_SCHED;
            PG8_LDB(B1, 0, 1); PG8_STAGE(PG8_SB(0, 0), b2, voffB);
            PG8_BAR; PG8_WAIT_L(0); PG8_MMA(0, 1, At, B1); PG8_BAR;
            PG8_LDA(At, 0, 1); PG8_STAGE(PG8_SA(0, 0), a2, voffA);
            PG8_BAR; PG8_WAIT_L(0); PG8_MMA(1, 0, At, B0); PG8_BAR; PG8_SCHED;
            PG8_STAGE(PG8_SB(0, 1), b2 + hstep, voffB);
            PG8_WAIT_V(6); PG8_BAR; PG8_MMA(1, 1, At, B1); PG8_BAR;
            PG8_LDB(B0, 1, 0); PG8_SCHED; PG8_LDA(At, 1, 0); PG8_STAGE(PG8_SA(0, 1), a2 + hstep, voffA);
            PG8_WAIT_L(8); PG8_BAR; PG8_WAIT_L(0); PG8_MMA(0, 0, At, B0); PG8_BAR; PG8_SCHED;
            PG8_LDB(B1, 1, 1); PG8_STAGE(PG8_SB(1, 0), b3, voffB);
            PG8_BAR; PG8_WAIT_L(0); PG8_MMA(0, 1, At, B1); PG8_BAR;
            PG8_LDA(At, 1, 1); PG8_STAGE(PG8_SA(1, 0), a3, voffA);
            PG8_BAR; PG8_WAIT_L(0); PG8_MMA(1, 0, At, B0); PG8_BAR; PG8_SCHED;
            PG8_STAGE(PG8_SB(1, 1), b3 + hstep, voffB);
            PG8_WAIT_V(6); PG8_BAR; PG8_MMA(1, 1, At, B1); PG8_BAR;
            }
        }
        if constexpr (ALIGN_EPI) { if (wr == 0) PG8_BAR; }
        if constexpr (!Epi::AFTER_DRAIN) { E(acc, cur, wr, wc, fr, fq); S.done(cur); }
        if (!has_next) break;
        if constexpr (!Epi::CHAIN) {
#pragma unroll
        for (int a = 0; a < 2; ++a)
#pragma unroll
            for (int b = 0; b < 2; ++b)
#pragma unroll
                for (int m = 0; m < 4; ++m)
#pragma unroll
                    for (int n = 0; n < 2; ++n) acc[a][b][m][n] = (f32x4){0.f, 0.f, 0.f, 0.f};
        }
        cur = nxt; cA = nA; cB = nB; ++ui;
        if constexpr (GATHER) {
#pragma unroll
            for (int h = 0; h < 2; ++h)
#pragma unroll
                for (int i = 0; i < 2; ++i) vC[h][i] = vN[h][i]; }
        if constexpr (ALIGN_EPI) { if (wr == 1) PG8_BAR; }
    }
    PG8_WAIT_V(0);
    if constexpr (!ALIGN_EPI) { if (wr == 0) PG8_BAR; }
    PG8_BAR;
    if constexpr (Epi::AFTER_DRAIN) { E.fused(acc, cur, wr, wc, fr, fq, lds, wid, lane); S.done(cur); }
#undef PG8_SA
#undef PG8_SB
#undef PG8_STAGE
#undef PG8_STAGEA
#undef PG8_LDA
#undef PG8_LDB
#undef PG8_MMA
#undef PG8_WAIT_V
#undef PG8_WAIT_L
#undef PG8_BAR
#undef PG8_SCHED
}
}

namespace pg8 {
__device__ __forceinline__ void map_tile(int L, int nM, int nN, int& pm, int& pn) {
    const int nwg = nM * nN; int wgid = L;
    { const int q = nwg / NXCD, r = nwg % NXCD, xcd = wgid % NXCD, off = wgid / NXCD; wgid = (xcd < r ? xcd * (q + 1) : r * (q + 1) + (xcd - r) * q) + off; }
    const int nig = WGM * nN, gid = wgid / nig, fm = gid * WGM, gsz = (nM - fm) < WGM ? (nM - fm) : WGM;
    pm = fm + ((wgid % nig) % gsz); pn = (wgid % nig) / gsz;
}
struct PlainOrder {
    int nM, nN, G, c;
    __device__ __forceinline__ bool next(int i, Unit& u) const { const long L = (long)i * G + c; if (L >= (long)nM * nN) return false; map_tile((int)L, nM, nN, u.pm, u.pn); u.aux = u.pn; return true; }
    __device__ __forceinline__ void a_ready(const Unit&) const {}
    __device__ __forceinline__ void done(const Unit&) const {}
};
struct MergeOrder {
    int nM, G, c;
    __device__ __forceinline__ bool next(int i, Unit& u) const { const int tr = i / 3, n = i - 3 * tr; const long L = (long)tr * G + c; if (L >= (long)nM * 4) return false;
        int pm, pn; map_tile((int)L, nM, 4, pm, pn); u.pm = n * (R / 256) + pm; u.pn = n * 4 + pn; u.aux = n; return true; }
    __device__ __forceinline__ void a_ready(const Unit&) const {}
    __device__ __forceinline__ void done(const Unit&) const {}
};
struct MoeOrder {
    int PM, nN, G, c;
    __device__ __forceinline__ bool next(int i, Unit& u) const { const long L = (long)i * G + c; if (L >= (long)NE * PM * nN) return false;
        int pm, pn; map_tile((int)L, NE * PM, nN, pm, pn); const int e = pm / PM, p = pm - e * PM; u.pm = e * 17 + p; u.pn = e * nN + pn; u.aux = pn; return true; }
    __device__ __forceinline__ void a_ready(const Unit&) const {}
    __device__ __forceinline__ void done(const Unit&) const {}
};

__device__ __forceinline__ unsigned gate_q8x4(float a, float b, float c, float d) { const float sc = 255.9999f;
    return (unsigned)(a * sc) | ((unsigned)(b * sc) << 8) | ((unsigned)(c * sc) << 16) | ((unsigned)(d * sc) << 24); }
__device__ __forceinline__ float gate_c(unsigned w, int j) { return (float)((w >> (8 * j)) & 0xffu) + 0.5f; }
__device__ __forceinline__ float gate_dq(unsigned w, int j) { return (float)((w >> (8 * j)) & 0xffu) * 0.00390625f + 0.001953125f; }
struct EpiInProj {
    static constexpr bool PERM = false, AFTER_DRAIN = false, CHAIN = false;
    unsigned char* ws; const float *qn, *kn; unsigned* nrm;
    __device__ __forceinline__ void operator()(const f32x4 (&acc)[2][2][4][2], const Unit& u, int wr, int wc, int fr_, int fq_) const {
        int fr = fr_, fq = fq_; asm volatile("" : "+v"(fr), "+v"(fq));
        const int pn = u.pn;
        bf16_t* dst; int ld, colbase; bool kv = false, rope = false, gm = false; const float* gain = nullptr; float scale = 1.f; int act = 0, trk = -1; float nmx = 0.f;
        if (pn < 2)       { dst = (bf16_t*)(ws + WS_QA); ld = 512; colbase = pn * 256 + wc * 64; gain = qn; rope = true; scale = C2; }
        else if (pn == 2) { if (wc < 2) { dst = (bf16_t*)(ws + WS_KA); ld = 128; colbase = wc * 64; kv = true; gain = kn; rope = true; } else { dst = (bf16_t*)(ws + WS_VA); ld = 128; colbase = (wc - 2) * 64; kv = true; } }
        else if (pn < 5)  { dst = (bf16_t*)(ws + WS_XB); ld = 512; colbase = (pn - 3) * 256 + wc * 64; }
        else if (pn < 7)  { dst = (bf16_t*)(ws + WS_GB); ld = 512; colbase = (pn - 5) * 256 + wc * 64; act = 1; }
        else if (pn < 9)  { dst = (bf16_t*)(ws + WS_QC); ld = 512; colbase = (pn - 7) * 256 + wc * 64; rope = true; scale = C2; trk = 0; }
        else if (pn < 11) { dst = (bf16_t*)(ws + WS_KC); ld = 512; colbase = (pn - 9) * 256 + wc * 64; kv = true; rope = true; trk = 1; }
        else if (pn < 13) { dst = (bf16_t*)(ws + WS_VC); ld = 512; colbase = (pn - 11) * 256 + wc * 64; kv = true; }
        else              { dst = (bf16_t*)(ws + WS_GM); ld = 3072; colbase = (pn - 13) * 256 + wc * 32; act = 2; gm = true; }
#pragma unroll
        for (int ai = 0; ai < 2; ++ai)
#pragma unroll
            for (int m = 0; m < 4; ++m) {
                const int r = u.pm * BM + ai * HALF + wr * 64 + m * 16 + fr;
                f32x4 v[2][2];
#pragma unroll
                for (int bj = 0; bj < 2; ++bj)
#pragma unroll
                    for (int n = 0; n < 2; ++n) v[bj][n] = acc[ai][bj][m][n];
                if (gain) {
                    float ss = 0.f;
#pragma unroll
                    for (int bj = 0; bj < 2; ++bj)
#pragma unroll
                        for (int n = 0; n < 2; ++n) ss += (v[bj][n][0] * v[bj][n][0] + v[bj][n][1] * v[bj][n][1]) + (v[bj][n][2] * v[bj][n][2] + v[bj][n][3] * v[bj][n][3]);
                    ss += __shfl_xor(ss, 16); ss += __shfl_xor(ss, 32);
                    const float rinv = __builtin_amdgcn_rsqf(ss * (1.0f / 64.0f) + RMS_EPS);
#pragma unroll
                    for (int bj = 0; bj < 2; ++bj)
#pragma unroll
                        for (int n = 0; n < 2; ++n) v[bj][n] = v[bj][n] * rinv * *(const f32x4*)(gain + 32 * bj + 16 * n + 4 * fq);
                }
                if (rope && r < T) {
                    const int s = r & (SEQ - 1); const float pos[2] = {(float)(s >> 6), (float)(s & 63)};
#pragma unroll
                    for (int bj = 0; bj < 2; ++bj)
#pragma unroll
                        for (int j = 0; j < 4; ++j) {
                            const float invf = __builtin_amdgcn_exp2f(-(float)(4 * fq + j) * (13.287712379549449f / 16.0f)) * 0.15915494309189535f;
                            float rev = pos[bj] * invf; rev = rev - floorf(rev);
                            const float sn = __builtin_amdgcn_sinf(rev), cs = __builtin_amdgcn_cosf(rev);
                            const float x1 = v[bj][0][j], x2 = v[bj][1][j];
                            v[bj][0][j] = x1 * cs - x2 * sn; v[bj][1][j] = x2 * cs + x1 * sn;
                        }
                }
                if (trk >= 0) { float ss = 0.f;
#pragma unroll
                    for (int bj = 0; bj < 2; ++bj)
#pragma unroll
                        for (int n = 0; n < 2; ++n) ss += (v[bj][n][0] * v[bj][n][0] + v[bj][n][1] * v[bj][n][1]) + (v[bj][n][2] * v[bj][n][2] + v[bj][n][3] * v[bj][n][3]);
                    ss += __shfl_xor(ss, 16); ss += __shfl_xor(ss, 32); nmx = __builtin_fmaxf(nmx, ss); }
                size_t drow = (size_t)r;
                if (kv) { if (r < T) drow = (size_t)(r >> 13) * KVL + CTX + (r & (SEQ - 1)); else { const int jj = r - T; drow = (size_t)(jj >> 8) * KVL + (jj & 255); } }
                bf16_t* rowp = dst + drow * ld + colbase + 4 * fq;
                if (gm) {
                    unsigned char* gp = (unsigned char*)dst + drow * 3072 + colbase + 8 * fq;
#pragma unroll
                    for (int bj = 0; bj < 2; ++bj) { const f32x4 a0 = v[bj][0], a1 = v[bj][1];
                        v2u w; w.x = gate_q8x4(sigmoid_f(a0[0]), sigmoid_f(a0[1]), sigmoid_f(a0[2]), sigmoid_f(a0[3])); w.y = gate_q8x4(sigmoid_f(a1[0]), sigmoid_f(a1[1]), sigmoid_f(a1[2]), sigmoid_f(a1[3]));
                        *(v2u*)(gp + bj * HALF) = w; }
                } else
#pragma unroll
                for (int bj = 0; bj < 2; ++bj)
#pragma unroll
                    for (int n = 0; n < 2; ++n) {
                        f32x4 o = v[bj][n] * scale;
                        if (act == 1) { o[0] = gelu_tanh_f(o[0]); o[1] = gelu_tanh_f(o[1]); o[2] = gelu_tanh_f(o[2]); o[3] = gelu_tanh_f(o[3]); }
                        if (act == 2) { o[0] = sigmoid_f(o[0]); o[1] = sigmoid_f(o[1]); o[2] = sigmoid_f(o[2]); o[3] = sigmoid_f(o[3]); }
                        v2u w; w.x = cvt_pk_bf16(o[0], o[1]); w.y = cvt_pk_bf16(o[2], o[3]);
                        *(v2u*)(rowp + 32 * bj + 16 * n) = w;
                    }
                __builtin_amdgcn_sched_barrier(0);
            }
        if (trk >= 0) { nmx = __builtin_fmaxf(nmx, __shfl_xor(nmx, 1)); nmx = __builtin_fmaxf(nmx, __shfl_xor(nmx, 2)); nmx = __builtin_fmaxf(nmx, __shfl_xor(nmx, 4)); nmx = __builtin_fmaxf(nmx, __shfl_xor(nmx, 8));
            if (fr == 0 && fq == 0) (void)__hip_atomic_fetch_max(nrm + trk, __float_as_uint(nmx), __ATOMIC_RELAXED, __HIP_MEMORY_SCOPE_AGENT); }
    }
};

struct EpiMerge {
    static constexpr bool PERM = true, AFTER_DRAIN = false, CHAIN = true;
    const unsigned char* GMF; bf16_t* MM;
    __device__ __forceinline__ void operator()(f32x4 (&acc)[2][2][4][2], const Unit& u, int wr, int wc, int fr, int fq) const {
        const int nb = u.aux, pm = u.pm - nb * (R / 256), pn = u.pn - nb * 4;
        const unsigned char* gt = GMF + (size_t)(pm * BM + wr * 64 + fr) * 3072 + nb * 1024 + pn * BM + wc * 32 + 8 * fq;
        const int row0 = pm * BM + wr * 64 + fr, col0 = pn * BM + wc * 32 + 8 * fq;
        constexpr int PD = 6;
        v2u ga[PD], gb[PD];
#define MG_LOAD(k_, s_) do { const int ai_ = (k_) >> 3, m_ = ((k_) >> 1) & 3, bj_ = (k_) & 1; const unsigned char* q_ = gt + (size_t)(ai_ * HALF + m_ * 16) * 3072 + bj_ * HALF; \
            ga[s_] = *(const v2u*)q_; gb[s_] = nb < 2 ? *(const v2u*)(q_ + 1024) : (v2u){0u, 0u}; } while (0)
#pragma unroll
        for (int k = 0; k < PD; ++k) MG_LOAD(k, k);
#pragma unroll
        for (int k = 0; k < 16; ++k) { const int ai = k >> 3, m = (k >> 1) & 3, bj = k & 1, s = k % PD;
            const v2u gw = ga[s], hw = gb[s];
            asm volatile("" :: "v"(gw), "v"(hw));
            if (k + PD < 16) MG_LOAD(k + PD, s);
            f32x4 o0 = acc[ai][bj][m][0], o1 = acc[ai][bj][m][1];
            if (nb < 2) {
#pragma unroll
                for (int j = 0; j < 4; ++j) { o0[j] *= gate_c(gw.x, j) * __builtin_amdgcn_rcpf(gate_c(hw.x, j)); o1[j] *= gate_c(gw.y, j) * __builtin_amdgcn_rcpf(gate_c(hw.y, j)); }
                acc[ai][bj][m][0] = o0; acc[ai][bj][m][1] = o1;
            } else {
#pragma unroll
                for (int j = 0; j < 4; ++j) { o0[j] *= gate_dq(gw.x, j); o1[j] *= gate_dq(gw.y, j); }
                u32x4 w; w.x = cvt_pk_bf16(o0[0], o0[1]); w.y = cvt_pk_bf16(o0[2], o0[3]); w.z = cvt_pk_bf16(o1[0], o1[1]); w.w = cvt_pk_bf16(o1[2], o1[3]);
                *(u32x4*)(MM + (size_t)(row0 + ai * HALF + m * 16) * 1024 + col0 + bj * HALF) = w;
                acc[ai][bj][m][0] = (f32x4){0.f, 0.f, 0.f, 0.f}; acc[ai][bj][m][1] = (f32x4){0.f, 0.f, 0.f, 0.f}; }
        }
#undef MG_LOAD
    }
};

struct EpiF32 {
    static constexpr bool PERM = false, AFTER_DRAIN = false, CHAIN = false;
    float* C; int ldc;
    __device__ __forceinline__ void operator()(const f32x4 (&acc)[2][2][4][2], const Unit& u, int wr, int wc, int fr, int fq) const {
        const int row0 = u.pm * BM + wr * 64 + fr, col0 = u.pn * BM + wc * 32 + 4 * fq;
#pragma unroll
        for (int ai = 0; ai < 2; ++ai)
#pragma unroll
            for (int m = 0; m < 4; ++m) { float* rowp = C + (size_t)(row0 + ai * HALF + m * 16) * ldc + col0;
#pragma unroll
                for (int bj = 0; bj < 2; ++bj)
#pragma unroll
                    for (int n = 0; n < 2; ++n) *(f32x4*)(rowp + bj * HALF + n * 16) = acc[ai][bj][m][n]; }
    }
};

struct EpiGateUp {
    static constexpr bool PERM = true, AFTER_DRAIN = false, CHAIN = false;
    bf16_t* ACT;
    __device__ __forceinline__ void operator()(const f32x4 (&acc)[2][2][4][2], const Unit& u, int wr, int wc, int fr, int fq) const {
        const int row0 = u.pm * BM + wr * 64 + fr, col0 = u.aux * 128 + wc * 32 + 8 * fq;
#pragma unroll
        for (int ai = 0; ai < 2; ++ai)
#pragma unroll
            for (int m = 0; m < 4; ++m) { bf16_t* rowp = ACT + (size_t)(row0 + ai * HALF + m * 16) * FFP + col0;
                const f32x4 g0 = acc[ai][0][m][0], g1 = acc[ai][0][m][1], u0 = acc[ai][1][m][0], u1 = acc[ai][1][m][1];
                u32x4 w; w.x = cvt_pk_bf16(silu_f(g0[0]) * u0[0], silu_f(g0[1]) * u0[1]); w.y = cvt_pk_bf16(silu_f(g0[2]) * u0[2], silu_f(g0[3]) * u0[3]);
                w.z = cvt_pk_bf16(silu_f(g1[0]) * u1[0], silu_f(g1[1]) * u1[1]); w.w = cvt_pk_bf16(silu_f(g1[2]) * u1[2], silu_f(g1[3]) * u1[3]);
                *(u32x4*)rowp = w; }
    }
};

__device__ __forceinline__ float clamp448(float x) { return __builtin_fminf(__builtin_fmaxf(x, -448.0f), 448.0f); }
__device__ __forceinline__ unsigned pk_fp8x4(float a, float b, float c, float d) { int w = 0; w = __builtin_amdgcn_cvt_pk_fp8_f32(clamp448(a), clamp448(b), w, false); w = __builtin_amdgcn_cvt_pk_fp8_f32(clamp448(c), clamp448(d), w, true); return (unsigned)w; }
struct EpiGateUp8 {
    static constexpr bool PERM = true, AFTER_DRAIN = false, CHAIN = false;
    unsigned char* ACT; float descale;
    __device__ __forceinline__ void operator()(const f32x4 (&acc)[2][2][4][2], const Unit& u, int wr, int wc, int fr, int fq) const {
        const int row0 = u.pm * BM + wr * 64 + fr, col0 = u.aux * 128 + wc * 32 + 8 * fq;
#pragma unroll
        for (int ai = 0; ai < 2; ++ai)
#pragma unroll
            for (int m = 0; m < 4; ++m) { unsigned char* rowp = ACT + (size_t)(row0 + ai * HALF + m * 16) * FFP + col0;
                const f32x4 g0 = acc[ai][0][m][0] * descale, g1 = acc[ai][0][m][1] * descale, u0 = acc[ai][1][m][0] * descale, u1 = acc[ai][1][m][1] * descale;
                v2u w; w.x = pk_fp8x4(silu_f(g0[0]) * u0[0], silu_f(g0[1]) * u0[1], silu_f(g0[2]) * u0[2], silu_f(g0[3]) * u0[3]);
                w.y = pk_fp8x4(silu_f(g1[0]) * u1[0], silu_f(g1[1]) * u1[1], silu_f(g1[2]) * u1[2], silu_f(g1[3]) * u1[3]);
                *(v2u*)rowp = w; }
    }
};

struct EpiGate8 {
    static constexpr bool PERM = false, AFTER_DRAIN = false, CHAIN = false;
    unsigned char* GM; float descale;
    __device__ __forceinline__ void operator()(const f32x4 (&acc)[2][2][4][2], const Unit& u, int wr, int wc, int fr, int fq) const {
        const int row0 = u.pm * BM + wr * 64 + fr, col0 = u.pn * BM + wc * 32 + 8 * fq;
#pragma unroll
        for (int ai = 0; ai < 2; ++ai)
#pragma unroll
            for (int m = 0; m < 4; ++m) { unsigned char* rowp = GM + (size_t)(row0 + ai * HALF + m * 16) * 3072 + col0;
#pragma unroll
                for (int bj = 0; bj < 2; ++bj) { const f32x4 a0 = acc[ai][bj][m][0], a1 = acc[ai][bj][m][1];
                    const float ce = -1.4426950408889634f * descale, cq = 1.0f / 255.999f;
                    unsigned q0[4], q1[4];
#pragma unroll
                    for (int j = 0; j < 4; ++j) { q0[j] = (unsigned)__builtin_amdgcn_rcpf(__builtin_fmaf(__builtin_amdgcn_exp2f(a0[j] * ce), cq, cq)); q1[j] = (unsigned)__builtin_amdgcn_rcpf(__builtin_fmaf(__builtin_amdgcn_exp2f(a1[j] * ce), cq, cq)); }
                    v2u w; w.x = q0[0] | (q0[1] << 8) | (q0[2] << 16) | (q0[3] << 24); w.y = q1[0] | (q1[1] << 8) | (q1[2] << 16) | (q1[3] << 24);
                    *(v2u*)(rowp + bj * HALF) = w; }
                __builtin_amdgcn_sched_barrier(0); }
    }
};

struct EpiBf16Out {
    static constexpr bool PERM = true, AFTER_DRAIN = false, CHAIN = false;
    bf16_t* O; int ldc; float scale;
    __device__ __forceinline__ void operator()(const f32x4 (&acc)[2][2][4][2], const Unit& u, int wr, int wc, int fr, int fq) const {
        const int row0 = u.pm * BM + wr * 64 + fr, col0 = u.aux * BM + wc * 32 + 8 * fq;
#pragma unroll
        for (int ai = 0; ai < 2; ++ai)
#pragma unroll
            for (int m = 0; m < 4; ++m) { bf16_t* rowp = O + (size_t)(row0 + ai * HALF + m * 16) * ldc + col0;
#pragma unroll
                for (int bj = 0; bj < 2; ++bj) { const f32x4 v0 = acc[ai][bj][m][0] * scale, v1 = acc[ai][bj][m][1] * scale;
                    u32x4 w; w.x = cvt_pk_bf16(v0[0], v0[1]); w.y = cvt_pk_bf16(v0[2], v0[3]); w.z = cvt_pk_bf16(v1[0], v1[1]); w.w = cvt_pk_bf16(v1[2], v1[3]);
                    *(u32x4*)(rowp + bj * HALF) = w; } }
    }
};
}
namespace attn_body {
using bf16=__hip_bfloat16;
using bf16x8=__attribute__((ext_vector_type(8)))short;
using s16x4=__attribute__((ext_vector_type(4)))short;
using f32x16=__attribute__((ext_vector_type(16)))float;
using u32x4=__attribute__((ext_vector_type(4)))unsigned;
constexpr int D=64;
constexpr int NW=8,QBLK=32,QB=QBLK*NW,KVBLK=64;
constexpr int ATTN_UNIT_ROWS=QB;
__device__ __forceinline__ int crow(int r,int hi){return (r&3)+8*(r>>2)+4*hi;}
#define SBAR() __builtin_amdgcn_sched_barrier(0)
constexpr int NSLOT=3, SLOTB=8192;
constexpr int LDS_K=0, LDS_V=NSLOT*SLOTB, LDS_WS=2*NSLOT*SLOTB, LDS_OST=LDS_WS+NW*64*4, LDS_BYTES=LDS_OST+NW*4096;
__device__ __forceinline__ void glds16(const void*gsrc,unsigned lds_dst){unsigned keep;
  asm volatile("s_mov_b32 %0, m0\n\ts_mov_b32 m0, %2\n\ts_nop 0\n\tglobal_load_lds_dwordx4 %1, off\n\ts_mov_b32 m0, %0":"=&s"(keep):"v"(gsrc),"s"(lds_dst):"memory");}
__device__ __forceinline__ float max3f(float a,float b,float c){float r;asm("v_max3_f32 %0, %1, %2, %3":"=v"(r):"v"(a),"v"(b),"v"(c));return r;}
__device__ __forceinline__ float max2f(float a,float b){float r;asm("v_max_f32_e32 %0, %1, %2":"=v"(r):"v"(a),"v"(b));return r;}
__device__ __forceinline__ float fadd_s(float a,float b){float r;asm("v_add_f32_e32 %0, %1, %2":"=v"(r):"v"(a),"v"(b));return r;}
__device__ __forceinline__ float fsub_s(float a,float b){float r;asm("v_sub_f32_e32 %0, %1, %2":"=v"(r):"v"(a),"v"(b));return r;}
typedef float f32x2_t __attribute__((ext_vector_type(2))); typedef __bf16 bf16x2_t __attribute__((ext_vector_type(2)));
__device__ __forceinline__ unsigned cvtpk_s(float lo,float hi){f32x2_t v={lo,hi};bf16x2_t b=__builtin_convertvector(v,bf16x2_t);return __builtin_bit_cast(unsigned,b);}
#define WAIT_BAR(N) asm volatile("s_waitcnt vmcnt(" #N ") lgkmcnt(0)\n\ts_barrier":::"memory")

__device__ __forceinline__ void qkt(f32x16&p0,f32x16&p1,const char*Kslot,const bf16x8*qr,const f32x16&negm,int r32,int hi){
  const char*kb=Kslot+hi*1024+r32*16;
  #pragma unroll
  for(int d0=0;d0<4;++d0){
    const bf16x8 b0=*reinterpret_cast<const bf16x8*>(kb+d0*2048);
    const bf16x8 b1=*reinterpret_cast<const bf16x8*>(kb+d0*2048+512);
    if(d0==0){p0=__builtin_amdgcn_mfma_f32_32x32x16_bf16(b0,qr[0],negm,0,0,0);p1=__builtin_amdgcn_mfma_f32_32x32x16_bf16(b1,qr[0],negm,0,0,0);}
    else{p0=__builtin_amdgcn_mfma_f32_32x32x16_bf16(b0,qr[d0],p0,0,0,0);p1=__builtin_amdgcn_mfma_f32_32x32x16_bf16(b1,qr[d0],p1,0,0,0);}}
}
typedef __attribute__((address_space(3))) const char* lds_cptr;
typedef short v4i16_t __attribute__((ext_vector_type(4)));
__device__ __forceinline__ void kload8(bf16x8*kf,lds_cptr kp){
  kf[0]=*(const __attribute__((address_space(3))) bf16x8*)(kp);      kf[1]=*(const __attribute__((address_space(3))) bf16x8*)(kp+512);
  kf[2]=*(const __attribute__((address_space(3))) bf16x8*)(kp+2048); kf[3]=*(const __attribute__((address_space(3))) bf16x8*)(kp+2560);
  kf[4]=*(const __attribute__((address_space(3))) bf16x8*)(kp+4096); kf[5]=*(const __attribute__((address_space(3))) bf16x8*)(kp+4608);
  kf[6]=*(const __attribute__((address_space(3))) bf16x8*)(kp+6144); kf[7]=*(const __attribute__((address_space(3))) bf16x8*)(kp+6656);
}
__device__ __forceinline__ void kload2(bf16x8*kf,lds_cptr kp,int j){ kf[2*j]=*(const __attribute__((address_space(3))) bf16x8*)(kp+j*2048); kf[2*j+1]=*(const __attribute__((address_space(3))) bf16x8*)(kp+j*2048+512); }
__device__ __forceinline__ s16x4 vtr(lds_cptr p){ return __builtin_bit_cast(s16x4,__builtin_amdgcn_ds_read_tr16_b64_v4i16((__attribute__((address_space(3))) v4i16_t*)p)); }
__device__ __forceinline__ float rowmax(const f32x16&p0,const f32x16&p1){
  float a=max3f(p0[0],p0[1],p1[0]),b=max3f(p0[2],p0[3],p1[1]);a=max3f(a,p1[2],p1[3]);
  #pragma unroll
  for(int r=4;r<16;r+=4){a=max3f(a,p0[r],p0[r+1]);b=max3f(b,p0[r+2],p0[r+3]);a=max3f(a,p1[r],p1[r+1]);b=max3f(b,p1[r+2],p1[r+3]);}
  const float m=max2f(a,b);
  auto rr=__builtin_amdgcn_permlane32_swap(__float_as_uint(m),__float_as_uint(m),false,false);
  return max2f(__uint_as_float(rr[0]),__uint_as_float(rr[1]));
}
__device__ __forceinline__ void pv(f32x16*o,int vb,bf16x8 pa0,bf16x8 pa1,bf16x8 pa2,bf16x8 pa3){
  #pragma unroll
  for(int d0=0;d0<2;++d0){s16x4 lo[4],hi[4];
    #pragma unroll
    for(int ks=0;ks<4;++ks){
      asm volatile("ds_read_b64_tr_b16 %0,%1 offset:%c2":"=&v"(lo[ks]):"v"(vb),"i"(d0*4096+ks*1024):"memory");
      asm volatile("ds_read_b64_tr_b16 %0,%1 offset:%c2":"=&v"(hi[ks]):"v"(vb),"i"(d0*4096+ks*1024+512):"memory");}
    asm volatile("s_waitcnt lgkmcnt(0)":::"memory");SBAR();
    #define PK(k) (bf16x8){lo[k][0],lo[k][1],lo[k][2],lo[k][3],hi[k][0],hi[k][1],hi[k][2],hi[k][3]}
    o[d0]=__builtin_amdgcn_mfma_f32_32x32x16_bf16(pa0,PK(0),o[d0],0,0,0);
    o[d0]=__builtin_amdgcn_mfma_f32_32x32x16_bf16(pa1,PK(1),o[d0],0,0,0);
    o[d0]=__builtin_amdgcn_mfma_f32_32x32x16_bf16(pa2,PK(2),o[d0],0,0,0);
    o[d0]=__builtin_amdgcn_mfma_f32_32x32x16_bf16(pa3,PK(3),o[d0],0,0,0);
    #undef PK
  }
}

#ifndef ATTN_STORE16
#define ATTN_STORE16(p,v) (*(u32x4*)(p)=(v))
#endif
template<int THRL,bool NOMAX=false> __device__ __forceinline__ void attn_unit(const bf16*Qu,int qp,const bf16*__restrict__ Kh,int kp,const bf16*__restrict__ Vh,int vp,bf16*Ou,int op,int NT,char*shm,int tid_in){
  int tid_=tid_in; asm volatile("":"+v"(tid_));
  const int tid=tid_,lane=tid&63,r32=lane&31,hi=lane>>5; const int wid=__builtin_amdgcn_readfirstlane(tid>>6);
  const bf16*Qw=Qu+(long)(wid*QBLK)*qp;
  const unsigned lds0=(unsigned)(uintptr_t)shm;
  float*wsf=(float*)(shm+LDS_WS)+wid*64;
  const bf16*ksrc=Kh+(long)lane*kp+wid*8;
  const bf16*vsrc=Vh+(long)(16*(wid&3)+(lane>>2))*vp+(wid>>2)*32+(lane&3)*8;
  const unsigned kdst=lds0+LDS_K+wid*1024, vdst=lds0+LDS_V+wid*1024;
  #define DMA_K(t,slot) glds16(ksrc+(long)(t)*KVBLK*kp,(unsigned)__builtin_amdgcn_readfirstlane(kdst+(slot)))
  #define DMA_V(t,slot) glds16(vsrc+(long)(t)*KVBLK*vp,(unsigned)__builtin_amdgcn_readfirstlane(vdst+(slot)))
  const int vb0=(int)(lds0+LDS_V)+((lane>>4)&1)*32+(lane&3)*8+(4*hi+((lane&15)>>2))*64;
  const char*Kbase=shm+LDS_K; bf16x8 kf[8];
  const lds_cptr shm3=(lds_cptr)shm; const lds_cptr kp0=shm3+LDS_K+hi*1024+r32*16; const lds_cptr vp0=shm3+LDS_V+((lane>>4)&1)*32+(lane&3)*8+(4*hi+((lane&15)>>2))*64;
  DMA_K(0,0);DMA_V(0,0);DMA_K(1,SLOTB);
  bf16x8 qr[4];
  #pragma unroll
  for(int d0=0;d0<4;++d0)qr[d0]=*reinterpret_cast<const bf16x8*>(&Qw[(long)r32*qp+d0*16+hi*8]);
  float mhat=0.f,l_reg=0.f;f32x16 o[2];o[0]=f32x16{};o[1]=f32x16{};f32x16 negm=f32x16{};asm volatile("":"+v"(negm));
  #define CMASK(P0,P1,t) do{}while(0)
  bool resc=false;
  #define START(P0,P1) do{ resc=false; if constexpr(!NOMAX){ const float rm=rowmax(P0,P1); \
    { const float dl=rm; mhat=fadd_s(mhat,dl); \
      _Pragma("unroll") for(int r=0;r<16;++r){P0[r]=fsub_s(P0[r],dl);P1[r]=fsub_s(P1[r],dl);} \
      _Pragma("unroll") for(int r=0;r<16;++r)negm[r]=-mhat; asm volatile("":"+v"(negm)); } } \
    _Pragma("unroll") for(int r=0;r<16;++r)P0[r]=__builtin_amdgcn_exp2f(P0[r]); }while(0)
  #define RESC() do{ if(resc){ asm volatile("s_waitcnt lgkmcnt(0)":::"memory"); \
      _Pragma("unroll") for(int d_=0;d_<2;++d_) _Pragma("unroll") for(int r=0;r<16;++r)o[d_][r]*=wsf[crow(r,hi)]; } }while(0)
  f32x16 pA0,pA1,pB0,pB1;
  int sl_prev=0,sl_cur=0,sl_next=SLOTB;
  #define ROT() do{sl_prev=sl_cur;sl_cur=sl_next;sl_next=(sl_next==(NSLOT-1)*SLOTB)?0:sl_next+SLOTB;}while(0)
  DMA_K(2,2*SLOTB);
  WAIT_BAR(3);
  qkt(pA0,pA1,Kbase,qr,negm,r32,hi);asm volatile("s_nop 15\n\ts_nop 7":"+v"(pA0),"+v"(pA1));CMASK(pA0,pA1,0);
  START(pA0,pA1);
  _Pragma("unroll") for(int r=0;r<16;++r)pA1[r]=__builtin_amdgcn_exp2f(pA1[r]);
  WAIT_BAR(0);
  DMA_K(3,0);DMA_V(1,SLOTB);
  ROT();
  kload8(kf,kp0+sl_cur);
  WAIT_BAR(2);
  s16x4 vlo[8],vhi[8]; u32x4 pw0,pw1,pw2,pw3;
  #define PKW(P,B) cvtpk_s(P[B],P[B+1])
  #define PAF(k) __builtin_bit_cast(bf16x8,pw##k)
  #define VFR(i) (bf16x8){vlo[i][0],vlo[i][1],vlo[i][2],vlo[i][3],vhi[i][0],vhi[i][1],vhi[i][2],vhi[i][3]}
  #define PIN(x) asm volatile("":"+v"(x))
  #define MX3(a,b,c) __builtin_fmaxf(__builtin_fmaxf((a),(b)),(c))
  #define GAPA(MF,A0,A1,A2,A3,W0,W1,PW) do{ MF; sacc+=A0; sacc+=A1; sacc+=A2; sacc+=A3; PIN(sacc); W0; W1; PIN(PW); SBAR(); }while(0)
  #define EX(v) __builtin_amdgcn_exp2f(v)
  #define GAPB(MF,X,B) do{ MF; X[B]=EX(X[B]); X[B+1]=EX(X[B+1]); X[B+2]=EX(X[B+2]); X[B+3]=EX(X[B+3]); PIN(X); SBAR(); }while(0)
  #define VRD(i) do{ vlo[i]=vtr(vp_+(((i)>>2)*4096+((i)&3)*1024)); vhi[i]=vtr(vp_+(((i)>>2)*4096+((i)&3)*1024+512)); }while(0)
  #define KRD(G,j) do{ if(G){ kload2(kf,kp0+sl_next,j); SBAR(); } }while(0)
  #define STEP(C0,C1,P0,P1,t,GK,GV,GL) do{ SBAR(); \
    const lds_cptr vp_=vp0+sl_prev; \
    VRD(0); SBAR(); float sacc=(P0[0]+P0[1]); \
    GAPA(C0=__builtin_amdgcn_mfma_f32_32x32x16_bf16(kf[0],qr[0],negm,0,0,0), P0[2],P0[3],P0[4],P0[5],     pw0[0]=PKW(P0,0), pw0[1]=PKW(P0,2), pw0); \
    VRD(4); SBAR(); GAPA(C1=__builtin_amdgcn_mfma_f32_32x32x16_bf16(kf[1],qr[0],negm,0,0,0), P0[6],P0[7],P0[8],P0[9],     pw0[2]=PKW(P0,4), pw0[3]=PKW(P0,6), pw0); \
    VRD(1); SBAR(); GAPA(C0=__builtin_amdgcn_mfma_f32_32x32x16_bf16(kf[2],qr[1],C0,0,0,0),   P0[10],P0[11],P0[12],P0[13], pw1[0]=PKW(P0,8), pw1[1]=PKW(P0,10), pw1); \
    VRD(5); SBAR(); GAPA(C1=__builtin_amdgcn_mfma_f32_32x32x16_bf16(kf[3],qr[1],C1,0,0,0),   P0[14],P0[15],P1[0],P1[1],   pw1[2]=PKW(P0,12),pw1[3]=PKW(P0,14), pw1); \
    VRD(2); SBAR(); GAPA(C0=__builtin_amdgcn_mfma_f32_32x32x16_bf16(kf[4],qr[2],C0,0,0,0),   P1[2],P1[3],P1[4],P1[5],     pw2[0]=PKW(P1,0), pw2[1]=PKW(P1,2), pw2); \
    VRD(6); SBAR(); GAPA(C1=__builtin_amdgcn_mfma_f32_32x32x16_bf16(kf[5],qr[2],C1,0,0,0),   P1[6],P1[7],P1[8],P1[9],     pw2[2]=PKW(P1,4), pw2[3]=PKW(P1,6), pw2); \
    VRD(3); SBAR(); GAPA(C0=__builtin_amdgcn_mfma_f32_32x32x16_bf16(kf[6],qr[3],C0,0,0,0),   P1[10],P1[11],P1[12],P1[13], pw3[0]=PKW(P1,8), pw3[1]=PKW(P1,10), pw3); \
    VRD(7); SBAR(); GAPA(C1=__builtin_amdgcn_mfma_f32_32x32x16_bf16(kf[7],qr[3],C1,0,0,0),   P1[14],P1[15],0.f,0.f,       pw3[2]=PKW(P1,12),pw3[3]=PKW(P1,14), pw3); \
    l_reg+=sacc; \
    if(GK){DMA_K((t)+3,sl_cur);} if(GV){DMA_V((t)+1,sl_next);} \
    CMASK(C0,C1,t); \
    if constexpr(!NOMAX){ float a=MX3(C0[0],C0[1],C1[0]),b=MX3(C0[2],C0[3],C1[1]); a=MX3(a,C1[2],C1[3]); \
      _Pragma("unroll") for(int r=4;r<16;r+=4){a=MX3(a,C0[r],C0[r+1]);b=MX3(b,C0[r+2],C0[r+3]);a=MX3(a,C1[r],C1[r+1]);b=MX3(b,C1[r+2],C1[r+3]);} \
      float rm=__builtin_fmaxf(a,b); { auto rr=__builtin_amdgcn_permlane32_swap(__float_as_uint(rm),__float_as_uint(rm),false,false); rm=__builtin_fmaxf(__uint_as_float(rr[0]),__uint_as_float(rr[1])); } \
      resc=false; \
      if(__builtin_expect(__any(rm>(float)THRL),0)){ const float dl=__builtin_fmaxf(rm,0.f); mhat+=dl; \
        _Pragma("unroll") for(int r=0;r<16;++r){C0[r]-=dl;C1[r]-=dl;} \
        _Pragma("unroll") for(int r=0;r<16;++r)negm[r]=-mhat; asm volatile("":"+v"(negm)); \
        const float f=__builtin_amdgcn_exp2f(-dl); l_reg*=f; if(hi==0)wsf[r32]=f; resc=true; } } \
    SBAR(); \
    GAPB(o[0]=__builtin_amdgcn_mfma_f32_32x32x16_bf16(PAF(0),VFR(0),o[0],0,0,0), C0,0); \
    GAPB(o[1]=__builtin_amdgcn_mfma_f32_32x32x16_bf16(PAF(0),VFR(4),o[1],0,0,0), C0,4); \
    KRD(GL,0); GAPB(o[0]=__builtin_amdgcn_mfma_f32_32x32x16_bf16(PAF(1),VFR(1),o[0],0,0,0), C0,8); \
    KRD(GL,1); GAPB(o[1]=__builtin_amdgcn_mfma_f32_32x32x16_bf16(PAF(1),VFR(5),o[1],0,0,0), C0,12); \
    KRD(GL,2); GAPB(o[0]=__builtin_amdgcn_mfma_f32_32x32x16_bf16(PAF(2),VFR(2),o[0],0,0,0), C1,0); \
    KRD(GL,3); GAPB(o[1]=__builtin_amdgcn_mfma_f32_32x32x16_bf16(PAF(2),VFR(6),o[1],0,0,0), C1,4); \
    GAPB(o[0]=__builtin_amdgcn_mfma_f32_32x32x16_bf16(PAF(3),VFR(3),o[0],0,0,0), C1,8); \
    GAPB(o[1]=__builtin_amdgcn_mfma_f32_32x32x16_bf16(PAF(3),VFR(7),o[1],0,0,0), C1,12); \
    }while(0)
  int t=1;
  #undef CMASK
  #define CMASK(P0,P1,t) do{}while(0)
  for(;t+5<NT;t+=2){
    STEP(pB0,pB1,pA0,pA1,t,true,true,true);     WAIT_BAR(2); RESC(); ROT();
    STEP(pA0,pA1,pB0,pB1,t+1,true,true,true);   WAIT_BAR(2); RESC(); ROT();
  }
  #undef CMASK
  #define CMASK(P0,P1,t) do{}while(0)
  #define ENDW(tt) do{ if((tt)+3<NT){WAIT_BAR(2);} else if((tt)+2<NT){WAIT_BAR(1);} else {WAIT_BAR(0);} }while(0)
  for(;t+1<NT;t+=2){
    STEP(pB0,pB1,pA0,pA1,t,(t+3<NT),(t+1<NT),(t+1<NT));       ENDW(t);   RESC(); ROT();
    STEP(pA0,pA1,pB0,pB1,t+1,(t+4<NT),(t+2<NT),(t+2<NT));     ENDW(t+1); RESC(); ROT();
  }
  STEP(pB0,pB1,pA0,pA1,NT-1,false,false,false); RESC();
  { float sacc=pB0[0]+pB0[1]; _Pragma("unroll") for(int r=2;r<16;++r)sacc+=pB0[r]; _Pragma("unroll") for(int r=0;r<16;++r)sacc+=pB1[r]; l_reg+=sacc;
    pw0=(u32x4){PKW(pB0,0),PKW(pB0,2),PKW(pB0,4),PKW(pB0,6)};pw1=(u32x4){PKW(pB0,8),PKW(pB0,10),PKW(pB0,12),PKW(pB0,14)};pw2=(u32x4){PKW(pB1,0),PKW(pB1,2),PKW(pB1,4),PKW(pB1,6)};pw3=(u32x4){PKW(pB1,8),PKW(pB1,10),PKW(pB1,12),PKW(pB1,14)};
    SBAR(); pv(o,vb0+sl_cur,PAF(0),PAF(1),PAF(2),PAF(3)); }
  #undef PKW
  #undef PAF
  #undef VFR
  #undef PIN
  #undef MX3
  #undef GAPA
  #undef GAPB
  #undef EX
  #undef VRD
  #undef KRD
  #undef STEP
  #undef ENDW
  {auto rr=__builtin_amdgcn_permlane32_swap(__float_as_uint(l_reg),__float_as_uint(l_reg),false,false);l_reg=__uint_as_float(rr[0])+__uint_as_float(rr[1]);}
  if(hi==0)wsf[32+r32]=l_reg;asm volatile("s_waitcnt lgkmcnt(0)":::"memory");
  float rli[16];
  #pragma unroll
  for(int r=0;r<16;++r)rli[r]=__builtin_amdgcn_rcpf(wsf[32+crow(r,hi)]);
  bf16*Ow=Ou+(long)(wid*QBLK)*op;
  { bf16*stg=(bf16*)(shm+LDS_OST)+wid*2048;
    #pragma unroll
    for(int r=0;r<16;++r){const int orow=crow(r,hi);
      #pragma unroll
      for(int d0=0;d0<2;++d0)stg[orow*64+d0*32+r32]=__float2bfloat16(o[d0][r]*rli[r]);}
    asm volatile("s_waitcnt lgkmcnt(0)":::"memory");
    #pragma unroll
    for(int i=0;i<4;++i){const int row=i*8+(lane>>3),ch=lane&7; const u32x4 v=*(const u32x4*)(stg+row*64+ch*8); ATTN_STORE16(Ow+(long)row*op+ch*8,v);} }
  asm volatile("s_waitcnt lgkmcnt(0)\n\ts_barrier":::"memory");
  #undef DMA_K
  #undef DMA_V
  #undef CMASK
  #undef START
  #undef RESC
  #undef ROT
}

__device__ __forceinline__ void attn_unit2(const bf16*Qu,int qp,const bf16*__restrict__ Kh,int kp,const bf16*__restrict__ Vh,int vp,bf16*Ou,int op,int NT,char*shm,int tid_in){
  int tid_=tid_in; asm volatile("":"+v"(tid_));
  const int tid=tid_,lane=tid&63,r32=lane&31,hi=lane>>5; const int wid=__builtin_amdgcn_readfirstlane(tid>>6);
  const bf16*Qw=Qu+(long)(wid*64)*qp;
  const unsigned lds0=(unsigned)(uintptr_t)shm;
  float*wsf=(float*)(shm+LDS_WS)+wid*64;
  const bf16*ksrc=Kh+(long)lane*kp+wid*8;
  const bf16*vsrc=Vh+(long)(16*(wid&3)+(lane>>2))*vp+(wid>>2)*32+(lane&3)*8;
  const unsigned kdst=lds0+LDS_K+wid*1024, vdst=lds0+LDS_V+wid*1024;
  #define DMA_K(t,slot) glds16(ksrc+(long)(t)*KVBLK*kp,(unsigned)__builtin_amdgcn_readfirstlane(kdst+(slot)))
  #define DMA_V(t,slot) glds16(vsrc+(long)(t)*KVBLK*vp,(unsigned)__builtin_amdgcn_readfirstlane(vdst+(slot)))
  const lds_cptr shm3=(lds_cptr)shm; const lds_cptr kp0=shm3+LDS_K+hi*1024+r32*16; const lds_cptr vp0=shm3+LDS_V+((lane>>4)&1)*32+(lane&3)*8+(4*hi+((lane&15)>>2))*64;
  DMA_K(0,0);DMA_V(0,0);DMA_K(1,SLOTB);DMA_V(1,SLOTB);
  bf16x8 qa[4],qb[4];
  #pragma unroll
  for(int d0=0;d0<4;++d0){qa[d0]=*reinterpret_cast<const bf16x8*>(&Qw[(long)r32*qp+d0*16+hi*8]);qb[d0]=*reinterpret_cast<const bf16x8*>(&Qw[(long)(32+r32)*qp+d0*16+hi*8]);}
  float la=0.f,lb=0.f; f32x16 oa[2],ob[2]; oa[0]=f32x16{};oa[1]=f32x16{};ob[0]=f32x16{};ob[1]=f32x16{};
  asm volatile("s_waitcnt vmcnt(0) lgkmcnt(0)\n\ts_barrier":::"memory");
  int sl_cur=0,sl_n2=2*SLOTB;
  for(int t=0;t<NT;++t){
    if(t>0){ if(t+1<NT) asm volatile("s_waitcnt vmcnt(2) lgkmcnt(0)\n\ts_barrier":::"memory"); else asm volatile("s_waitcnt vmcnt(0) lgkmcnt(0)\n\ts_barrier":::"memory"); }
    if(t+2<NT){DMA_K(t+2,sl_n2);DMA_V(t+2,sl_n2);}
    f32x16 a0,a1,b0,b1; const f32x16 z16=f32x16{};
    bf16x8 kf[8]; kload8(kf,kp0+sl_cur);
    #pragma unroll
    for(int d0=0;d0<4;++d0){ a0=__builtin_amdgcn_mfma_f32_32x32x16_bf16(kf[2*d0],qa[d0],d0==0?z16:a0,0,0,0); a1=__builtin_amdgcn_mfma_f32_32x32x16_bf16(kf[2*d0+1],qa[d0],d0==0?z16:a1,0,0,0); }
    SBAR();
    #define X4(P,B) do{ P[B]=__builtin_amdgcn_exp2f(P[B]); P[B+1]=__builtin_amdgcn_exp2f(P[B+1]); P[B+2]=__builtin_amdgcn_exp2f(P[B+2]); P[B+3]=__builtin_amdgcn_exp2f(P[B+3]); asm volatile("":"+v"(P)); SBAR(); }while(0)
    b0=__builtin_amdgcn_mfma_f32_32x32x16_bf16(kf[0],qb[0],z16,0,0,0); X4(a0,0);
    b1=__builtin_amdgcn_mfma_f32_32x32x16_bf16(kf[1],qb[0],z16,0,0,0); X4(a0,4);
    b0=__builtin_amdgcn_mfma_f32_32x32x16_bf16(kf[2],qb[1],b0,0,0,0);  X4(a0,8);
    b1=__builtin_amdgcn_mfma_f32_32x32x16_bf16(kf[3],qb[1],b1,0,0,0);  X4(a0,12);
    b0=__builtin_amdgcn_mfma_f32_32x32x16_bf16(kf[4],qb[2],b0,0,0,0);  X4(a1,0);
    b1=__builtin_amdgcn_mfma_f32_32x32x16_bf16(kf[5],qb[2],b1,0,0,0);  X4(a1,4);
    b0=__builtin_amdgcn_mfma_f32_32x32x16_bf16(kf[6],qb[3],b0,0,0,0);  X4(a1,8);
    b1=__builtin_amdgcn_mfma_f32_32x32x16_bf16(kf[7],qb[3],b1,0,0,0);  X4(a1,12);
    const lds_cptr vq=vp0+sl_cur; s16x4 vlo[8],vhi[8];
    #pragma unroll
    for(int i=0;i<8;++i){ vlo[i]=vtr(vq+((i>>2)*4096+(i&3)*1024)); vhi[i]=vtr(vq+((i>>2)*4096+(i&3)*1024+512)); }
    #define VF(i) (bf16x8){vlo[i][0],vlo[i][1],vlo[i][2],vlo[i][3],vhi[i][0],vhi[i][1],vhi[i][2],vhi[i][3]}
    float sa=0.f,sb=0.f;
    #pragma unroll
    for(int r=0;r<16;++r) sa+=a0[r]+a1[r];
    u32x4 pa[4],pb[4];
    pa[0]=(u32x4){cvtpk_s(a0[0],a0[1]),cvtpk_s(a0[2],a0[3]),cvtpk_s(a0[4],a0[5]),cvtpk_s(a0[6],a0[7])}; pa[1]=(u32x4){cvtpk_s(a0[8],a0[9]),cvtpk_s(a0[10],a0[11]),cvtpk_s(a0[12],a0[13]),cvtpk_s(a0[14],a0[15])};
    pa[2]=(u32x4){cvtpk_s(a1[0],a1[1]),cvtpk_s(a1[2],a1[3]),cvtpk_s(a1[4],a1[5]),cvtpk_s(a1[6],a1[7])}; pa[3]=(u32x4){cvtpk_s(a1[8],a1[9]),cvtpk_s(a1[10],a1[11]),cvtpk_s(a1[12],a1[13]),cvtpk_s(a1[14],a1[15])};
    SBAR();
    #define PVA(ks,d0) oa[d0]=__builtin_amdgcn_mfma_f32_32x32x16_bf16(__builtin_bit_cast(bf16x8,pa[ks]),VF((ks)+4*(d0)),oa[d0],0,0,0)
    #define PVB(ks,d0) ob[d0]=__builtin_amdgcn_mfma_f32_32x32x16_bf16(__builtin_bit_cast(bf16x8,pb[ks]),VF((ks)+4*(d0)),ob[d0],0,0,0)
    PVA(0,0); X4(b0,0); PVA(0,1); X4(b0,4); PVA(1,0); X4(b0,8); PVA(1,1); X4(b0,12);
    PVA(2,0); X4(b1,0); PVA(2,1); X4(b1,4); PVA(3,0); X4(b1,8); PVA(3,1); X4(b1,12);
    #pragma unroll
    for(int r=0;r<16;++r) sb+=b0[r]+b1[r];
    pb[0]=(u32x4){cvtpk_s(b0[0],b0[1]),cvtpk_s(b0[2],b0[3]),cvtpk_s(b0[4],b0[5]),cvtpk_s(b0[6],b0[7])}; pb[1]=(u32x4){cvtpk_s(b0[8],b0[9]),cvtpk_s(b0[10],b0[11]),cvtpk_s(b0[12],b0[13]),cvtpk_s(b0[14],b0[15])};
    pb[2]=(u32x4){cvtpk_s(b1[0],b1[1]),cvtpk_s(b1[2],b1[3]),cvtpk_s(b1[4],b1[5]),cvtpk_s(b1[6],b1[7])}; pb[3]=(u32x4){cvtpk_s(b1[8],b1[9]),cvtpk_s(b1[10],b1[11]),cvtpk_s(b1[12],b1[13]),cvtpk_s(b1[14],b1[15])};
    la+=sa; lb+=sb;
    SBAR();
    PVB(0,0); PVB(0,1); PVB(1,0); PVB(1,1); PVB(2,0); PVB(2,1); PVB(3,0); PVB(3,1);
    SBAR();
    #undef X4
    #undef VF
    #undef PVA
    #undef PVB
    sl_cur=(sl_cur==2*SLOTB)?0:sl_cur+SLOTB; sl_n2=(sl_n2==2*SLOTB)?0:sl_n2+SLOTB;
  }
  bf16*stg=(bf16*)(shm+LDS_OST)+wid*2048;
  #pragma unroll
  for(int blk=0;blk<2;++blk){ float l_reg=blk?lb:la; const f32x16 o0=blk?ob[0]:oa[0], o1=blk?ob[1]:oa[1];
    {auto rr=__builtin_amdgcn_permlane32_swap(__float_as_uint(l_reg),__float_as_uint(l_reg),false,false);l_reg=__uint_as_float(rr[0])+__uint_as_float(rr[1]);}
    if(hi==0)wsf[32+r32]=l_reg;asm volatile("s_waitcnt lgkmcnt(0)":::"memory");
    float rli[16];
    #pragma unroll
    for(int r=0;r<16;++r)rli[r]=__builtin_amdgcn_rcpf(wsf[32+crow(r,hi)]);
    #pragma unroll
    for(int r=0;r<16;++r){const int orow=crow(r,hi); stg[orow*64+r32]=__float2bfloat16(o0[r]*rli[r]); stg[orow*64+32+r32]=__float2bfloat16(o1[r]*rli[r]);}
    asm volatile("s_waitcnt lgkmcnt(0)":::"memory");
    bf16*Ow=Ou+(long)(wid*64+blk*32)*op;
    #pragma unroll
    for(int i=0;i<4;++i){const int row=i*8+(lane>>3),ch=lane&7; const u32x4 v=*(const u32x4*)(stg+row*64+ch*8); ATTN_STORE16(Ow+(long)row*op+ch*8,v);}
    asm volatile("s_waitcnt lgkmcnt(0)":::"memory"); }
  asm volatile("s_waitcnt lgkmcnt(0)\n\ts_barrier":::"memory");
  #undef DMA_K
  #undef DMA_V
}
constexpr int V2_LDS_K=0, V2_LDS_V=3*8192, V2_LDS_WS=V2_LDS_V+3*16384, V2_LDS_OST=V2_LDS_WS+NW*64*4, V2_LDS_BYTES=V2_LDS_OST+NW*4096;
__device__ __forceinline__ void qkt0(f32x16&p0,f32x16&p1,const char*Kslot,const bf16x8*qr,int r32,int hi){
  const char*kb=Kslot+hi*1024+r32*16; const f32x16 z=f32x16{};
  #pragma unroll
  for(int d0=0;d0<4;++d0){
    const bf16x8 b0=*reinterpret_cast<const bf16x8*>(kb+d0*2048);
    const bf16x8 b1=*reinterpret_cast<const bf16x8*>(kb+d0*2048+512);
    if(d0==0){p0=__builtin_amdgcn_mfma_f32_32x32x16_bf16(b0,qr[0],z,0,0,0);p1=__builtin_amdgcn_mfma_f32_32x32x16_bf16(b1,qr[0],z,0,0,0);}
    else{p0=__builtin_amdgcn_mfma_f32_32x32x16_bf16(b0,qr[d0],p0,0,0,0);p1=__builtin_amdgcn_mfma_f32_32x32x16_bf16(b1,qr[d0],p1,0,0,0);}}
}
__device__ __forceinline__ void pv4(f32x16*o,int vb,bf16x8 pa0,bf16x8 pa1,bf16x8 pa2,bf16x8 pa3){
  #pragma unroll
  for(int d0=0;d0<4;++d0){s16x4 lo[4],hi[4];
    #pragma unroll
    for(int ks=0;ks<4;++ks){
      asm volatile("ds_read_b64_tr_b16 %0,%1 offset:%c2":"=&v"(lo[ks]):"v"(vb),"i"(d0*4096+ks*1024):"memory");
      asm volatile("ds_read_b64_tr_b16 %0,%1 offset:%c2":"=&v"(hi[ks]):"v"(vb),"i"(d0*4096+ks*1024+512):"memory");}
    asm volatile("s_waitcnt lgkmcnt(0)":::"memory");SBAR();
    #define PK(k) (bf16x8){lo[k][0],lo[k][1],lo[k][2],lo[k][3],hi[k][0],hi[k][1],hi[k][2],hi[k][3]}
    o[d0]=__builtin_amdgcn_mfma_f32_32x32x16_bf16(pa0,PK(0),o[d0],0,0,0);
    o[d0]=__builtin_amdgcn_mfma_f32_32x32x16_bf16(pa1,PK(1),o[d0],0,0,0);
    o[d0]=__builtin_amdgcn_mfma_f32_32x32x16_bf16(pa2,PK(2),o[d0],0,0,0);
    o[d0]=__builtin_amdgcn_mfma_f32_32x32x16_bf16(pa3,PK(3),o[d0],0,0,0);
    #undef PK
  }
}
template<int THRL,bool NOMAX=false> __device__ __forceinline__ void attn_unit_v128(const bf16*Qu,int qp,const bf16*__restrict__ Kh,int kp,const bf16*__restrict__ Vh,int vp,bf16*Ou,int op,int NT,char*shm,int tid_in){
  int tid_=tid_in; asm volatile("":"+v"(tid_));
  const int tid=tid_,lane=tid&63,r32=lane&31,hi=lane>>5; const int wid=__builtin_amdgcn_readfirstlane(tid>>6);
  const bf16*Qw=Qu+(long)(wid*QBLK)*qp;
  const unsigned lds0=(unsigned)(uintptr_t)shm;
  float*wsf=(float*)(shm+V2_LDS_WS)+wid*64;
  const bf16*ksrc=Kh+(long)lane*kp+wid*8;
  const bf16*vsrc=Vh+(long)(16*(wid&3)+(lane>>2))*vp+(wid>>2)*32+(lane&3)*8;
  const unsigned kdst=lds0+V2_LDS_K+wid*1024, vdst=lds0+V2_LDS_V+wid*1024;
  #define DMA_K(t,slot) glds16(ksrc+(long)(t)*KVBLK*kp,(unsigned)__builtin_amdgcn_readfirstlane(kdst+(slot)))
  #define DMA_V(t,slot) do{ glds16(vsrc+(long)(t)*KVBLK*vp,(unsigned)__builtin_amdgcn_readfirstlane(vdst+2*(slot))); glds16(vsrc+64+(long)(t)*KVBLK*vp,(unsigned)__builtin_amdgcn_readfirstlane(vdst+2*(slot)+8192)); }while(0)
  const int vb0=(int)(lds0+V2_LDS_V)+((lane>>4)&1)*32+(lane&3)*8+(4*hi+((lane&15)>>2))*64;
  const char*Kbase=shm+V2_LDS_K; bf16x8 kf[8];
  const lds_cptr shm3=(lds_cptr)shm; const lds_cptr kp0=shm3+V2_LDS_K+hi*1024+r32*16; const lds_cptr vp0=shm3+V2_LDS_V+((lane>>4)&1)*32+(lane&3)*8+(4*hi+((lane&15)>>2))*64;
  DMA_K(0,0);DMA_V(0,0);DMA_K(1,SLOTB);
  bf16x8 qr[4];
  #pragma unroll
  for(int d0=0;d0<4;++d0)qr[d0]=*reinterpret_cast<const bf16x8*>(&Qw[(long)r32*qp+d0*16+hi*8]);
  float mhat=0.f,l_reg=0.f;f32x16 o[4];o[0]=f32x16{};o[1]=f32x16{};o[2]=f32x16{};o[3]=f32x16{};
  const f32x16 zero16=f32x16{};
  bool resc=false;
  #define START(P0,P1) do{ resc=false; if constexpr(NOMAX){ _Pragma("unroll") for(int r=0;r<16;++r){P0[r]=__builtin_amdgcn_exp2f(P0[r]);} } \
    else { const float rm=rowmax(P0,P1); mhat=rm; _Pragma("unroll") for(int r=0;r<16;++r){P0[r]=__builtin_amdgcn_exp2f(fsub_s(P0[r],mhat));} } }while(0)
  #define RESC() do{ if(resc){ asm volatile("s_waitcnt lgkmcnt(0)":::"memory"); \
      _Pragma("unroll") for(int d_=0;d_<4;++d_) _Pragma("unroll") for(int r=0;r<16;++r)o[d_][r]*=wsf[crow(r,hi)]; } }while(0)
  f32x16 pA0,pA1,pB0,pB1;
  int sl_prev=0,sl_cur=0,sl_next=SLOTB;
  #define ROT() do{sl_prev=sl_cur;sl_cur=sl_next;sl_next=(sl_next==(NSLOT-1)*SLOTB)?0:sl_next+SLOTB;}while(0)
  DMA_K(2,2*SLOTB);
  WAIT_BAR(3);
  qkt0(pA0,pA1,Kbase,qr,r32,hi);asm volatile("s_nop 15\n\ts_nop 7":"+v"(pA0),"+v"(pA1));
  START(pA0,pA1);
  if constexpr(NOMAX){ _Pragma("unroll") for(int r=0;r<16;++r)pA1[r]=__builtin_amdgcn_exp2f(pA1[r]); } else { _Pragma("unroll") for(int r=0;r<16;++r)pA1[r]=__builtin_amdgcn_exp2f(fsub_s(pA1[r],mhat)); }
  WAIT_BAR(0);
  DMA_K(3,0);DMA_V(1,SLOTB);
  ROT();
  kload8(kf,kp0+sl_cur);
  WAIT_BAR(3);
  s16x4 vwl[5],vwh[5]; u32x4 pw0,pw1,pw2,pw3;
  #define PKW(P,B) cvtpk_s(P[B],P[B+1])
  #define PAF(k) __builtin_bit_cast(bf16x8,pw##k)
  #define VWF(s) (bf16x8){vwl[s][0],vwl[s][1],vwl[s][2],vwl[s][3],vwh[s][0],vwh[s][1],vwh[s][2],vwh[s][3]}
  #define PIN(x) asm volatile("":"+v"(x))
  #define MX3(a,b,c) __builtin_fmaxf(__builtin_fmaxf((a),(b)),(c))
  #define GAPA(MF,A0,A1,A2,A3,W0,W1,PW) do{ MF; sacc+=A0; sacc+=A1; sacc+=A2; sacc+=A3; PIN(sacc); W0; W1; PIN(PW); SBAR(); }while(0)
  #define EXS(v) (NOMAX?__builtin_amdgcn_exp2f(v):__builtin_amdgcn_exp2f((v)-mhat))
  #define GAPB(MF,X,B) do{ MF; X[B]=EXS(X[B]); X[B+1]=EXS(X[B+1]); PIN(X); SBAR(); }while(0)
  #define VRD(f,s) do{ vwl[s]=vtr(vp_+(((f)>>2)*4096+((f)&3)*1024)); vwh[s]=vtr(vp_+(((f)>>2)*4096+((f)&3)*1024+512)); }while(0)
  #define KRD(G,j) do{ if(G){ kload2(kf,kp0+sl_next,j); SBAR(); } }while(0)
  #define PVM(i) o[(i)&3]=__builtin_amdgcn_mfma_f32_32x32x16_bf16(PAF_SEL((i)>>2),VWF((i)%5),o[(i)&3],0,0,0)
  #define PAF_SEL(k) ((k)==0?PAF(0):(k)==1?PAF(1):(k)==2?PAF(2):PAF(3))
  #define VNEXT(i) do{ if((i)+5<16){ VRD((((i)+5)>>2)+4*(((i)+5)&3),(i)%5); SBAR(); } }while(0)
  #define STEP(C0,C1,P0,P1,t,GK,GV,GL) do{ SBAR(); \
    const lds_cptr vp_=vp0+2*sl_prev; \
    float sacc=(P0[0]+P0[1]); \
    GAPA(C0=__builtin_amdgcn_mfma_f32_32x32x16_bf16(kf[0],qr[0],zero16,0,0,0), P0[2],P0[3],P0[4],P0[5],     pw0[0]=PKW(P0,0), pw0[1]=PKW(P0,2), pw0); \
    GAPA(C1=__builtin_amdgcn_mfma_f32_32x32x16_bf16(kf[1],qr[0],zero16,0,0,0), P0[6],P0[7],P0[8],P0[9],     pw0[2]=PKW(P0,4), pw0[3]=PKW(P0,6), pw0); \
    GAPA(C0=__builtin_amdgcn_mfma_f32_32x32x16_bf16(kf[2],qr[1],C0,0,0,0),   P0[10],P0[11],P0[12],P0[13], pw1[0]=PKW(P0,8), pw1[1]=PKW(P0,10), pw1); \
    VRD(0,0); SBAR(); GAPA(C1=__builtin_amdgcn_mfma_f32_32x32x16_bf16(kf[3],qr[1],C1,0,0,0),   P0[14],P0[15],P1[0],P1[1],   pw1[2]=PKW(P0,12),pw1[3]=PKW(P0,14), pw1); \
    VRD(4,1); SBAR(); GAPA(C0=__builtin_amdgcn_mfma_f32_32x32x16_bf16(kf[4],qr[2],C0,0,0,0),   P1[2],P1[3],P1[4],P1[5],     pw2[0]=PKW(P1,0), pw2[1]=PKW(P1,2), pw2); \
    VRD(8,2); SBAR(); GAPA(C1=__builtin_amdgcn_mfma_f32_32x32x16_bf16(kf[5],qr[2],C1,0,0,0),   P1[6],P1[7],P1[8],P1[9],     pw2[2]=PKW(P1,4), pw2[3]=PKW(P1,6), pw2); \
    VRD(12,3); SBAR(); GAPA(C0=__builtin_amdgcn_mfma_f32_32x32x16_bf16(kf[6],qr[3],C0,0,0,0),   P1[10],P1[11],P1[12],P1[13], pw3[0]=PKW(P1,8), pw3[1]=PKW(P1,10), pw3); \
    VRD(1,4); SBAR(); GAPA(C1=__builtin_amdgcn_mfma_f32_32x32x16_bf16(kf[7],qr[3],C1,0,0,0),   P1[14],P1[15],0.f,0.f,       pw3[2]=PKW(P1,12),pw3[3]=PKW(P1,14), pw3); \
    l_reg+=sacc; \
    if(GK){DMA_K((t)+3,sl_cur);} if(GV){DMA_V((t)+1,sl_next);} \
    if constexpr(!NOMAX){ float a=MX3(C0[0],C0[1],C1[0]),b=MX3(C0[2],C0[3],C1[1]); a=MX3(a,C1[2],C1[3]); \
      _Pragma("unroll") for(int r=4;r<16;r+=4){a=MX3(a,C0[r],C0[r+1]);b=MX3(b,C0[r+2],C0[r+3]);a=MX3(a,C1[r],C1[r+1]);b=MX3(b,C1[r+2],C1[r+3]);} \
      float rm=__builtin_fmaxf(a,b); { auto rr=__builtin_amdgcn_permlane32_swap(__float_as_uint(rm),__float_as_uint(rm),false,false); rm=__builtin_fmaxf(__uint_as_float(rr[0]),__uint_as_float(rr[1])); } \
      resc=false; const float rel=rm-mhat; \
      if(__builtin_expect(__any(rel>(float)THRL),0)){ const float dl=__builtin_fmaxf(rel,0.f); mhat+=dl; \
        const float f=__builtin_amdgcn_exp2f(-dl); l_reg*=f; if(hi==0)wsf[r32]=f; resc=true; } } \
    SBAR(); \
    GAPB(PVM(0),C0,0);  VNEXT(0); \
    GAPB(PVM(1),C0,2);  VNEXT(1); \
    GAPB(PVM(2),C0,4);  VNEXT(2); \
    GAPB(PVM(3),C0,6);  VNEXT(3); \
    KRD(GL,0); GAPB(PVM(4),C0,8);  VNEXT(4); \
    GAPB(PVM(5),C0,10); VNEXT(5); \
    GAPB(PVM(6),C0,12); VNEXT(6); \
    KRD(GL,1); GAPB(PVM(7),C0,14); VNEXT(7); \
    GAPB(PVM(8),C1,0);  VNEXT(8); \
    GAPB(PVM(9),C1,2);  VNEXT(9); \
    KRD(GL,2); GAPB(PVM(10),C1,4); VNEXT(10); \
    GAPB(PVM(11),C1,6); \
    GAPB(PVM(12),C1,8); \
    KRD(GL,3); GAPB(PVM(13),C1,10); \
    GAPB(PVM(14),C1,12); \
    GAPB(PVM(15),C1,14); \
    }while(0)
  int t=1;
  for(;t+5<NT;t+=2){
    STEP(pB0,pB1,pA0,pA1,t,true,true,true);     WAIT_BAR(3); RESC(); ROT();
    STEP(pA0,pA1,pB0,pB1,t+1,true,true,true);   WAIT_BAR(3); RESC(); ROT();
  }
  #define ENDW(tt) do{ if((tt)+3<NT){WAIT_BAR(3);} else if((tt)+2<NT){WAIT_BAR(2);} else {WAIT_BAR(0);} }while(0)
  for(;t+1<NT;t+=2){
    STEP(pB0,pB1,pA0,pA1,t,(t+3<NT),(t+1<NT),(t+1<NT));       ENDW(t);   RESC(); ROT();
    STEP(pA0,pA1,pB0,pB1,t+1,(t+4<NT),(t+2<NT),(t+2<NT));     ENDW(t+1); RESC(); ROT();
  }
  STEP(pB0,pB1,pA0,pA1,NT-1,false,false,false); RESC();
  { float sacc=pB0[0]+pB0[1]; _Pragma("unroll") for(int r=2;r<16;++r)sacc+=pB0[r]; _Pragma("unroll") for(int r=0;r<16;++r)sacc+=pB1[r]; l_reg+=sacc;
    pw0=(u32x4){PKW(pB0,0),PKW(pB0,2),PKW(pB0,4),PKW(pB0,6)};pw1=(u32x4){PKW(pB0,8),PKW(pB0,10),PKW(pB0,12),PKW(pB0,14)};pw2=(u32x4){PKW(pB1,0),PKW(pB1,2),PKW(pB1,4),PKW(pB1,6)};pw3=(u32x4){PKW(pB1,8),PKW(pB1,10),PKW(pB1,12),PKW(pB1,14)};
    SBAR(); pv4(o,vb0+2*sl_cur,PAF(0),PAF(1),PAF(2),PAF(3)); }
  #undef PKW
  #undef PAF
  #undef VWF
  #undef PIN
  #undef MX3
  #undef GAPA
  #undef GAPB
  #undef EXS
  #undef VRD
  #undef KRD
  #undef PVM
  #undef PAF_SEL
  #undef VNEXT
  #undef STEP
  #undef ENDW
  {auto rr=__builtin_amdgcn_permlane32_swap(__float_as_uint(l_reg),__float_as_uint(l_reg),false,false);l_reg=__uint_as_float(rr[0])+__uint_as_float(rr[1]);}
  if(hi==0)wsf[32+r32]=l_reg;asm volatile("s_waitcnt lgkmcnt(0)":::"memory");
  float rli[16];
  #pragma unroll
  for(int r=0;r<16;++r)rli[r]=__builtin_amdgcn_rcpf(wsf[32+crow(r,hi)]);
  bf16*Ow=Ou+(long)(wid*QBLK)*op;
  { bf16*stg=(bf16*)(shm+V2_LDS_OST)+wid*2048;
    #pragma unroll
    for(int rd=0;rd<2;++rd){
      #pragma unroll
      for(int r=0;r<16;++r){const int orow=crow(r,hi);
        #pragma unroll
        for(int d0=0;d0<2;++d0)stg[orow*64+d0*32+r32]=__float2bfloat16(o[2*rd+d0][r]*rli[r]);}
      asm volatile("s_waitcnt lgkmcnt(0)":::"memory");
      #pragma unroll
      for(int i=0;i<4;++i){const int row=i*8+(lane>>3),ch=lane&7; const u32x4 v=*(const u32x4*)(stg+row*64+ch*8); ATTN_STORE16(Ow+(long)row*op+rd*64+ch*8,v);}
      asm volatile("s_waitcnt lgkmcnt(0)":::"memory"); } }
  asm volatile("s_waitcnt lgkmcnt(0)\n\ts_barrier":::"memory");
  #undef DMA_K
  #undef DMA_V
  #undef START
  #undef RESC
  #undef ROT
}
#undef SBAR
#undef WAIT_BAR
}
#define XB_TMO      128
#define XB_XCNT(j)  (256  + 64 * (j))
#define XB_XSUB(j)  (1280 + 64 * (j))
#define XB_XGEN(j)  (2304 + 64 * (j))
#define XB_TOP      3328
#define XB_TOPGEN   3392
#define XCD_BAR_WORDS 3456
#define XB_SPIN_CAP (1u << 18)

__device__ __forceinline__ unsigned xb_ld(unsigned* p)              { return __hip_atomic_load(p, __ATOMIC_RELAXED, __HIP_MEMORY_SCOPE_AGENT); }
__device__ __forceinline__ unsigned xb_add(unsigned* p, unsigned v) { return __hip_atomic_fetch_add(p, v, __ATOMIC_RELAXED, __HIP_MEMORY_SCOPE_AGENT); }
__device__ __forceinline__ unsigned xb_xcc_id() { return (unsigned)__builtin_amdgcn_s_getreg((3 << 11) | 20) & 0xFu; }
#define XB_SPIN(cond, bar) do { unsigned _sp = 0; while (cond) { __builtin_amdgcn_s_sleep(1); \
    if ((++_sp & 255u) == 0u) { if (xb_ld(&(bar)[XB_TMO])) break; if (_sp > XB_SPIN_CAP) { atomicAdd(&(bar)[XB_TMO], 1u); break; } } } } while (0)

struct XcdBarrier {
    unsigned* bar; unsigned x;
    volatile LAS unsigned* st;
};

__device__ __forceinline__ XcdBarrier xcd_barrier_post(unsigned* bar, volatile LAS unsigned* st, int tid) {
    XcdBarrier b; b.bar = bar; b.x = xb_xcc_id(); b.st = st;
    if (tid == 0) (void)xb_add(&bar[XB_XCNT(b.x)], 1u);
    return b;
}
__device__ __forceinline__ void xcd_barrier_complete(unsigned* bar, unsigned x, unsigned& nloc, unsigned& nx) {
    const unsigned G = gridDim.x * gridDim.y * gridDim.z;
    unsigned sum, cnt, mine, sp = 0u;
    for (;;) {
        sum = 0u; cnt = 0u; mine = 0u;
#pragma unroll
        for (unsigned j = 0; j < 16; ++j) { const unsigned c = xb_ld(&bar[XB_XCNT(j)]); sum += c; cnt += (c > 0u) ? 1u : 0u; mine = (j == x) ? c : mine; }
        if (sum == G) break;
        __builtin_amdgcn_s_sleep(1);
        if ((++sp & 255u) == 0u) { if (xb_ld(&bar[XB_TMO])) break; if (sp > XB_SPIN_CAP) { atomicAdd(&bar[XB_TMO], 1u); break; } }
    }
    nloc = mine > 0u ? mine : 1u; nx = cnt > 0u ? cnt : 1u;
}

__device__ __forceinline__ void xcd_barrier(const XcdBarrier& b, int tid) {
    asm volatile("s_waitcnt vmcnt(0)" ::: "memory");
    __syncthreads();
    if (tid == 0) {
        unsigned* bar = b.bar;
        __builtin_amdgcn_s_waitcnt(0);
        unsigned nloc = b.st[0], nx = b.st[1];
        if (nloc == 0u) { xcd_barrier_complete(bar, b.x, nloc, nx); b.st[0] = nloc; b.st[1] = nx; }
        const unsigned old = xb_add(&bar[XB_XSUB(b.x)], 1u);
        const unsigned gen = old / nloc;
        if (old + 1u == (gen + 1u) * nloc) {
            __builtin_amdgcn_fence(__ATOMIC_RELEASE, "agent");
            asm volatile("s_waitcnt vmcnt(0)" ::: "memory");
            const unsigned og = xb_add(&bar[XB_TOP], 1u);
            const unsigned tg = og / nx;
            if (og + 1u == (tg + 1u) * nx) xb_add(&bar[XB_TOPGEN], 1u);
            else XB_SPIN(xb_ld(&bar[XB_TOPGEN]) == tg, bar);
            __builtin_amdgcn_fence(__ATOMIC_ACQUIRE, "agent");
            xb_add(&bar[XB_XGEN(b.x)], 1u);
            asm volatile("s_waitcnt vmcnt(0)" ::: "memory");
        } else {
            XB_SPIN(xb_ld(&bar[XB_XGEN(b.x)]) == gen, bar);
            __builtin_amdgcn_fence(__ATOMIC_ACQUIRE, "agent");
            asm volatile("s_waitcnt vmcnt(0)" ::: "memory");
        }
    }
    __syncthreads();
}

struct Ctx { LAS unsigned char* lds; int tid, lane, wave, G, vcu; unsigned char* ws; };
struct Args { const float* in[28]; float* out; unsigned char* ws; int ph_lo, ph_hi, rep_mask, pad; };
typedef const __attribute__((address_space(4))) Args* CArgs;
__device__ __forceinline__ const float* inp(CArgs a, int i) { return (const float*)(GAS const float*)a->in[i]; }
enum { I_X = 0, I_C, I_CTX, I_CCTX, I_WADA, I_BADA, I_WIN, I_AQN, I_AKN, I_CONVW, I_CONVB, I_LWA, I_LBA, I_LWX, I_LBX, I_LLAM, I_DLAM, I_DSUB, I_WBR, I_WOUT, I_LN1G, I_LN1B, I_WR, I_WG, I_WU, I_WDN, I_LN2G, I_LN2B };

__device__ __forceinline__ void tr_item64(const float* W, int ldw, int k0, int n0, bf16* dst0, bf16* dst1, int pitch, LAS bf16* scr, int lane, bool permd = false) {
    f32x4 v[16];
    const float* src = W + (size_t)(k0 + (lane >> 4)) * ldw + n0 + 4 * (lane & 15);
#pragma unroll
    for (int i = 0; i < 16; ++i) v[i] = *(const f32x4*)(src + (size_t)(4 * i) * ldw);
#pragma unroll
    for (int i = 0; i < 16; ++i) { const unsigned p0 = cvt_pk_bf16(v[i][0], v[i][1]), p1 = cvt_pk_bf16(v[i][2], v[i][3]);
        LAS unsigned* q = (LAS unsigned*)(scr + (4 * i + (lane >> 4)) * 66 + 4 * (lane & 15)); q[0] = p0; q[1] = p1; }
    LDS_WAIT(); asm volatile("" ::: "memory");
    const int c = lane & 7;
#pragma unroll
    for (int j = 0; j < 8; ++j) { const int n = (lane >> 3) + 8 * j; const LAS bf16* t = scr + (8 * c) * 66 + n;
        v4u o; o.x = (unsigned)t[0] | ((unsigned)t[66] << 16); o.y = (unsigned)t[2 * 66] | ((unsigned)t[3 * 66] << 16);
        o.z = (unsigned)t[4 * 66] | ((unsigned)t[5 * 66] << 16); o.w = (unsigned)t[6 * 66] | ((unsigned)t[7 * 66] << 16);
        const int nl = n & 31, nr = permd ? (16 * ((nl >> 2) & 1) + 4 * (nl >> 3) + (nl & 3)) : nl;
        bf16* d = ((j < 4) ? dst0 : dst1) + (size_t)nr * pitch;
        *(GAS v4u*)(d + 8 * c) = o; }
    LDS_WAIT(); asm volatile("" ::: "memory");
}

__device__ __forceinline__ void tr_item64_f8(const float* W, int ldw, int k0, int n0, unsigned char* dst0, unsigned char* dst1, int pitch, float scale, LAS bf16* scr, int lane, bool permd = false) {
    f32x4 v[16];
    const float* src = W + (size_t)(k0 + (lane >> 4)) * ldw + n0 + 4 * (lane & 15);
#pragma unroll
    for (int i = 0; i < 16; ++i) v[i] = *(const f32x4*)(src + (size_t)(4 * i) * ldw);
#pragma unroll
    for (int i = 0; i < 16; ++i) { const unsigned p0 = cvt_pk_bf16(v[i][0], v[i][1]), p1 = cvt_pk_bf16(v[i][2], v[i][3]);
        LAS unsigned* q = (LAS unsigned*)(scr + (4 * i + (lane >> 4)) * 66 + 4 * (lane & 15)); q[0] = p0; q[1] = p1; }
    LDS_WAIT(); asm volatile("" ::: "memory");
    const int c = lane & 3;
#pragma unroll
    for (int j = 0; j < 4; ++j) { const int n = (lane >> 2) + 16 * j; const LAS bf16* t = scr + (16 * c) * 66 + n;
        float f[16];
#pragma unroll
        for (int q = 0; q < 16; ++q) f[q] = __uint_as_float((unsigned)t[q * 66] << 16) * scale;
        v4u o; o.x = pg8::pk_fp8x4(f[0], f[1], f[2], f[3]); o.y = pg8::pk_fp8x4(f[4], f[5], f[6], f[7]); o.z = pg8::pk_fp8x4(f[8], f[9], f[10], f[11]); o.w = pg8::pk_fp8x4(f[12], f[13], f[14], f[15]);
        const int nl8 = n & 31, nr8 = permd ? (16 * ((nl8 >> 2) & 1) + 4 * (nl8 >> 3) + (nl8 & 3)) : nl8;
        unsigned char* d = ((j < 2) ? dst0 : dst1) + (size_t)nr8 * pitch;
        *(GAS v4u*)(d + 16 * c) = o; }
    LDS_WAIT(); asm volatile("" ::: "memory");
}

struct CvItem { const float* src; unsigned voff; int ldw; unsigned char* d0; unsigned char* d1; int pitch; float scale; };
__device__ __forceinline__ void cv_load(f32x4 (&v)[16], const CvItem& c) {
#pragma unroll
    for (int i = 0; i < 16; ++i) v[i] = *(const f32x4*)((const char*)uni(c.src + (size_t)(4 * i) * c.ldw) + c.voff);
}
__device__ __forceinline__ void cv_finish(const f32x4 (&v)[16], const CvItem& ci, LAS bf16* scr, int lane) {
#pragma unroll
    for (int i = 0; i < 16; ++i) { const unsigned p0 = cvt_pk_bf16(v[i][0], v[i][1]), p1 = cvt_pk_bf16(v[i][2], v[i][3]);
        LAS unsigned* q = (LAS unsigned*)(scr + (4 * i + (lane >> 4)) * 66 + 4 * (lane & 15)); q[0] = p0; q[1] = p1; }
    LDS_WAIT(); asm volatile("" ::: "memory");
    const int c = lane & 3;
#pragma unroll
    for (int j = 0; j < 4; ++j) { const int n = (lane >> 2) + 16 * j; const LAS bf16* t = scr + (16 * c) * 66 + n;
        float f[16];
#pragma unroll
        for (int q = 0; q < 16; ++q) f[q] = __uint_as_float((unsigned)t[q * 66] << 16) * ci.scale;
        v4u o; o.x = pg8::pk_fp8x4(f[0], f[1], f[2], f[3]); o.y = pg8::pk_fp8x4(f[4], f[5], f[6], f[7]); o.z = pg8::pk_fp8x4(f[8], f[9], f[10], f[11]); o.w = pg8::pk_fp8x4(f[12], f[13], f[14], f[15]);
        unsigned char* d = (j < 2) ? ci.d0 + (size_t)n * ci.pitch : ci.d1 + (size_t)(n - 32) * ci.pitch;
        *(GAS v4u*)(d + 16 * c) = o; }
    LDS_WAIT(); asm volatile("" ::: "memory");
}
__device__ __forceinline__ void cv_pack(const f32x4 (&v)[16], unsigned (&pk)[32]) {
#pragma unroll
    for (int i = 0; i < 16; ++i) { pk[2 * i] = cvt_pk_bf16(v[i][0], v[i][1]); pk[2 * i + 1] = cvt_pk_bf16(v[i][2], v[i][3]); }
}
__device__ __forceinline__ void cv_finish_p(const unsigned (&pk)[32], const CvItem& ci, LAS bf16* scr, int lane) {
#pragma unroll
    for (int i = 0; i < 16; ++i) { LAS unsigned* q = (LAS unsigned*)(scr + (4 * i + (lane >> 4)) * 66 + 4 * (lane & 15)); q[0] = pk[2 * i]; q[1] = pk[2 * i + 1]; }
    LDS_WAIT(); asm volatile("" ::: "memory");
    const int c = lane & 3;
#pragma unroll
    for (int j = 0; j < 4; ++j) { const int n = (lane >> 2) + 16 * j; const LAS bf16* t = scr + (16 * c) * 66 + n;
        float f[16];
#pragma unroll
        for (int q = 0; q < 16; ++q) f[q] = __uint_as_float((unsigned)t[q * 66] << 16) * ci.scale;
        v4u o; o.x = pg8::pk_fp8x4(f[0], f[1], f[2], f[3]); o.y = pg8::pk_fp8x4(f[4], f[5], f[6], f[7]); o.z = pg8::pk_fp8x4(f[8], f[9], f[10], f[11]); o.w = pg8::pk_fp8x4(f[12], f[13], f[14], f[15]);
        unsigned char* d = (j < 2) ? ci.d0 + (size_t)n * ci.pitch : ci.d1 + (size_t)(n - 32) * ci.pitch;
        *(GAS v4u*)(d + 16 * c) = o; }
    LDS_WAIT(); asm volatile("" ::: "memory");
}
__device__ __forceinline__ void cv_pack8(const f32x4 (&v)[16], float scale, unsigned (&P)[4][4]) {
#pragma unroll
    for (int j = 0; j < 4; ++j)
#pragma unroll
        for (int g = 0; g < 4; ++g) P[j][g] = pg8::pk_fp8x4(v[4 * g][j] * scale, v[4 * g + 1][j] * scale, v[4 * g + 2][j] * scale, v[4 * g + 3][j] * scale);
}
__device__ __forceinline__ void cv_store8(const unsigned (&P)[4][4], const CvItem& ci, int lane) {
    const int n = 4 * (lane & 15) + (lane >> 4);
    unsigned char* d = (n < 32) ? ci.d0 + (size_t)n * ci.pitch : ci.d1 + (size_t)(n - 32) * ci.pitch;
#pragma unroll
    for (int g = 0; g < 4; ++g) {
        const auto a = __builtin_amdgcn_permlane16_swap(P[0][g], P[1][g], false, false); const auto b = __builtin_amdgcn_permlane16_swap(P[2][g], P[3][g], false, false);
        const auto c = __builtin_amdgcn_permlane32_swap(a[0], b[0], false, false); const auto e = __builtin_amdgcn_permlane32_swap(a[1], b[1], false, false);
        const unsigned q0 = c[0], q2 = c[1], q1 = e[0], q3 = e[1];
        const unsigned t0 = __builtin_amdgcn_perm(q1, q0, 0x05010400u), t1 = __builtin_amdgcn_perm(q1, q0, 0x07030602u), t2 = __builtin_amdgcn_perm(q3, q2, 0x05010400u), t3 = __builtin_amdgcn_perm(q3, q2, 0x07030602u);
        v4u o; o.x = __builtin_amdgcn_perm(t2, t0, 0x05040100u); o.y = __builtin_amdgcn_perm(t2, t0, 0x07060302u); o.z = __builtin_amdgcn_perm(t3, t1, 0x05040100u); o.w = __builtin_amdgcn_perm(t3, t1, 0x07060302u);
        *(GAS v4u*)(d + 16 * g) = o; }
}
constexpr int CV_ITEMS = 3 * 11008, CV_IN_LRU = 0, CV_IN_ATT = 16;
__device__ __forceinline__ CvItem cv_make(CArgs a, unsigned char* ws, int l, int it, int lane) {
    CvItem c; const int which = it / 11008, r = it % 11008, e = r / 688, q = r % 688;
    if (which < 2) { const int kb = q / 43, nb = q % 43, n0 = nb * 64, k0 = kb * 64;
        const float* W = inp(a, which == 0 ? I_WG : I_WU) + ((size_t)(l * NE + e) * D) * FF;
        const int drow = e * 5632 + (n0 >> 7) * 256 + (n0 & 127) + which * 128; unsigned char* d0 = ws + WS_WGU + (size_t)drow * D + k0;
        c.src = W + (size_t)k0 * FF + n0; c.voff = (unsigned)((lane >> 4) * FF + 4 * (lane & 15)) * 4u; c.ldw = FF; c.d0 = d0; c.d1 = d0 + (size_t)32 * D; c.pitch = D; c.scale = WSC_GU; }
    else { const int kb = q / 16, nb = q % 16, n0 = nb * 64, k0 = kb * 64;
        const float* W = inp(a, I_WDN) + ((size_t)(l * NE + e) * FF) * D; unsigned char* d0 = ws + WS_WD + ((size_t)e * D + n0) * FFP + k0;
        c.src = W + (size_t)k0 * D + n0; c.voff = (unsigned)((lane >> 4) * D + 4 * (lane & 15)) * 4u; c.ldw = D; c.d0 = d0; c.d1 = d0 + (size_t)32 * FFP; c.pitch = FFP; c.scale = WSC_D; }
    return c;
}

__device__ __forceinline__ void ph_prologue(const Ctx& X, CArgs a) {
    float* MOD = (float*)(X.ws + WS_MOD);
    if ((int)blockIdx.x < 384) {
        LAS float* SV = (LAS float*)X.lds;
        LAS float* RED = (LAS float*)(X.lds + 5 * 1024 * 4);
        for (int i = X.tid; i < 5 * 1024; i += 512) { const int v = i >> 10, k = i & 1023; const float cv = v < 4 ? inp(a, I_C)[v * 1024 + k] : inp(a, I_CCTX)[k]; SV[i] = silu_f(cv); }
        __syncthreads();
        for (int it = blockIdx.x; it < 384; it += X.G) {
            const int l = it / 192, n0 = (it % 192) * 32, kg = X.tid >> 5, cn = X.tid & 31;
            const float* W = inp(a, I_WADA) + (size_t)l * 1024 * 6144 + n0 + cn;
            float acc[5] = {0.f, 0.f, 0.f, 0.f, 0.f};
#pragma unroll 16
            for (int k = kg; k < 1024; k += 16) { const float w = W[(size_t)k * 6144];
#pragma unroll
                for (int v = 0; v < 5; ++v) acc[v] += SV[v * 1024 + k] * w; }
#pragma unroll
            for (int v = 0; v < 5; ++v) RED[(kg * 5 + v) * 32 + cn] = acc[v];
            __syncthreads();
            if (X.tid < 160) { const int v = X.tid >> 5; float s = 0.f;
                for (int q = 0; q < 16; ++q) s += RED[(q * 5 + v) * 32 + cn];
                MOD[(l * 5 + v) * 6144 + n0 + cn] = s + inp(a, I_BADA)[l * 6144 + n0 + cn]; }
            __syncthreads();
        }
    }
    LAS bf16* scr = (LAS bf16*)(X.lds + 32768 + X.wave * 8448);
    const int gw = X.vcu * NWAVES + X.wave, NGW = X.G * NWAVES;
    bf16* WIN = (bf16*)(X.ws + WS_WIN); bf16* WBR = (bf16*)(X.ws + WS_WBR); bf16* WOUT = (bf16*)(X.ws + WS_WOUT);
    for (int it = gw; it < 3200 + 768 + 512; it += NGW) {
        if (it < 3200) { const int l = it / 1600, r = it % 1600, kb = r / 100, nb = r % 100, n0 = nb * 64, k0 = kb * 64;
            const int tile = n0 >> 8, wc = (n0 & 255) >> 6, drow = tile * 256 + 32 * wc;
            bf16* d0 = WIN + (size_t)l * DIN * D + (size_t)drow * D + k0;
            if (n0 < 3328) tr_item64(inp(a, I_WIN) + (size_t)l * D * DIN, DIN, k0, n0, d0, d0 + (size_t)128 * D, D, scr, X.lane);
            else { unsigned char* e0 = (unsigned char*)(WIN + (size_t)l * DIN * D + (size_t)3328 * D) + (size_t)(n0 - 3328) * D + k0;
                tr_item64_f8(inp(a, I_WIN) + (size_t)l * D * DIN, DIN, k0, n0, e0, e0 + (size_t)32 * D, D, WSC_GU, scr, X.lane, true); } }
        else if (it < 3200 + 768) { const int q = it - 3200, ln = q / 128, r = q % 128, kb = r / 16, nb = r % 16, n0 = nb * 64, k0 = kb * 64;
            bf16* d0 = WBR + (size_t)ln * 1024 * 512 + (size_t)n0 * 512 + k0;
            tr_item64(inp(a, I_WBR) + (size_t)ln * 512 * 1024, 1024, k0, n0, d0, d0 + (size_t)32 * 512, 512, scr, X.lane); }
        else { const int q = it - 3968, l = q / 256, r = q % 256, kb = r / 16, nb = r % 16, n0 = nb * 64, k0 = kb * 64;
            bf16* d0 = WOUT + (size_t)l * D * D + (size_t)n0 * D + k0;
            tr_item64(inp(a, I_WOUT) + (size_t)l * D * D, D, k0, n0, d0, d0 + (size_t)32 * D, D, scr, X.lane); }
    }
    bf16* LW = (bf16*)(X.ws + WS_LRUW);
    for (int i = gw * 64 + X.lane; i < 2 * 2 * 2 * 8 * 4096; i += NGW * 64) {
        const int k = i & 63, n = (i >> 6) & 63, g = (i >> 12) & 7, gate = (i >> 15) & 1, d = (i >> 16) & 1, l = i >> 17;
        const float* src = gate ? inp(a, I_LWX) : inp(a, I_LWA);
        const float w = src[((((size_t)l * 2 + d) * 8 + g) * 64 + k) * 64 + n];
        LW[i] = (bf16)(cvt_pk_bf16(w, 0.f) & 0xffffu);
    }
}

__device__ __forceinline__ const float* xrow_ptr(CArgs a, unsigned char* ws, int l, int r) {
    if (l == 0) return r < T ? inp(a, I_X) + (size_t)r * D : inp(a, I_CTX) + (size_t)(r - T) * D;
    return (const float*)(ws + WS_X2) + (size_t)r * D;
}
__device__ __forceinline__ const float* mod_ptr(unsigned char* ws, int l, int r) { const int v = r < T ? (r >> 13) : 4; return (const float*)(ws + WS_MOD) + (size_t)(l * 5 + v) * 6144; }

__device__ __forceinline__ void ph_make_xh0(const Ctx& X, CArgs a) {
    const int gw = X.vcu * NWAVES + X.wave, NGW = X.G * NWAVES;
    bf16* XH = (bf16*)(X.ws + WS_SA);
    for (int r0 = gw * 4; r0 < R; r0 += NGW * 4) {
        const float* md = mod_ptr(X.ws, 0, r0);
        f32x4 x[4][4];
#pragma unroll
        for (int q = 0; q < 4; ++q) { const float* xr = xrow_ptr(a, X.ws, 0, r0 + q);
#pragma unroll
            for (int j = 0; j < 4; ++j) x[q][j] = *(const f32x4*)(xr + 4 * X.lane + 256 * j); }
#pragma unroll
        for (int j = 0; j < 4; ++j) { const int c = 4 * X.lane + 256 * j; const f32x4 sh = *(const f32x4*)(md + c), sc = *(const f32x4*)(md + 1024 + c) + 1.0f;
#pragma unroll
            for (int q = 0; q < 4; ++q) { const f32x4 h = x[q][j] * sc + sh; v2u w; w.x = cvt_pk_bf16(h[0], h[1]); w.y = cvt_pk_bf16(h[2], h[3]);
                *(v2u*)(XH + (size_t)(r0 + q) * D + c) = w; *(unsigned*)(X.ws + WS_XH8 + (size_t)(r0 + q) * D + c) = pg8::pk_fp8x4(h[0], h[1], h[2], h[3]); } }
    }
}

__device__ __forceinline__ f32x2 lru_comp(f32x2 first, f32x2 second) { return (f32x2){first.x * second.x, second.x * first.y + second.y}; }
template <int PASS> __device__ __forceinline__ void ph_lru(const Ctx& X, CArgs a, int l, bool need_ctx) {
    LAS float* U = (LAS float*)X.lds;
    LAS f32x2* WAG = (LAS f32x2*)(X.lds + 34816);
    LAS float* PRE = (LAS float*)(X.lds + 34816 + 8192);
    LAS f32x2* CAR = (LAS f32x2*)(X.lds + 34816 + 8192 + 4096);
    LAS v4u* BW = (LAS v4u*)(X.lds + 51200);
    LAS float* CW = (LAS float*)(X.lds + 51200 + 32768);
    unsigned char* wsl = X.ws;
#define LRU_WS(off) (wsl + (off))
#define XB ((const bf16*)LRU_WS(WS_XB))
#define GB ((const bf16*)LRU_WS(WS_GB))
#define YB ((bf16*)LRU_WS(WS_BR) + (size_t)R * 512)
#define LW ((const bf16*)LRU_WS(WS_LRUW) + (size_t)l * 2 * 2 * 8 * 4096)
#define AGG ((f32x2*)LRU_WS(WS_AGG))
#define LBQ ((v4u*)LRU_WS(WS_MM32))
    const int w = X.wave;
    int tid_o = X.tid; asm volatile("" : "+v"(tid_o));
    int quad = (tid_o & 63) >> 4, l16 = tid_o & 15, tt = tid_o >> 2, c16 = (tid_o & 3) * 16;
    int gcur = -1; float cba[2][4], cbx[2][4], csp[2][4];
#define LRU_ITEM(it_, b_, sc_, g_) const int b_ = (it_) / 528, sc_ = ((it_) % 528) >> 3, g_ = (it_) & 7
#define LRU_LOADX(dst, it_) do { LRU_ITEM(it_, b__, sc__, g__); const int slo = sc__ < 2 ? T + b__ * CTX : b__ * SEQ, sln = sc__ < 2 ? CTX : SEQ, tq = (sc__ < 2 ? sc__ * 128 : (sc__ - 2) * 128) + tt - 2; \
        _Pragma("unroll") for (int j = 0; j < 4; ++j) { const int t = tq + j; const bool ok = t >= 0 && t < sln; const bf16* p = XB + (size_t)(slo + (ok ? t : 0)) * 512 + g__ * 64 + c16; \
            dst[j][0] = ok ? *(const v4u*)p : (v4u){0u, 0u, 0u, 0u}; dst[j][1] = ok ? *(const v4u*)(p + 8) : (v4u){0u, 0u, 0u, 0u}; } } while (0)
    v4u xc[4][2];
    int item = blockIdx.x;
    while (item < NB * 66 * 8 && PASS == 2 && !need_ctx && ((item % 528) >> 3) < 2) item += X.G;
    if (PASS == 1 && item < NB * 66 * 8) LRU_LOADX(xc, item);
    int cvk = 0;
    while (item < NB * 66 * 8) {
        LRU_ITEM(item, b, sc, g);
        { unsigned long long w_ = (unsigned long long)X.ws; asm volatile("" : "+s"(w_)); wsl = (unsigned char*)(GAS unsigned char*)w_; }
        asm volatile("" : "+v"(tid_o)); quad = (tid_o & 63) >> 4; l16 = tid_o & 15; tt = tid_o >> 2; c16 = (tid_o & 3) * 16;
        int nitem = item + X.G;
        f32x4 cvv[16]; CvItem cvi; const bool cvh = PASS == 2 && cvk < CV_IN_LRU;
        while (nitem < NB * 66 * 8 && PASS == 2 && !need_ctx && ((nitem % 528) >> 3) < 2) nitem += X.G;
        const int seqlo = sc < 2 ? T + b * CTX : b * SEQ, t0 = sc < 2 ? sc * 128 : (sc - 2) * 128;
        if (PASS == 1 && g != gcur) {
            __syncthreads();
            CArgs a2 = a; asm volatile("" : "+s"(a2));
            const bf16* lw_ = LW;
            for (int i = X.tid; i < 2048; i += 512) { const int slot = i >> 6, ln = i & 63, ks = slot & 1, nt = (slot >> 1) & 3, dg = slot >> 3;
                BW[i] = *(const v4u*)(lw_ + ((size_t)(dg * 8 + g) * 64 + nt * 16 + (ln & 15)) * 64 + ks * 32 + 8 * (ln >> 4)); }
            if (X.tid < 320) { const int j = X.tid >> 6, ch = X.tid & 63; CW[X.tid] = j < 4 ? inp(a2, I_CONVW)[(l * 4 + j) * 512 + g * 64 + ch] : inp(a2, I_CONVB)[l * 512 + g * 64 + ch]; }
#pragma unroll
            for (int d = 0; d < 2; ++d)
#pragma unroll
                for (int nt = 0; nt < 4; ++nt) { const int ch = g * 64 + nt * 16 + l16;
                    cba[d][nt] = inp(a2, I_LBA)[(l * 2 + d) * 512 + ch]; cbx[d][nt] = inp(a2, I_LBX)[(l * 2 + d) * 512 + ch];
                    const float el = fast_exp(-inp(a2, I_LLAM)[(l * 2 + d) * 512 + ch]);
                    csp[d][nt] = el < 0.03f ? el * (1.0f - el * (0.5f - el * (0.33333334f - el * 0.25f))) : __builtin_amdgcn_logf(1.0f + el) * 0.6931471805599453f; }
            gcur = g;
            __syncthreads();
        }
        if (PASS == 2) {
        { const int dc = tid_o & 127, d = dc >> 6, ch = dc & 63, sg = tid_o >> 7;
          const f32x2* ag = AGG + (size_t)(b * 2 + d) * 66 * 512 + g * 64 + ch;
          const int npos = d == 0 ? sc : (sc == 1 ? 0 : (sc == 0 ? 1 : 67 - sc));
          f32x2 qv[17];
#pragma unroll
          for (int k = 0; k < 17; ++k) { const int p = sg * 17 + k; const int c = d == 0 ? p : (p == 0 ? 1 : (p == 1 ? 0 : 67 - p));
              qv[k] = p < npos ? ag[(size_t)c * 512] : (f32x2){1.f, 0.f}; }
          f32x2 part = {1.f, 0.f};
#pragma unroll
          for (int k = 0; k < 17; ++k) part = lru_comp(part, qv[k]);
          CAR[sg * 128 + dc] = part; }
        }
        if (PASS == 1) { float u[16];
#pragma unroll
          for (int k = 0; k < 16; k += 4) { const f32x4 bvv = *(const LAS f32x4*)(CW + 256 + c16 + k); u[k] = bvv[0]; u[k + 1] = bvv[1]; u[k + 2] = bvv[2]; u[k + 3] = bvv[3]; }
#pragma unroll
          for (int j = 0; j < 4; ++j) { const unsigned xw[8] = {xc[j][0].x, xc[j][0].y, xc[j][0].z, xc[j][0].w, xc[j][1].x, xc[j][1].y, xc[j][1].z, xc[j][1].w};
#pragma unroll
              for (int k = 0; k < 16; k += 4) { const f32x4 wv = *(const LAS f32x4*)(CW + j * 64 + c16 + k);
                  u[k] += wv[0] * bf_lo(xw[k >> 1]); u[k + 1] += wv[1] * bf_hi(xw[k >> 1]); u[k + 2] += wv[2] * bf_lo(xw[(k >> 1) + 1]); u[k + 3] += wv[3] * bf_hi(xw[(k >> 1) + 1]); } }
#pragma unroll
          for (int k = 0; k < 16; k += 4) *(LAS f32x4*)(U + tt * 68 + c16 + k) = (f32x4){u[k], u[k + 1], u[k + 2], u[k + 3]}; }
        if (PASS == 1 && nitem < NB * 66 * 8) LRU_LOADX(xc, nitem);
        const int rowb = seqlo + t0 + 16 * w + 4 * quad;
        unsigned short gbq[4][4];
        if (PASS == 2) {
#pragma unroll
            for (int nt = 0; nt < 4; ++nt)
#pragma unroll
                for (int i = 0; i < 4; ++i) gbq[nt][i] = GB[(size_t)(rowb + i) * 512 + g * 64 + nt * 16 + l16]; }
        v4u lbq[8];
        if (PASS == 2) {
#pragma unroll
            for (int k = 0; k < 8; ++k) lbq[k] = LBQ[((size_t)item * 8 + k) * 512 + tid_o]; }
        if (cvh) { cvi = cv_make(a, X.ws, l, (X.vcu * NWAVES + w) + cvk * (X.G * NWAVES), tid_o & 63); cv_load(cvv, cvi); }
        if (PASS == 1) __syncthreads();
        float av[2][4][4], bv[2][4][4];
        if (PASS == 1) {
        bf16x8 af[2];
#pragma unroll
        for (int ks = 0; ks < 2; ++ks) { const LAS float* up = U + (16 * w + l16) * 68 + ks * 32 + 8 * quad; const f32x4 p0 = *(const LAS f32x4*)up, p1 = *(const LAS f32x4*)(up + 4);
            v4u pk; pk.x = cvt_pk_bf16(p0[0], p0[1]); pk.y = cvt_pk_bf16(p0[2], p0[3]); pk.z = cvt_pk_bf16(p1[0], p1[1]); pk.w = cvt_pk_bf16(p1[2], p1[3]); af[ks] = __builtin_bit_cast(bf16x8, pk); }
#pragma unroll
        for (int d = 0; d < 2; ++d)
#pragma unroll
            for (int nt = 0; nt < 4; ++nt) {
                f32x4 cr = {0.f, 0.f, 0.f, 0.f}, ci = {0.f, 0.f, 0.f, 0.f};
#pragma unroll
                for (int ks = 0; ks < 2; ++ks) {
                    const bf16x8 br = __builtin_bit_cast(bf16x8, BW[((((d * 2 + 0) * 4 + nt) * 2 + ks) << 6) + (tid_o & 63)]);
                    const bf16x8 bi = __builtin_bit_cast(bf16x8, BW[((((d * 2 + 1) * 4 + nt) * 2 + ks) << 6) + (tid_o & 63)]);
                    cr = __builtin_amdgcn_mfma_f32_16x16x32_bf16(af[ks], br, cr, 0, 0, 0);
                    ci = __builtin_amdgcn_mfma_f32_16x16x32_bf16(af[ks], bi, ci, 0, 0, 0);
                }
                const float ba = cba[d][nt], bx = cbx[d][nt], sp = csp[d][nt];
                unsigned pkw[4];
#pragma unroll
                for (int i = 0; i < 4; ++i) {
                    const float uu = U[(16 * w + 4 * quad + i) * 68 + nt * 16 + l16];
                    const float rr = sigmoid_f(cr[i] + ba), ii = sigmoid_f(ci[i] + bx);
                    const float la = -8.0f * rr * sp, x2 = 2.0f * la;
                    const float om = x2 > -0.25f ? -x2 * (1.0f + x2 * (0.5f + x2 * (0.16666667f + x2 * (0.041666668f + x2 * (0.008333334f + x2 * 0.0013888889f))))) : 1.0f - fast_exp(x2);
                    av[d][nt][i] = fast_exp(la); bv[d][nt][i] = __builtin_amdgcn_sqrtf(om) * (ii * uu);
                    pkw[i] = (unsigned)__builtin_bit_cast(unsigned short, (_Float16)la) | cvt_pk_bf16(0.f, bv[d][nt][i]);
                }
                LBQ[((size_t)item * 8 + d * 4 + nt) * 512 + tid_o] = (v4u){pkw[0], pkw[1], pkw[2], pkw[3]};
            }
        } else {
#pragma unroll
        for (int d = 0; d < 2; ++d)
#pragma unroll
            for (int nt = 0; nt < 4; ++nt) { const v4u q4 = lbq[d * 4 + nt]; const unsigned qq[4] = {q4.x, q4.y, q4.z, q4.w};
#pragma unroll
                for (int i = 0; i < 4; ++i) { av[d][nt][i] = fast_exp((float)__builtin_bit_cast(_Float16, (unsigned short)(qq[i] & 0xffffu))); bv[d][nt][i] = __uint_as_float(qq[i] & 0xffff0000u); } }
        }
        f32x2 seg[2][4];
#pragma unroll
        for (int nt = 0; nt < 4; ++nt) {
            { float A = 1.f, H = 0.f;
#pragma unroll
              for (int i = 0; i < 4; ++i) { H = av[0][nt][i] * H + bv[0][nt][i]; A *= av[0][nt][i]; } seg[0][nt] = (f32x2){A, H}; }
            { float A = 1.f, H = 0.f;
#pragma unroll
              for (int i = 3; i >= 0; --i) { H = av[1][nt][i] * H + bv[1][nt][i]; A *= av[1][nt][i]; } seg[1][nt] = (f32x2){A, H}; }
        }
#pragma unroll
        for (int d = 0; d < 2; ++d)
#pragma unroll
            for (int nt = 0; nt < 4; ++nt) {
                f32x2 tot = seg[d][nt];
#pragma unroll
                for (int off = 16; off <= 32; off <<= 1) {
                    const f32x2 o = (f32x2){__shfl_xor(tot.x, off), __shfl_xor(tot.y, off)};
                    const bool me_low = (X.lane & off) == 0;
                    const bool me_first = (d == 0) ? me_low : !me_low;
                    tot = me_first ? lru_comp(tot, o) : lru_comp(o, tot);
                }
                if (quad == 0) WAG[(d * 8 + w) * 64 + nt * 16 + l16] = tot;
            }
        __syncthreads();
        if (PASS == 1) {
            if (X.tid < 128) { const int d = X.tid >> 6, ch = X.tid & 63; f32x2 tot = (f32x2){1.f, 0.f};
                for (int q = 0; q < 8; ++q) { const int ww = d == 0 ? q : 7 - q; tot = lru_comp(tot, WAG[(d * 8 + ww) * 64 + ch]); }
                AGG[((size_t)(b * 2 + d) * 66 + sc) * 512 + g * 64 + ch] = tot; }
            __syncthreads();
        } else {
            if (X.tid < 128) { const int d = X.tid >> 6, ch = X.tid & 63; float st = 0.f;
#pragma unroll
                for (int sg = 0; sg < 4; ++sg) { const f32x2 q = CAR[sg * 128 + X.tid]; st = q.x * st + q.y; }
                for (int q = 0; q < 8; ++q) { const int ww = d == 0 ? q : 7 - q; PRE[(d * 8 + ww) * 64 + ch] = st; const f32x2 t2 = WAG[(d * 8 + ww) * 64 + ch]; st = t2.x * st + t2.y; } }
            __syncthreads();
#pragma unroll
            for (int nt = 0; nt < 4; ++nt) {
                float y[4];
                { float s = PRE[(0 * 8 + w) * 64 + nt * 16 + l16];
#pragma unroll
                  for (int q = 0; q < 4; ++q) { const float A = __shfl(seg[0][nt].x, q * 16 + l16), H = __shfl(seg[0][nt].y, q * 16 + l16); if (q < quad) s = A * s + H; }
#pragma unroll
                  for (int i = 0; i < 4; ++i) { s = av[0][nt][i] * s + bv[0][nt][i]; y[i] = s; } }
                { float s = PRE[(1 * 8 + w) * 64 + nt * 16 + l16];
#pragma unroll
                  for (int q = 3; q >= 0; --q) { const float A = __shfl(seg[1][nt].x, q * 16 + l16), H = __shfl(seg[1][nt].y, q * 16 + l16); if (q > quad) s = A * s + H; }
#pragma unroll
                  for (int i = 3; i >= 0; --i) { s = av[1][nt][i] * s + bv[1][nt][i]; y[i] += s; } }
                const int ch = g * 64 + nt * 16 + l16;
#pragma unroll
                for (int i = 0; i < 4; ++i) { const size_t o = (size_t)(rowb + i) * 512 + ch; const float gbv = __uint_as_float((unsigned)gbq[nt][i] << 16);
                    YB[o] = (bf16)(cvt_pk_bf16(y[i] * gbv, 0.f) & 0xffffu); }
            }
            __syncthreads();
        }
        if (cvh) { cv_finish(cvv, cvi, (LAS bf16*)(X.lds + 51200 + w * 8448), tid_o & 63); ++cvk; }
        item = nitem;
    }
    for (; PASS == 2 && cvk < CV_IN_LRU; ++cvk) {
        const CvItem ci = cv_make(a, X.ws, l, (X.vcu * NWAVES + w) + cvk * (X.G * NWAVES), tid_o & 63); f32x4 v[16]; cv_load(v, ci); cv_finish(v, ci, (LAS bf16*)(X.lds + 51200 + w * 8448), tid_o & 63); }
#undef LRU_ITEM
#undef LRU_LOADX
#undef LRU_WS
#undef XB
#undef GB
#undef YB
#undef LW
#undef AGG
#undef LBQ
}

__device__ __forceinline__ void ph_diff_combine(const Ctx& X, CArgs a, int l, int nrows) {
    const int gw = X.vcu * NWAVES + X.wave, NGW = X.G * NWAVES;
    const float lam_init = l == 0 ? 0.2f : 0.35550906759096926f;
    const float* dl = inp(a, I_DLAM) + l * 256;
    const float s1 = wave_sum(dl[X.lane] * dl[64 + X.lane]), s2 = wave_sum(dl[128 + X.lane] * dl[192 + X.lane]);
    const float lam = expf(s1) - expf(s2) + lam_init;
    const bf16* DO0 = (const bf16*)(X.ws + WS_DO); const bf16* DO1 = DO0 + (size_t)R * 512; bf16* YC = (bf16*)(X.ws + WS_BR) + (size_t)2 * R * 512;
    const float* sub = inp(a, I_DSUB) + l * 128 + (8 * X.lane & 127);
    const f32x4 g0 = *(const f32x4*)sub, g1 = *(const f32x4*)(sub + 4);
    const float post = 1.0f - lam_init;
    for (int r = gw; r < nrows; r += NGW) {
        const v4u p = *(const v4u*)(DO0 + (size_t)r * 512 + 8 * X.lane), q = *(const v4u*)(DO1 + (size_t)r * 512 + 8 * X.lane);
        float v[8] = {bf_lo(p.x) - lam * bf_lo(q.x), bf_hi(p.x) - lam * bf_hi(q.x), bf_lo(p.y) - lam * bf_lo(q.y), bf_hi(p.y) - lam * bf_hi(q.y),
                      bf_lo(p.z) - lam * bf_lo(q.z), bf_hi(p.z) - lam * bf_hi(q.z), bf_lo(p.w) - lam * bf_lo(q.w), bf_hi(p.w) - lam * bf_hi(q.w)};
        float ss = 0.f;
#pragma unroll
        for (int k = 0; k < 8; ++k) ss += v[k] * v[k];
        ss += __shfl_xor(ss, 1); ss += __shfl_xor(ss, 2); ss += __shfl_xor(ss, 4); ss += __shfl_xor(ss, 8);
        const float rinv = __builtin_amdgcn_rsqf(ss * (1.0f / 128.0f) + RMS_EPS) * post;
        v4u o; o.x = cvt_pk_bf16(v[0] * rinv * g0[0], v[1] * rinv * g0[1]); o.y = cvt_pk_bf16(v[2] * rinv * g0[2], v[3] * rinv * g0[3]);
        o.z = cvt_pk_bf16(v[4] * rinv * g1[0], v[5] * rinv * g1[1]); o.w = cvt_pk_bf16(v[6] * rinv * g1[2], v[7] * rinv * g1[3]);
        *(v4u*)(YC + (size_t)r * 512 + 8 * X.lane) = o;
    }
}

__device__ __forceinline__ void ph_ln1_router(const Ctx& X, CArgs a, int l, int nrows) {
    const int gw = X.vcu * NWAVES + X.wave, NGW = X.G * NWAVES;
    LAS float* WR = (LAS float*)X.lds;
    for (int i = X.tid; i < 16 * 1024; i += 512) { const int c = i >> 4, e = i & 15; WR[e * 1024 + c] = inp(a, I_WR)[(size_t)l * 1024 * 16 + i]; }
    __syncthreads();
    const bf16* O16 = (const bf16*)(X.ws + WS_GM); float* X1 = (float*)(X.ws + WS_X1); unsigned char* H2 = X.ws + WS_SA; float* AFF = (float*)(X.ws + WS_AFF);
    const float* lg = uni(inp(a, I_LN1G) + l * D); const float* lb = uni(inp(a, I_LN1B) + l * D);
    f32x4 xn[2][4]; v2u on[2][4];
#define LN1_FETCH(rr_) do { unsigned lp_ = 4u * (unsigned)X.lane; asm volatile("" : "+v"(lp_)); \
        const float* p0_ = uni(xrow_ptr(a, X.ws, l, (rr_))); const float* p1_ = uni(xrow_ptr(a, X.ws, l, (rr_) + 1)); const bf16* po_ = uni(O16 + (size_t)(rr_) * D); \
        _Pragma("unroll") for (int j = 0; j < 4; ++j) { xn[0][j] = *(const f32x4*)(p0_ + (lp_ + 256u * j)); xn[1][j] = *(const f32x4*)(p1_ + (lp_ + 256u * j)); } \
        _Pragma("unroll") for (int j = 0; j < 4; ++j) { on[0][j] = *(const v2u*)(po_ + (lp_ + 256u * j)); on[1][j] = *(const v2u*)(po_ + (lp_ + 1024u + 256u * j)); } } while (0)
    if (gw * 2 < nrows) LN1_FETCH(gw * 2);
    for (int r0 = gw * 2; r0 < nrows; r0 += NGW * 2) {
        const float* md = uni(mod_ptr(X.ws, l, r0));
        unsigned l4 = 4u * (unsigned)X.lane; asm volatile("" : "+v"(l4));
        float* x1p = uni(X1 + (size_t)r0 * D); unsigned char* h2p = uni(H2 + (size_t)r0 * D);
        f32x4 v[2][4]; float s[2] = {0.f, 0.f};
#pragma unroll
        for (int j = 0; j < 4; ++j) { v[0][j] = xn[0][j]; v[1][j] = xn[1][j]; }
#pragma unroll
        for (int j = 0; j < 4; ++j) { const f32x4 g1 = *(const f32x4*)(md + (l4 + 2048u + 256u * j));
#pragma unroll
            for (int q = 0; q < 2; ++q) { const v2u ow = on[q][j]; const f32x4 of = {bf_lo(ow.x), bf_hi(ow.x), bf_lo(ow.y), bf_hi(ow.y)};
                v[q][j] = v[q][j] * DN_ALPHA + g1 * of;
                s[q] += (v[q][j][0] + v[q][j][1]) + (v[q][j][2] + v[q][j][3]); } }
        float mean[2], rstd[2];
#pragma unroll
        for (int q = 0; q < 2; ++q) mean[q] = wave_sum(s[q]) * (1.0f / D);
#pragma unroll
        for (int q = 0; q < 2; ++q) { float qq = 0.f;
#pragma unroll
            for (int j = 0; j < 4; ++j) { v[q][j] = v[q][j] - mean[q]; qq += (v[q][j][0] * v[q][j][0] + v[q][j][1] * v[q][j][1]) + (v[q][j][2] * v[q][j][2] + v[q][j][3] * v[q][j][3]); }
            s[q] = qq; }
#pragma unroll
        for (int q = 0; q < 2; ++q) rstd[q] = 1.0f / sqrtf(wave_sum(s[q]) * (1.0f / D) + LN_EPS);
#pragma unroll
        for (int j = 0; j < 4; ++j) { const unsigned c = l4 + 256u * j;
            const f32x4 g4 = *(const f32x4*)(lg + c), b4 = *(const f32x4*)(lb + c), sc4 = *(const f32x4*)(md + (c + 4096u)) + 1.0f, sh4 = *(const f32x4*)(md + (c + 3072u));
#pragma unroll
            for (int q = 0; q < 2; ++q) { const f32x4 y = v[q][j] * rstd[q] * g4 + b4;
                *(f32x4*)(x1p + (c + 1024u * q)) = y;
                const f32x4 h = y * sc4 + sh4; v[q][j] = h;
                *(unsigned*)(h2p + (c + 1024u * q)) = pg8::pk_fp8x4(h[0], h[1], h[2], h[3]); } }
        __builtin_amdgcn_sched_barrier(0);
        if (r0 + NGW * 2 < nrows) LN1_FETCH(r0 + NGW * 2);
        __builtin_amdgcn_sched_barrier(0);
        float lgt[2][16];
#pragma unroll
        for (int q = 0; q < 2; ++q) {
            unsigned cq = l4; asm volatile("" : "+v"(cq));
#pragma unroll
            for (int e = 0; e < 16; ++e) lgt[q][e] = 0.f;
#pragma unroll
            for (int j = 0; j < 4; ++j)
#pragma unroll
                for (int e = 0; e < 16; ++e) { const f32x4 wr = *(const LAS f32x4*)(WR + e * 1024 + cq + 256u * j);
                    lgt[q][e] += (v[q][j][0] * wr[0] + v[q][j][1] * wr[1]) + (v[q][j][2] * wr[2] + v[q][j][3] * wr[3]);
                    asm volatile("" : "+v"(lgt[q][e]));
                    if ((e & 7) == 7) __builtin_amdgcn_sched_barrier(0); }
        }
#pragma unroll
        for (int q = 0; q < 2; ++q) {
            float k8[8], k4[4], k2[2], k1;
            { const bool hi = (X.lane & 32) != 0;
#pragma unroll
              for (int e = 0; e < 8; ++e) { const float send = hi ? lgt[q][e] : lgt[q][e + 8], keep = hi ? lgt[q][e + 8] : lgt[q][e]; k8[e] = keep + __shfl_xor(send, 32); } }
            { const bool hi = (X.lane & 16) != 0;
#pragma unroll
              for (int e = 0; e < 4; ++e) { const float send = hi ? k8[e] : k8[e + 4], keep = hi ? k8[e + 4] : k8[e]; k4[e] = keep + __shfl_xor(send, 16); } }
            { const bool hi = (X.lane & 8) != 0;
#pragma unroll
              for (int e = 0; e < 2; ++e) { const float send = hi ? k4[e] : k4[e + 2], keep = hi ? k4[e + 2] : k4[e]; k2[e] = keep + __shfl_xor(send, 8); } }
            { const bool hi = (X.lane & 4) != 0; const float send = hi ? k2[0] : k2[1], keep = hi ? k2[1] : k2[0]; k1 = keep + __shfl_xor(send, 4); }
            k1 += __shfl_xor(k1, 2); k1 += __shfl_xor(k1, 1);
            float mx = k1;
            mx = fmaxf(mx, __shfl_xor(mx, 32)); mx = fmaxf(mx, __shfl_xor(mx, 16)); mx = fmaxf(mx, __shfl_xor(mx, 8)); mx = fmaxf(mx, __shfl_xor(mx, 4));
            const float ex = expf(k1 - mx); float den = ex;
            den += __shfl_xor(den, 32); den += __shfl_xor(den, 16); den += __shfl_xor(den, 8); den += __shfl_xor(den, 4);
            const int eidx = ((X.lane >> 5) & 1) * 8 + ((X.lane >> 4) & 1) * 4 + ((X.lane >> 3) & 1) * 2 + ((X.lane >> 2) & 1);
            if ((X.lane & 3) == 0) AFF[(size_t)(r0 + q) * 16 + eidx] = ex / den;
        }
    }
#undef LN1_FETCH
    __syncthreads();
}

__device__ __forceinline__ void ph_topk_convert(const Ctx& X, CArgs a, int l, bool need_ctx) {
    LAS unsigned* HIST = (LAS unsigned*)X.lds;
    LAS unsigned* SH = HIST + 256;
    const float* AFF = (const float*)(X.ws + WS_AFF); int* SLOT = (int*)(X.ws + WS_SLOT); int* SRC = (int*)(X.ws + WS_SRC);
    const int nitems = need_ctx ? 128 : 64;
    for (int it = blockIdx.x; it < nitems; it += X.G) {
        const bool isc = it >= 64; const int q = it & 63, b = q >> 4, e = q & 15;
        const int n = isc ? CTX : SEQ, cap = isc ? CAPC : CAP, rbase = isc ? T + b * CTX : b * SEQ;
        unsigned key[16];
#pragma unroll
        for (int i = 0; i < 16; ++i) { const int t = i * 512 + X.tid; key[i] = t < n ? __float_as_uint(AFF[(size_t)(rbase + t) * 16 + e]) : 0u; }
        unsigned prefix = 0u, need = (unsigned)cap;
        for (int pass = 0; pass < 4; ++pass) {
            const int shift = 24 - 8 * pass;
            if (X.tid < 256) HIST[X.tid] = 0u;
            __syncthreads();
            if (pass == 0) {
#pragma unroll
                for (int i = 0; i < 16; ++i) { bool act = (i * 512 + X.tid) < n; const unsigned bin = key[i] >> 24;
#pragma unroll
                    for (int rep = 0; rep < 4; ++rep) { const unsigned long long am = __ballot(act);
                        if (am != 0ull) { const int leader = __builtin_ctzll(am); const unsigned vv = (unsigned)__builtin_amdgcn_readlane((int)bin, leader); const unsigned long long mm = __ballot(act && bin == vv);
                            if (X.lane == leader) __hip_atomic_fetch_add(&HIST[vv], (unsigned)__popcll(mm), __ATOMIC_RELAXED, __HIP_MEMORY_SCOPE_WORKGROUP);
                            act = act && bin != vv; } }
                    if (act) __hip_atomic_fetch_add(&HIST[bin], 1u, __ATOMIC_RELAXED, __HIP_MEMORY_SCOPE_WORKGROUP); }
            } else {
#pragma unroll
            for (int i = 0; i < 16; ++i) { const bool ok = ((key[i] >> (shift + 8)) == (prefix >> (shift + 8)));
                if (ok && (i * 512 + X.tid) < n) __hip_atomic_fetch_add(&HIST[(key[i] >> shift) & 255u], 1u, __ATOMIC_RELAXED, __HIP_MEMORY_SCOPE_WORKGROUP); }
            }
            __syncthreads();
            if (X.wave == 0) {
                const unsigned c0 = HIST[4 * X.lane], c1 = HIST[4 * X.lane + 1], c2 = HIST[4 * X.lane + 2], c3 = HIST[4 * X.lane + 3];
                const unsigned s = c0 + c1 + c2 + c3; unsigned suf = s;
#pragma unroll
                for (int off = 1; off < 64; off <<= 1) { const unsigned o = __shfl_down(suf, off); if (X.lane + off < 64) suf += o; }
                const unsigned above = suf - s;
                if (above < need && need <= above + s) {
                    unsigned cum = above; int bin;
                    if (need <= cum + c3) bin = 3; else { cum += c3; if (need <= cum + c2) bin = 2; else { cum += c2; if (need <= cum + c1) bin = 1; else { cum += c1; bin = 0; } } }
                    SH[0] = prefix | ((unsigned)(4 * X.lane + bin) << shift); SH[1] = need - cum;
                }
            }
            __syncthreads();
            prefix = SH[0]; need = SH[1];
            __syncthreads();
        }
        const unsigned K = prefix;
        const int niter = isc ? 1 : 16;
        LAS unsigned* CNT = SH + 32;
#pragma unroll
        for (int i = 0; i < 16; ++i) { if (i < niter) { const int t = i * 512 + X.tid; const bool valid = t < n;
            const unsigned long long mg = __ballot(valid && key[i] > K), me = __ballot(valid && key[i] == K);
            if (X.lane == 0) CNT[i * 8 + X.wave] = (unsigned)__popcll(mg) | ((unsigned)__popcll(me) << 16); } }
        __syncthreads();
        if (X.wave == 0) { const int ne = niter * 8;
            const unsigned c0 = 2 * X.lane < ne ? CNT[2 * X.lane] : 0u, c1 = 2 * X.lane + 1 < ne ? CNT[2 * X.lane + 1] : 0u;
            const unsigned sm = c0 + c1; unsigned inc = sm;
#pragma unroll
            for (int off = 1; off < 64; off <<= 1) { const unsigned o = __shfl_up(inc, off); if (X.lane >= off) inc += o; }
            const unsigned exc = inc - sm;
            if (2 * X.lane < ne) CNT[2 * X.lane] = exc;
            if (2 * X.lane + 1 < ne) CNT[2 * X.lane + 1] = exc + c0; }
        __syncthreads();
#pragma unroll
        for (int i = 0; i < 16; ++i) { if (i < niter) { const int t = i * 512 + X.tid; const bool valid = t < n;
            const bool gt = valid && key[i] > K, eq = valid && key[i] == K;
            const unsigned long long mg = __ballot(gt), me = __ballot(eq);
            const unsigned long long lower = (1ull << X.lane) - 1ull;
            const unsigned bs = CNT[i * 8 + X.wave];
            const unsigned ngt = (bs & 0xffffu) + (unsigned)__popcll(mg & lower), neq = (bs >> 16) + (unsigned)__popcll(me & lower);
            const bool sel = gt || (eq && neq < need);
            const unsigned pos = ngt + (neq < need ? neq : need);
            if (valid) { SLOT[(size_t)(rbase + t) * 16 + e] = sel ? (int)pos : -1;
                if (sel) SRC[e * EROWS + (isc ? 4096 + b * CAPC : b * CAP) + (int)pos] = rbase + t; } } }
        __syncthreads();
    }
    if (need_ctx) { const int gt = blockIdx.x * 512 + X.tid; if (gt < NE * 128) SRC[(gt >> 7) * EROWS + 4224 + (gt & 127)] = -1; }
    LAS bf16* scr = (LAS bf16*)(X.lds + 32768 + X.wave * 8448);
    const int gw = X.vcu * NWAVES + X.wave, NGW = X.G * NWAVES;
    unsigned char* WGU = X.ws + WS_WGU; unsigned char* WD = X.ws + WS_WD;
    __syncthreads();
    for (int it = gw + CV_IN_ATT * NGW; it < CV_ITEMS; it += NGW) {
        const CvItem ci = cv_make(a, X.ws, l, it, X.lane); f32x4 v[16]; unsigned P[4][4]; cv_load(v, ci); cv_pack8(v, ci.scale, P); cv_store8(P, ci, X.lane); }
    unsigned zz = 0u; asm volatile("" : "+v"(zz)); const v4u zero4 = {zz, zz, zz, zz};
    for (int i = gw * 64 + X.lane; i < NE * 128 * 64; i += NGW * 64) {
        const int e = i >> 13, rr = (i >> 6) & 127, pc = i & 63; const int row = e * 5632 + 21 * 256 + (rr >> 6) * 128 + 64 + (rr & 63);
        *(v4u*)(WGU + (size_t)row * D + pc * 16) = zero4; }
    for (int i = gw * 64 + X.lane; i < NE * 1024 * 4; i += NGW * 64) {
        const int rowi = i >> 2, pc = i & 3; *(v4u*)(WD + (size_t)rowi * FFP + FF + pc * 16) = zero4; }
}

__device__ __forceinline__ void ph_gather(const Ctx& X, bool need_ctx) {
    const int gw = X.vcu * NWAVES + X.wave, NGW = X.G * NWAVES;
    const int* SRC = (const int*)(X.ws + WS_SRC); const unsigned char* H2 = X.ws + WS_SA; unsigned char* XG = X.ws + WS_XG;
    const int per_e = need_ctx ? EROWS : 4096;
    for (int i0 = gw * 8; i0 < NE * per_e; i0 += NGW * 8) {
        const int e = i0 / per_e, q0 = i0 - e * per_e, mr0 = e * EROWS + q0;
        int src[8]; v4u v0[8];
#pragma unroll
        for (int q = 0; q < 8; ++q) src[q] = SRC[mr0 + q];
#pragma unroll
        for (int q = 0; q < 8; ++q) { v0[q] = (v4u){0u, 0u, 0u, 0u}; if (src[q] >= 0) v0[q] = *(const v4u*)(H2 + (size_t)src[q] * D + 16 * X.lane); }
#pragma unroll
        for (int q = 0; q < 8; ++q) *(v4u*)(XG + (size_t)(mr0 + q) * D + 16 * X.lane) = v0[q];
    }
}

__device__ __forceinline__ void ph_ln2(const Ctx& X, CArgs a, int l, int nrows) {
    const int gw = X.vcu * NWAVES + X.wave, NGW = X.G * NWAVES;
    const float* X1 = (const float*)(X.ws + WS_X1); const float* AFF = (const float*)(X.ws + WS_AFF); const int* SLOT = (const int*)(X.ws + WS_SLOT);
    const bf16* EO = (const bf16*)(X.ws + WS_EO); float* X2 = (float*)(X.ws + WS_X2); bf16* XH = (bf16*)(X.ws + WS_SA);
    const float* lg = inp(a, I_LN2G) + l * D; const float* lb = inp(a, I_LN2B) + l * D;
    int slv_n = -1; float afv_n = 0.f; f32x4 xn[2][4];
#define LN2_FETCH(rr_) do { unsigned lp_ = 4u * (unsigned)X.lane; asm volatile("" : "+v"(lp_)); \
        slv_n = X.lane < 32 ? SLOT[(size_t)(rr_) * 16 + X.lane] : -1; afv_n = X.lane < 32 ? AFF[(size_t)(rr_) * 16 + X.lane] : 0.f; \
        _Pragma("unroll") for (int q = 0; q < 2; ++q) _Pragma("unroll") for (int j = 0; j < 4; ++j) xn[q][j] = *(const f32x4*)(X1 + (size_t)((rr_) + q) * D + (lp_ + 256u * j)); } while (0)
    if (gw * 2 < nrows) LN2_FETCH(gw * 2);
    for (int r0 = gw * 2; r0 < nrows; r0 += NGW * 2) {
        const float* md = mod_ptr(X.ws, l, r0);
        const bool isc = r0 >= T; const int b = isc ? (r0 - T) >> 8 : r0 >> 13;
        const int slv = slv_n; const float afv = afv_n;
        f32x4 v[2][4], mo[2][4];
#pragma unroll
        for (int q = 0; q < 2; ++q)
#pragma unroll
            for (int j = 0; j < 4; ++j) { v[q][j] = xn[q][j]; mo[q][j] = (f32x4){0.f, 0.f, 0.f, 0.f}; }
        const unsigned long long bal = __ballot(slv >= 0);
        unsigned msk[2] = {(unsigned)(bal & 0xffffull), (unsigned)((bal >> 16) & 0xffffull)};
        const size_t rb = (size_t)(isc ? 4096 + b * CAPC : b * CAP);
        while ((msk[0] | msk[1]) != 0u) {
            v2u wv[2][4][4]; float af[2][4];
#pragma unroll
            for (int q = 0; q < 2; ++q) { unsigned m = msk[q];
#pragma unroll
                for (int k = 0; k < 4; ++k) { const bool has = m != 0u; const int e = has ? __builtin_ctz(m) : 0; m = has ? (m & (m - 1u)) : 0u;
                    int sl = 0; float aq = 0.f;
                    if (has) { sl = __builtin_amdgcn_readlane(slv, q * 16 + e); aq = __builtin_bit_cast(float, __builtin_amdgcn_readlane(__builtin_bit_cast(int, afv), q * 16 + e)); }
                    af[q][k] = aq; const size_t er = (size_t)e * EROWS + rb + sl;
#pragma unroll
                    for (int j = 0; j < 4; ++j) wv[q][k][j] = *(const v2u*)(EO + er * D + 4 * X.lane + 256 * j); }
                msk[q] = m; }
#pragma unroll
            for (int q = 0; q < 2; ++q)
#pragma unroll
                for (int k = 0; k < 4; ++k)
#pragma unroll
                    for (int j = 0; j < 4; ++j) { const v2u w2 = wv[q][k][j]; const float aq = af[q][k];
                        mo[q][j][0] += aq * bf_lo(w2.x); mo[q][j][1] += aq * bf_hi(w2.x); mo[q][j][2] += aq * bf_lo(w2.y); mo[q][j][3] += aq * bf_hi(w2.y); }
        }
        __builtin_amdgcn_sched_barrier(0);
        if (r0 + NGW * 2 < nrows) LN2_FETCH(r0 + NGW * 2);
        __builtin_amdgcn_sched_barrier(0);
        float s[2] = {0.f, 0.f}, mean[2], rstd[2];
#pragma unroll
        for (int q = 0; q < 2; ++q)
#pragma unroll
            for (int j = 0; j < 4; ++j) { const int c = 4 * X.lane + 256 * j;
                v[q][j] = v[q][j] * DN_ALPHA + *(const f32x4*)(md + 5120 + c) * mo[q][j];
                s[q] += (v[q][j][0] + v[q][j][1]) + (v[q][j][2] + v[q][j][3]); }
#pragma unroll
        for (int q = 0; q < 2; ++q) mean[q] = wave_sum(s[q]) * (1.0f / D);
#pragma unroll
        for (int q = 0; q < 2; ++q) { float qq = 0.f;
#pragma unroll
            for (int j = 0; j < 4; ++j) { v[q][j] = v[q][j] - mean[q]; qq += (v[q][j][0] * v[q][j][0] + v[q][j][1] * v[q][j][1]) + (v[q][j][2] * v[q][j][2] + v[q][j][3] * v[q][j][3]); }
            s[q] = qq; }
#pragma unroll
        for (int q = 0; q < 2; ++q) rstd[q] = 1.0f / sqrtf(wave_sum(s[q]) * (1.0f / D) + LN_EPS);
        const float* md1 = (const float*)(X.ws + WS_MOD) + (size_t)(1 * 5 + (isc ? 4 : b)) * 6144;
#pragma unroll
        for (int j = 0; j < 4; ++j) { const int c = 4 * X.lane + 256 * j; const f32x4 g4 = *(const f32x4*)(lg + c), b4 = *(const f32x4*)(lb + c);
#pragma unroll
            for (int q = 0; q < 2; ++q) { const f32x4 y = v[q][j] * rstd[q] * g4 + b4;
                if (l == 0) { *(f32x4*)(X2 + (size_t)(r0 + q) * D + c) = y;
                    const f32x4 h = y * (*(const f32x4*)(md1 + 1024 + c) + 1.0f) + *(const f32x4*)(md1 + c);
                    v2u wv; wv.x = cvt_pk_bf16(h[0], h[1]); wv.y = cvt_pk_bf16(h[2], h[3]); *(v2u*)(XH + (size_t)(r0 + q) * D + c) = wv;
                    *(unsigned*)(X.ws + WS_XH8 + (size_t)(r0 + q) * D + c) = pg8::pk_fp8x4(h[0], h[1], h[2], h[3]); }
                else *(f32x4*)((float*)(GAS float*)a->out + (size_t)(r0 + q) * D + c) = y; } }
    }
#undef LN2_FETCH
}
__device__ __forceinline__ int lane_now() { int l_; asm volatile("v_mbcnt_lo_u32_b32 %0, -1, 0\n\tv_mbcnt_hi_u32_b32 %0, -1, %0" : "=v"(l_)); return l_; }
__device__ __forceinline__ void ph_attention(const Ctx& X, CArgs a, int l, unsigned char* lds_generic, bool need_ctx) {
    using attn_body::attn_unit; using attn_body::attn_unit_v128; typedef attn_body::bf16 abf;
    const abf* QA = (const abf*)(X.ws + WS_QA); const abf* KA = (const abf*)(X.ws + WS_KA); const abf* VA = (const abf*)(X.ws + WS_VA);
    const abf* QC = (const abf*)(X.ws + WS_QC); const abf* KC = (const abf*)(X.ws + WS_KC); const abf* VC = (const abf*)(X.ws + WS_VC);
    abf* YA = (abf*)(X.ws + WS_BR); abf* DO = (abf*)(X.ws + WS_DO);
    int cvk = CV_IN_LRU; const int gwc = X.vcu * NWAVES + X.wave, ngwc = X.G * NWAVES;
    bool nomax; { float gq = fabsf(inp(a, I_AQN)[l * 64 + lane_now()]), gk = fabsf(inp(a, I_AKN)[l * 64 + lane_now()]);
#pragma unroll
        for (int o = 1; o < 64; o <<= 1) { gq = fmaxf(gq, __shfl_xor(gq, o)); gk = fmaxf(gk, __shfl_xor(gk, o)); }
        const float bound = 64.0f * C2 * gq * gk * 1.02f;
        nomax = __builtin_amdgcn_readfirstlane((int)(bound < 40.0f)) != 0; }
    bool nomaxd; { const unsigned* nw = (const unsigned*)(X.ws + WS_CTL) + CW_NRM + 2 * l;
        const float mq = __uint_as_float(__hip_atomic_load(nw, __ATOMIC_RELAXED, __HIP_MEMORY_SCOPE_AGENT)), mk = __uint_as_float(__hip_atomic_load(nw + 1, __ATOMIC_RELAXED, __HIP_MEMORY_SCOPE_AGENT));
        const float boundd = C2 * sqrtf(mq * mk) * 1.02f;
        nomaxd = __builtin_amdgcn_readfirstlane((int)(boundd < 60.0f && mq > 0.0f && mk > 0.0f)) != 0; }
#define ATT_CV() do { if (cvk < CV_IN_ATT) { const bool two_ = cvk + 1 < CV_IN_ATT; \
        CvItem c0_ = cv_make(a, X.ws, l, gwc + cvk * ngwc, lane_now()); f32x4 v_[16]; unsigned pk_[4][4]; cv_load(v_, c0_); cv_pack8(v_, c0_.scale, pk_); \
        asm volatile("" ::: "memory"); __builtin_amdgcn_sched_barrier(0); \
        CvItem c1_ = c0_; if (two_) { c1_ = cv_make(a, X.ws, l, gwc + (cvk + 1) * ngwc, lane_now()); cv_load(v_, c1_); } \
        __builtin_amdgcn_sched_barrier(0); cv_store8(pk_, c0_, lane_now()); \
        if (two_) { cv_pack8(v_, c1_.scale, pk_); cv_store8(pk_, c1_, lane_now()); } cvk += 2; } } while (0)
    const int ng = nomax ? 512 : 1024, nun2 = ng + 1024 + (need_ctx ? 64 : 0);
    for (int U = X.vcu; U < nun2; U += X.G) {
        if (U < ng) {
            if (nomax) { const int qb = U & 15, h = (U >> 4) & 7, b = U >> 7; const size_t qrow = (size_t)b * SEQ + qb * 512;
                attn_body::attn_unit2(QA + qrow * 512 + h * 64, 512, KA + (size_t)b * KVL * 128 + (h >> 2) * 64, 128, VA + (size_t)b * KVL * 128 + (h >> 2) * 64, 128, YA + qrow * 512 + h * 64, 512, KVL / 64, (char*)lds_generic + RING_OFF, (X.wave << 6) | lane_now());
                ATT_CV(); }
            else { const int qb = U & 31, h = (U >> 5) & 7, b = U >> 8; const size_t qrow = (size_t)b * SEQ + qb * 256;
                attn_unit<8, false>(QA + qrow * 512 + h * 64, 512, KA + (size_t)b * KVL * 128 + (h >> 2) * 64, 128, VA + (size_t)b * KVL * 128 + (h >> 2) * 64, 128, YA + qrow * 512 + h * 64, 512, KVL / 64, (char*)lds_generic + RING_OFF, (X.wave << 6) | lane_now()); }
        } else if (U >= ng + 1024 && U < ng + 1024 + 32) { const int V = U - ng - 1024, h = V & 7, b = V >> 3; const size_t qrow = (size_t)T + b * CTX;
            if (nomax) attn_unit<8, true>(QA + qrow * 512 + h * 64, 512, KA + (size_t)b * KVL * 128 + (h >> 2) * 64, 128, VA + (size_t)b * KVL * 128 + (h >> 2) * 64, 128, YA + qrow * 512 + h * 64, 512, CTX / 64, (char*)lds_generic + RING_OFF, (X.wave << 6) | lane_now());
            else attn_unit<8, false>(QA + qrow * 512 + h * 64, 512, KA + (size_t)b * KVL * 128 + (h >> 2) * 64, 128, VA + (size_t)b * KVL * 128 + (h >> 2) * 64, 128, YA + qrow * 512 + h * 64, 512, CTX / 64, (char*)lds_generic + RING_OFF, (X.wave << 6) | lane_now());
        } else { int b, hj, NT; size_t qrow;
            if (U < ng + 1024) { const int V = U - ng, qb = V & 31; hj = (V >> 5) & 7; b = V >> 8; qrow = (size_t)b * SEQ + qb * 256; NT = KVL / 64; }
            else { const int V = U - ng - 1024 - 32; hj = V & 7; b = V >> 3; qrow = (size_t)T + b * CTX; NT = CTX / 64; }
            const int hc = hj >> 1, j = hj & 1;
            if (nomaxd) attn_unit_v128<8, true>(QC + qrow * 512 + hj * 64, 512, KC + (size_t)b * KVL * 512 + hj * 64, 512, VC + (size_t)b * KVL * 512 + hc * 128, 512, DO + (size_t)j * R * 512 + qrow * 512 + hc * 128, 512, NT, (char*)lds_generic + RING_OFF, (X.wave << 6) | lane_now());
            else attn_unit_v128<8, false>(QC + qrow * 512 + hj * 64, 512, KC + (size_t)b * KVL * 512 + hj * 64, 512, VC + (size_t)b * KVL * 512 + hc * 128, 512, DO + (size_t)j * R * 512 + qrow * 512 + hc * 128, 512, NT, (char*)lds_generic + RING_OFF, (X.wave << 6) | lane_now());
        }
        ATT_CV();
    }
    while (cvk < CV_IN_ATT) ATT_CV();
#undef ATT_CV
}

__device__ __forceinline__ bool grid_bar_fn(const XcdBarrier& bar, int tid) { XcdBarrier b2_ = bar; asm volatile("" : "+s"(b2_.x)); xcd_barrier(b2_, tid); return true; }
constexpr int PH_PER_LAYER = 12, N_PHASES = 2 + DEPTH * PH_PER_LAYER;
__global__ void __launch_bounds__(NWAVES * 64, 2) fwd_kernel(Args args) {
    extern __shared__ __attribute__((aligned(16))) unsigned char lds[];
    Ctx X;
    const int wave0 = __builtin_amdgcn_readfirstlane((int)threadIdx.x >> 6);
#define MK_TID() ({ int l_; asm volatile("v_mbcnt_lo_u32_b32 %0, -1, 0\n\tv_mbcnt_hi_u32_b32 %0, -1, %0" : "=v"(l_)); (wave0 << 6) | l_; })
    X.lds = (LAS unsigned char*)lds; X.tid = MK_TID(); X.lane = X.tid & 63; X.wave = wave0;
    X.G = gridDim.x; { const int bx = blockIdx.x; X.vcu = (X.G % 8 == 0) ? (bx % 8) * (X.G / 8) + bx / 8 : bx; }
    X.ws = args.ws;
    gu32* ctl = (gu32*)(args.ws + WS_CTL);
    volatile LAS unsigned* MISC = (volatile LAS unsigned*)(X.lds + MISC_OFF);
    for (int u = X.tid; u < (LDS_BYTES - LDSCTL_OFF) / 4; u += NWAVES * 64) ((LAS unsigned*)(X.lds + LDSCTL_OFF))[u] = 0u;
    __syncthreads();
#if MK_PER_PHASE
#define GRID_BAR() do { } while (0)
#else
    XcdBarrier bar = xcd_barrier_post((unsigned*)(ctl + CW_BAR), MISC + 8, X.tid);
#define GRID_BAR() ((void)grid_bar_fn(bar, MK_TID()))
#endif
#if MK_PER_PHASE
    const int lo = args.ph_lo, hi = args.ph_hi;
#endif
    CArgs A = (CArgs)__builtin_amdgcn_kernarg_segment_ptr(); int bx_ = (int)blockIdx.x;
#define OPQ() do { int t_ = MK_TID(); asm volatile("" : "+v"(t_)); X.tid = t_; X.lane = t_ & 63; X.wave = wave0; unsigned long long w_ = (unsigned long long)args.ws; asm volatile("" : "+s"(w_)); X.ws = (unsigned char*)(GAS unsigned char*)w_; A = (CArgs)__builtin_amdgcn_kernarg_segment_ptr(); asm volatile("" : "+s"(A)); bx_ = (int)blockIdx.x; asm volatile("" : "+s"(bx_)); } while (0)
#if MK_PER_PHASE
#define IN(k) (lo <= (k) && (k) < hi)
#else
#define IN(k) true
#endif
#ifdef MK_REP_MASK
#define REP(k) for (int rep_ = 0; rep_ <= ((MK_REP_MASK >> (k)) & 1); ++rep_) if (rep_ ? grid_bar_fn(bar, MK_TID()) : true)
#else
#define REP(k)
#endif
#define SEAM(k) do { if (IN(k) && IN((k) + 1)) GRID_BAR(); } while (0)
#define SA ((pg8::bf16_t*)(X.ws + WS_SA))

    REP(12) { if (IN(0)) { OPQ(); ph_prologue(X, A); } } SEAM(0);
    REP(13) { if (IN(1)) { OPQ(); ph_make_xh0(X, A); } } SEAM(1);

    for (int l = 0; l < DEPTH; ++l) {
        const int P = 2 + l * PH_PER_LAYER; const bool need_ctx = l < DEPTH - 1; const int nrows = need_ctx ? R : T;
        REP(0) { if (IN(P + 0)) { OPQ();
            { pg8::Gemm g{SA, (const pg8::bf16_t*)(X.ws + WS_WIN) + (size_t)l * DIN * D, R, 3328, D, nullptr};
              pg8::PlainOrder S{R / 256, 13, X.G, bx_};
              pg8::EpiInProj E{X.ws, inp(A, I_AQN) + l * 64, inp(A, I_AKN) + l * 64, (unsigned*)(X.ws + WS_CTL) + CW_NRM + 2 * l};
              pg8::gemm_phase<pg8::EpiInProj, pg8::PlainOrder, true, true>(X.lds + RING_OFF, g, S, E, X.tid); }
            OPQ();
            { pg8::Gemm g{(const pg8::bf16_t*)(X.ws + WS_XH8), (const pg8::bf16_t*)(X.ws + WS_WIN) + (size_t)l * DIN * D + (size_t)3328 * D, R, 3072, D / 2, nullptr};
              pg8::PlainOrder S{R / 256, 12, X.G, X.G - 1 - bx_};
              pg8::EpiGate8 E{X.ws + WS_GM, 1.0f / WSC_GU};
              pg8::gemm_phase<pg8::EpiGate8, pg8::PlainOrder, true, true, true>(X.lds + RING_OFF, g, S, E, X.tid); }
        } }
        SEAM(P + 0);
        REP(1) { if (IN(P + 1)) { OPQ(); ph_lru<1>(X, A, l, need_ctx); } }
#if MK_PER_PHASE
        SEAM(P + 1);
#endif
        REP(2) { if (IN(P + 2)) { OPQ(); ph_attention(X, A, l, lds, need_ctx); } } SEAM(P + 2);
        REP(3) { if (IN(P + 3)) { OPQ(); ph_lru<2>(X, A, l, need_ctx); ph_diff_combine(X, A, l, nrows); } } SEAM(P + 3);
        REP(4) { if (IN(P + 4)) { OPQ();
            pg8::Gemm g{(const pg8::bf16_t*)(X.ws + WS_BR), (const pg8::bf16_t*)(X.ws + WS_WBR) + (size_t)l * 3 * 1024 * 512, 3 * R, 3 * 1024, 512, nullptr};
            pg8::MergeOrder S{nrows / 256, X.G, bx_};
            pg8::EpiMerge E{(const unsigned char*)(X.ws + WS_GM), SA};
            pg8::gemm_phase<pg8::EpiMerge, pg8::MergeOrder, true, true>(X.lds + RING_OFF, g, S, E, X.tid);
        } }
        SEAM(P + 4);
        REP(5) { if (IN(P + 5)) { OPQ();
            pg8::Gemm g{SA, (const pg8::bf16_t*)(X.ws + WS_WOUT) + (size_t)l * D * D, R, D, D, nullptr};
            pg8::PlainOrder S{nrows / 256, 4, X.G, bx_};
            pg8::EpiBf16Out E{(pg8::bf16_t*)(X.ws + WS_GM), D, 1.0f};
            pg8::gemm_phase<pg8::EpiBf16Out, pg8::PlainOrder, true, true>(X.lds + RING_OFF, g, S, E, X.tid);
        } }
        SEAM(P + 5);
        REP(6) { if (IN(P + 6)) { OPQ(); ph_ln1_router(X, A, l, nrows); } } SEAM(P + 6);
        REP(7) { if (IN(P + 7)) { OPQ(); ph_topk_convert(X, A, l, need_ctx); } } do { if (IN(P + 7) && IN(P + 9)) GRID_BAR(); } while (0);
        REP(9) { if (IN(P + 9)) { OPQ();
            pg8::Gemm g{(const pg8::bf16_t*)(X.ws + WS_SA), (const pg8::bf16_t*)(X.ws + WS_WGU), MROWS, NE * 5632, D / 2, (const int*)(X.ws + WS_SRC)};
            pg8::MoeOrder S{need_ctx ? 17 : 16, 22, X.G, bx_};
            pg8::EpiGateUp8 E{X.ws + WS_ACT, 1.0f / WSC_GU};
            pg8::gemm_phase<pg8::EpiGateUp8, pg8::MoeOrder, true, true, true, true>(X.lds + RING_OFF, g, S, E, X.tid);
        } }
        SEAM(P + 9);
        REP(10) { if (IN(P + 10)) { OPQ();
            pg8::Gemm g{(const pg8::bf16_t*)(X.ws + WS_ACT), (const pg8::bf16_t*)(X.ws + WS_WD), MROWS, NE * 1024, FFP / 2, nullptr};
            pg8::MoeOrder S{need_ctx ? 17 : 16, 4, X.G, bx_};
            pg8::EpiBf16Out E{(pg8::bf16_t*)(X.ws + WS_EO), D, 1.0f / WSC_D};
            pg8::gemm_phase<pg8::EpiBf16Out, pg8::MoeOrder, true, true, true>(X.lds + RING_OFF, g, S, E, X.tid);
        } }
        SEAM(P + 10);
        REP(11) { if (IN(P + 11)) { OPQ(); ph_ln2(X, A, l, nrows); } }
        if (l + 1 < DEPTH) SEAM(P + 11);
    }
#undef IN
#undef MK_TID
#undef REP
#undef SA
#undef OPQ
#undef SEAM
#undef GRID_BAR
}

extern "C" void kernel_launch(void* const* d_in, const int* in_sizes, int n_in, void* d_out, int out_size, void* d_ws, size_t ws_size, hipStream_t stream) {
    static int grid = 0;
    if (grid == 0) {
        if (n_in != 28 || out_size != T * D || ws_size < WS_END) { fprintf(stderr, "kernel_launch: unexpected shapes: n_in %d out %d ws %zu (need %zu)\n", n_in, out_size, ws_size, (size_t)WS_END); grid = -1; return; }
        int dev = 0, cus = 0, per_cu = 0;
        if (hipGetDevice(&dev) != hipSuccess || hipDeviceGetAttribute(&cus, hipDeviceAttributeMultiprocessorCount, dev) != hipSuccess) { grid = -1; return; }
        if (hipFuncSetAttribute((const void*)fwd_kernel, hipFuncAttributeMaxDynamicSharedMemorySize, LDS_BYTES) != hipSuccess) { fprintf(stderr, "kernel_launch: hipFuncSetAttribute failed\n"); grid = -1; return; }
        if (hipOccupancyMaxActiveBlocksPerMultiprocessor(&per_cu, (const void*)fwd_kernel, NWAVES * 64, LDS_BYTES) != hipSuccess || per_cu < 1)
            fprintf(stderr, "kernel_launch: occupancy query reports %d workgroups per CU\n", per_cu);
        (void)hipGetLastError();
        grid = cus;
    }
    if (grid < 0) return;
    if (hipMemsetAsync((char*)d_ws + WS_CTL, 0, CTL_BYTES, stream) != hipSuccess) return;
    Args a{};
    for (int i = 0; i < 28; ++i) a.in[i] = (const float*)d_in[i];
    a.out = (float*)d_out; a.ws = (unsigned char*)d_ws;
#if MK_PER_PHASE
    for (int p = 0; p < N_PHASES; ++p) { a.ph_lo = p; a.ph_hi = p + 1; hipLaunchKernelGGL(fwd_kernel, dim3(grid), dim3(NWAVES * 64), LDS_BYTES, stream, a); }
#else
    a.ph_lo = 0; a.ph_hi = N_PHASES;
    hipLaunchKernelGGL(fwd_kernel, dim3(grid), dim3(NWAVES * 64), LDS_BYTES, stream, a);
#endif
    const hipError_t le = hipPeekAtLastError();
    if (le != hipSuccess) fprintf(stderr, "kernel_launch: launch failed: %s\n", hipGetErrorName(le));
}
```

```cpp
#include <hip/hip_runtime.h>
#include <hip/hip_bf16.h>
#include <cstdio>
#include <cstdint>
#include <cmath>

#ifndef MK_PER_PHASE
#define MK_PER_PHASE 0
#endif

constexpr int D = 1024, NB = 4, SEQ = 8192, CTX = 256, DEPTH = 2;
constexpr int T = NB * SEQ;
constexpr int TC = NB * CTX;
constexpr int R = T + TC;
constexpr int KVL = CTX + SEQ;
constexpr int DIN = 6400;
constexpr int NE = 16, FF = 2752, FFP = 2816, CAP = 1024, CAPC = 32;
constexpr int EROWS = 4352;
constexpr int MROWS = NE * EROWS;
constexpr float LN_EPS = 1e-5f, RMS_EPS = 1e-6f;
constexpr float DN_ALPHA = 1.41421356237309515f;
constexpr float WSC_GU = 32.0f, WSC_D = 128.0f;
constexpr float C2 = 0.125f * 1.4426950408889634f;

constexpr size_t al256(size_t x) { return (x + 255) & ~(size_t)255; }
constexpr size_t WS_CTL = 0, CTL_BYTES = 65536;
constexpr size_t WS_MOD  = WS_CTL + CTL_BYTES;
constexpr size_t WS_LRUW = al256(WS_MOD + (size_t)2 * 5 * 6144 * 4);
constexpr size_t WS_AGG  = al256(WS_LRUW + (size_t)2 * 2 * 2 * 8 * 4096 * 2);
constexpr size_t WS_AFF  = al256(WS_AGG + (size_t)4 * 2 * 66 * 512 * 8);
constexpr size_t WS_SLOT = al256(WS_AFF + (size_t)R * 16 * 4);
constexpr size_t WS_SRC  = al256(WS_SLOT + (size_t)R * 16 * 4);
constexpr size_t WS_WIN  = al256(WS_SRC + (size_t)MROWS * 4);
constexpr size_t WS_WBR  = al256(WS_WIN + (size_t)2 * DIN * D * 2);
constexpr size_t WS_WOUT = al256(WS_WBR + (size_t)2 * 3 * 1024 * 512 * 2);
constexpr size_t WS_WGU  = al256(WS_WOUT + (size_t)2 * D * D * 2);
constexpr size_t WS_WD   = al256(WS_WGU + (size_t)NE * 5632 * D * 2);
constexpr size_t WS_X1   = al256(WS_WD + (size_t)NE * D * FFP * 2);
constexpr size_t WS_X2   = al256(WS_X1 + (size_t)R * D * 4);
constexpr size_t WS_SA   = al256(WS_X2 + (size_t)R * D * 4);
constexpr size_t WS_OV   = al256(WS_SA + (size_t)R * D * 2);
constexpr size_t WS_QA = WS_OV;
constexpr size_t WS_KA = al256(WS_QA + (size_t)R * 512 * 2);
constexpr size_t WS_VA = al256(WS_KA + (size_t)R * 128 * 2);
constexpr size_t WS_XB = al256(WS_VA + (size_t)R * 128 * 2);
constexpr size_t WS_GB = al256(WS_XB + (size_t)R * 512 * 2);
constexpr size_t WS_QC = al256(WS_GB + (size_t)R * 512 * 2);
constexpr size_t WS_KC = al256(WS_QC + (size_t)R * 512 * 2);
constexpr size_t WS_VC = al256(WS_KC + (size_t)R * 512 * 2);
constexpr size_t WS_GM = al256(WS_VC + (size_t)R * 512 * 2);
constexpr size_t WS_BR = al256(WS_GM + (size_t)R * 3072 * 2);
constexpr size_t WS_DO = al256(WS_BR + (size_t)3 * R * 512 * 2);
constexpr size_t WS_MM32 = al256(WS_DO + (size_t)2 * R * 512 * 2);
constexpr size_t WS_MIX_END = al256(WS_MM32 + (size_t)R * D * 4);
constexpr size_t WS_XH8 = WS_MIX_END - al256((size_t)R * D);
constexpr size_t WS_XG  = WS_OV;
constexpr size_t WS_ACT = al256(WS_XG + (size_t)MROWS * D * 2);
constexpr size_t WS_EO  = al256(WS_ACT + (size_t)MROWS * FFP * 2);
constexpr size_t WS_MOE_END = al256(WS_EO + (size_t)MROWS * D * 2);
constexpr size_t WS_END = WS_MIX_END > WS_MOE_END ? WS_MIX_END : WS_MOE_END;
static_assert(WS_END <= (size_t)1442840576, "d_ws map exceeds 4 x largest tensor");
static_assert(WS_XH8 >= WS_MOE_END, "XH8 is written while the MoE outputs are read");
static_assert((size_t)R * D * 4 <= (size_t)R * 3072 * 2, "O32 fits in GM's place");

constexpr int CW_TMO = 0, CW_BAR = 1024, CW_NRM = 8192;

constexpr int RING_OFF = 0, RING_BYTES = 131072;
constexpr int LDSCTL_OFF = RING_BYTES, MISC_OFF = LDSCTL_OFF + 320;
constexpr int LDS_BYTES = 147456;
constexpr int NWAVES = 8;

#define GAS __attribute__((address_space(1)))
#define LAS __attribute__((address_space(3)))
typedef unsigned short bf16;
typedef unsigned v4u __attribute__((ext_vector_type(4)));
typedef unsigned v2u __attribute__((ext_vector_type(2)));
typedef float f32x4 __attribute__((ext_vector_type(4)));
typedef float f32x2 __attribute__((ext_vector_type(2)));
typedef short bf16x8 __attribute__((ext_vector_type(8)));
typedef GAS unsigned gu32;
#define RLX_AGENT __ATOMIC_RELAXED, __HIP_MEMORY_SCOPE_AGENT
#define LDS_WAIT() asm volatile("s_waitcnt lgkmcnt(0)" ::: "memory")
#define VM_WAIT() asm volatile("s_waitcnt vmcnt(0)" ::: "memory")
typedef float f32x2_cv __attribute__((ext_vector_type(2))); typedef __bf16 bf16x2_cv __attribute__((ext_vector_type(2)));
__device__ __forceinline__ unsigned cvt_pk_bf16(float lo, float hi) { const f32x2_cv v = {lo, hi}; const bf16x2_cv b = __builtin_convertvector(v, bf16x2_cv); return __builtin_bit_cast(unsigned, b); }
__device__ __forceinline__ float bf_lo(unsigned w) { return __uint_as_float(w << 16); }
__device__ __forceinline__ float bf_hi(unsigned w) { return __uint_as_float(w & 0xffff0000u); }
__device__ __forceinline__ float fast_exp(float x) { return __builtin_amdgcn_exp2f(x * 1.4426950408889634f); }
__device__ __forceinline__ float sigmoid_f(float x) { return __builtin_amdgcn_rcpf(1.0f + fast_exp(-x)); }
__device__ __forceinline__ float silu_f(float x) { return x * sigmoid_f(x); }
__device__ __forceinline__ float gelu_tanh_f(float x) { const float z = 0.7978845608028654f * (x + 0.044715f * x * x * x); return x * sigmoid_f(2.0f * z); }
__device__ __forceinline__ float wave_sum(float v) {
#pragma unroll
    for (int o = 1; o < 64; o <<= 1) v += __shfl_xor(v, o);
    return v;
}
template <class Tp> __device__ __forceinline__ Tp* uni(Tp* p) { const unsigned long long v = (unsigned long long)p;
    const unsigned lo = __builtin_amdgcn_readfirstlane((unsigned)v), hi = __builtin_amdgcn_readfirstlane((unsigned)(v >> 32));
    return (Tp*)(GAS Tp*)(((unsigned long long)hi << 32) | lo); }
namespace pg8 {
#define PG8_LAS __attribute__((address_space(3)))
typedef unsigned short bf16_t;
typedef short bf16x8 __attribute__((ext_vector_type(8)));
typedef float f32x4 __attribute__((ext_vector_type(4)));
typedef unsigned u32x4 __attribute__((ext_vector_type(4)));
constexpr int BM = 256, BK = 64, HALF = 128, HTB = HALF * BK * 2  , STAGE_BYTES = 8 * HTB, NXCD = 8, WGM = 8;

__host__ __device__ __forceinline__ int lds_byte(int r, int c) { const int st = (r >> 4) * 2 + (c >> 5), rr = r & 15, cc = c & 31, ob = rr * 64 + cc * 2; return st * 1024 + (ob ^ (((ob >> 9) & 1) << 5)); }
__host__ __device__ __forceinline__ void stage_rc(int b, int& R, int& C) { const int st = b / 1024, sb = b % 1024, swz = sb ^ (((sb >> 9) & 1) << 5); R = (st >> 1) * 16 + swz / 64; C = (st & 1) * 32 + (swz % 64) / 2; }
__host__ __device__ __forceinline__ int perm32(int rho) { const int n = rho >> 4, i = rho & 15; return 8 * (i >> 2) + 4 * n + (i & 3); }

struct Unit { int pm, pn, aux; };
struct Gemm { const bf16_t* A; const bf16_t* Bt; int M, N, K; const int* rowsrc; };

struct StaticOrder {
    int nM, nN, nwg, G, c;
    __host__ __device__ void init(int M, int N, int G_, int c_) { nM = M / BM; nN = N / BM; nwg = nM * nN; G = G_; c = c_; }
    __host__ __device__ bool next(int i, Unit& u) const {
        const long L = (long)i * G + c; if (L >= nwg) return false;
        int wgid = (int)L; { const int q = nwg / NXCD, r = nwg % NXCD, xcd = wgid % NXCD, off = wgid / NXCD; wgid = (xcd < r ? xcd * (q + 1) : r * (q + 1) + (xcd - r) * q) + off; }
        const int nig = WGM * nN, gid = wgid / nig, fm = gid * WGM, gsz = (nM - fm) < WGM ? (nM - fm) : WGM;
        u.pm = fm + ((wgid % nig) % gsz); u.pn = (wgid % nig) / gsz; return true;
    }
    __device__ __forceinline__ void a_ready(const Unit&) const {}
    __device__ __forceinline__ void done(const Unit&) const {}
};

typedef float f32x2 __attribute__((ext_vector_type(2)));

template <class Epi, class Sched, bool ALIGN_EPI = false, bool SP2 = false, bool F8 = false, bool GATHER = false>
__device__ __forceinline__ void gemm_phase(PG8_LAS unsigned char* lds, const Gemm g, const Sched& S, const Epi& E, const int tid_in) {
    int tid_ = tid_in; asm volatile("" : "+v"(tid_));
    const int tid = tid_, wid = __builtin_amdgcn_readfirstlane(tid >> 6), lane = tid & 63, wr = wid >> 2, wc = wid & 3, fr = lane & 15, fq = lane >> 4;
    const int K = g.K, nt = K / BK;
    unsigned voffA[2], voffB[2];
#pragma unroll
    for (int i = 0; i < 2; ++i) { int R, C; stage_rc(tid * 16 + i * 8192, R, C); const int Rb = Epi::PERM ? ((R & ~31) + perm32(R & 31)) : R;
        voffA[i] = (unsigned)(R * K + C) * 2u; voffB[i] = (unsigned)(Rb * K + C) * 2u; }
    const size_t kstep = (size_t)(BK * 2);
    static_assert(!GATHER || SP2, "GATHER is written for the SP2 loop");
    int grow[2]; { int R0, C0, R1, C1; stage_rc(tid * 16, R0, C0); stage_rc(tid * 16 + 8192, R1, C1); grow[0] = R0; grow[1] = R1; }
    unsigned gcol[2]; { gcol[0] = voffA[0] - (unsigned)(grow[0] * K) * 2u; gcol[1] = voffA[1] - (unsigned)(grow[1] * K) * 2u; }
    unsigned vC[2][2], vN[2][2];
    constexpr int GIDX_OFF = STAGE_BYTES + 1024;
    const size_t hstep = (size_t)HALF * K * 2;
    const size_t tstep = 2 * hstep;
    const unsigned ldsw = (unsigned)wid * 1024u;
    const int aoff = lds_byte(wr * 64 + fr, fq * 8), boff = lds_byte(wc * 32 + fr, fq * 8);
#define PG8_SA(b, h) (((b) * 2 + (h)) * HTB)
#define PG8_SB(b, h) ((4 + (b) * 2 + (h)) * HTB)
#define PG8_STAGE(bufoff, gbase, voff) do { _Pragma("unroll") for (int _i = 0; _i < 2; ++_i) \
        __builtin_amdgcn_global_load_lds((const unsigned*)((const char*)(gbase) + (voff)[_i]), (PG8_LAS unsigned*)(lds + (bufoff) + ldsw + _i * 8192), 16, 0, 0); } while (0)
#define PG8_LDA(dst, b, h) do { if constexpr (F8) { _Pragma("unroll") for (int m = 0; m < 4; ++m) dst##8[m] = __builtin_shufflevector(*(const PG8_LAS v4i_*)(lds + PG8_SA(b, h) + aoff + m * 2048), *(const PG8_LAS v4i_*)(lds + PG8_SA(b, h) + aoff + m * 2048 + 1024), 0, 1, 2, 3, 4, 5, 6, 7); } \
        else { _Pragma("unroll") for (int m = 0; m < 4; ++m) _Pragma("unroll") for (int k = 0; k < 2; ++k) dst[m][k] = *(const PG8_LAS bf16x8*)(lds + PG8_SA(b, h) + aoff + m * 2048 + k * 1024); } } while (0)
#define PG8_LDB(dst, b, h) do { if constexpr (F8) { _Pragma("unroll") for (int n = 0; n < 2; ++n) dst##8[n] = __builtin_shufflevector(*(const PG8_LAS v4i_*)(lds + PG8_SB(b, h) + boff + n * 2048), *(const PG8_LAS v4i_*)(lds + PG8_SB(b, h) + boff + n * 2048 + 1024), 0, 1, 2, 3, 4, 5, 6, 7); } \
        else { _Pragma("unroll") for (int n = 0; n < 2; ++n) _Pragma("unroll") for (int k = 0; k < 2; ++k) dst[n][k] = *(const PG8_LAS bf16x8*)(lds + PG8_SB(b, h) + boff + n * 2048 + k * 1024); } } while (0)
#define PG8_MMA(ai, bj, At, Bt) do { if constexpr (F8) __builtin_amdgcn_sched_barrier(0); __builtin_amdgcn_s_setprio(1); \
        if constexpr (F8) { _Pragma("unroll") for (int m = 0; m < 4; ++m) _Pragma("unroll") for (int n = 0; n < 2; ++n) \
            acc[ai][bj][m][n] = __builtin_amdgcn_mfma_scale_f32_16x16x128_f8f6f4(Bt##8[n], At##8[m], acc[ai][bj][m][n], 0, 0, 0, 0x7f7f7f7f, 0, 0x7f7f7f7f); } \
        else { _Pragma("unroll") for (int m = 0; m < 4; ++m) _Pragma("unroll") for (int n = 0; n < 2; ++n) _Pragma("unroll") for (int k = 0; k < 2; ++k) \
            acc[ai][bj][m][n] = __builtin_amdgcn_mfma_f32_16x16x32_bf16(Bt[n][k], At[m][k], acc[ai][bj][m][n], 0, 0, 0); } \
        __builtin_amdgcn_s_setprio(0); \
        if constexpr (F8) { _Pragma("unroll") for (int m = 0; m < 4; ++m) asm volatile("" : "+v"(acc[ai][bj][m][0]), "+v"(acc[ai][bj][m][1]));     \
            __builtin_amdgcn_sched_barrier(0); } } while (0)
#define PG8_WAIT_V(n) asm volatile("s_waitcnt vmcnt(" #n ")" ::: "memory")
#define PG8_WAIT_L(n) asm volatile("s_waitcnt lgkmcnt(" #n ")" ::: "memory")
#define PG8_BAR __builtin_amdgcn_s_barrier()
#define PG8_SCHED __builtin_amdgcn_sched_barrier(0)
    Unit cur, nxt; int ui = 0;
    if (!S.next(0, cur)) return;
    f32x4 acc[2][2][4][2];
#pragma unroll
    for (int a = 0; a < 2; ++a)
#pragma unroll
        for (int b = 0; b < 2; ++b)
#pragma unroll
            for (int m = 0; m < 4; ++m)
#pragma unroll
                for (int n = 0; n < 2; ++n) acc[a][b][m][n] = (f32x4){0.f, 0.f, 0.f, 0.f};
    typedef int v4i_ __attribute__((ext_vector_type(4))); typedef int v8i_ __attribute__((ext_vector_type(8)));
    bf16x8 At[4][2], B0[2][2], B1[2][2]; v8i_ At8[4], B08[2], B18[2];
    const char* cA = (const char*)g.A + (GATHER ? (size_t)0 : (size_t)cur.pm * tstep); const char* cB = (const char*)g.Bt + (size_t)cur.pn * tstep;
    if constexpr (GATHER) {
#pragma unroll
        for (int h = 0; h < 2; ++h)
#pragma unroll
            for (int i = 0; i < 2; ++i) { int r = g.rowsrc[cur.pm * BM + h * HALF + grow[i]]; r = r < 0 ? 0 : r; vC[h][i] = (unsigned)r * (unsigned)(K * 2) + gcol[i]; vN[h][i] = vC[h][i]; }
    }
#define PG8_STAGEA(bufoff, gbase, h, vsel) do { if constexpr (GATHER) { PG8_STAGE(bufoff, gbase, vsel[h]); } else { PG8_STAGE(bufoff, (gbase) + (h) * hstep, voffA); } } while (0)
    S.a_ready(cur);
    if constexpr (SP2) {
        PG8_STAGE(PG8_SB(0, 0), cB, voffB); PG8_STAGE(PG8_SB(0, 1), cB + hstep, voffB); PG8_STAGEA(PG8_SA(0, 0), cA, 0, vC); PG8_STAGEA(PG8_SA(0, 1), cA, 1, vC);
        if (wr == 1) PG8_BAR;
        PG8_WAIT_V(2); PG8_BAR;
        PG8_STAGE(PG8_SB(1, 0), cB + kstep, voffB); PG8_STAGEA(PG8_SA(1, 0), cA + kstep, 0, vC); PG8_STAGE(PG8_SB(1, 1), cB + hstep + kstep, voffB);
        PG8_WAIT_V(6); PG8_BAR;
    } else {
        PG8_STAGE(PG8_SB(0, 0), cB, voffB); PG8_STAGE(PG8_SA(0, 0), cA, voffA); PG8_STAGE(PG8_SB(0, 1), cB + hstep, voffB); PG8_STAGE(PG8_SA(0, 1), cA + hstep, voffA);
        if (wr == 1) PG8_BAR;
        PG8_WAIT_V(4); PG8_BAR;
        PG8_STAGE(PG8_SB(1, 0), cB + kstep, voffB); PG8_STAGE(PG8_SA(1, 0), cA + kstep, voffA); PG8_STAGE(PG8_SB(1, 1), cB + hstep + kstep, voffB);
        PG8_WAIT_V(6); PG8_BAR;
    }
    for (;;) {
        const bool has_next = S.next(ui + 1, nxt);
        const char* nA = (has_next && !GATHER) ? (const char*)g.A + (size_t)nxt.pm * tstep : cA; const char* nB = has_next ? (const char*)g.Bt + (size_t)nxt.pn * tstep : cB;
        if constexpr (GATHER) { if (has_next) {
#pragma unroll
            for (int h = 0; h < 2; ++h)
#pragma unroll
                for (int i = 0; i < 2; ++i) __builtin_amdgcn_global_load_lds((const unsigned*)(g.rowsrc + (nxt.pm * BM + h * HALF + grow[i])), (PG8_LAS unsigned*)(lds + GIDX_OFF + ((h * 2 + i) * 8 + wid) * 256), 4, 0, 0); } }
        for (int t = 0; t < nt; t += 2) {
            const bool last = (t == nt - 2);
            const char* a1 = cA + (size_t)(t + 1) * kstep;
            const char* a2 = last ? nA : cA + (size_t)(t + 2) * kstep; const char* b2 = last ? nB : cB + (size_t)(t + 2) * kstep;
            const char* a3 = a2 + kstep; const char* b3 = b2 + kstep;
            if (last && has_next) S.a_ready(nxt);
            unsigned vS[2][2];
            if constexpr (GATHER) {
                if (last && has_next) {
                    asm volatile("s_waitcnt vmcnt(8)" ::: "memory");
#pragma unroll
                    for (int h = 0; h < 2; ++h)
#pragma unroll
                        for (int i = 0; i < 2; ++i) { int r = *(const volatile PG8_LAS int*)(lds + GIDX_OFF + ((h * 2 + i) * 8 + wid) * 256 + lane * 4); r = r < 0 ? 0 : r; vN[h][i] = (unsigned)r * (unsigned)(K * 2) + gcol[i]; }
                }
#pragma unroll
                for (int h = 0; h < 2; ++h)
#pragma unroll
                    for (int i = 0; i < 2; ++i) vS[h][i] = (last && has_next) ? vN[h][i] : vC[h][i];
            }
            if constexpr (SP2) {
            PG8_LDB(B0, 0, 0); PG8_LDB(B1, 0, 1); PG8_SCHED; PG8_LDA(At, 0, 0); PG8_STAGEA(PG8_SA(1, 1), a1, 1, vC);
            PG8_WAIT_V(8); PG8_WAIT_L(0); PG8_BAR; PG8_MMA(0, 0, At, B0); PG8_MMA(0, 1, At, B1); PG8_BAR; PG8_SCHED;
            PG8_LDA(At, 0, 1); PG8_STAGE(PG8_SB(0, 0), b2, voffB); PG8_STAGE(PG8_SB(0, 1), b2 + hstep, voffB); PG8_STAGEA(PG8_SA(0, 0), a2, 0, vS);
            PG8_WAIT_V(8); PG8_WAIT_L(0); PG8_BAR; PG8_MMA(1, 0, At, B0); PG8_MMA(1, 1, At, B1); PG8_BAR; PG8_SCHED;
            PG8_LDB(B0, 1, 0); PG8_LDB(B1, 1, 1); PG8_SCHED; PG8_LDA(At, 1, 0); PG8_STAGEA(PG8_SA(0, 1), a2, 1, vS);
            PG8_WAIT_V(8); PG8_WAIT_L(0); PG8_BAR; PG8_MMA(0, 0, At, B0); PG8_MMA(0, 1, At, B1); PG8_BAR; PG8_SCHED;
            PG8_LDA(At, 1, 1); PG8_STAGE(PG8_SB(1, 0), b3, voffB); PG8_STAGE(PG8_SB(1, 1), b3 + hstep, voffB); PG8_STAGEA(PG8_SA(1, 0), a3, 0, vS);
            PG8_WAIT_V(8); PG8_WAIT_L(0); PG8_BAR; PG8_MMA(1, 0, At, B0); PG8_MMA(1, 1, At, B1); PG8_BAR; PG8_SCHED;
            } else {
            PG8_LDB(B0, 0, 0); PG8_SCHED; PG8_LDA(At, 0, 0); PG8_STAGE(PG8_SA(1, 1), a1 + hstep, voffA);
            PG8_WAIT_L(8); PG8_BAR; PG8_WAIT_L(0); PG8_MMA(0, 0, At, B0); PG8_BAR; PG8_SCHED;
            PG8_LDB(B1, 0, 1); PG8_STAGE(PG8_SB(0, 0), b2, voffB);
            PG8_BAR; PG8_WAIT_L(0); PG8_MMA(0, 1, At, B1); PG8_BAR;
            PG8_LDA(At, 0, 1); PG8_STAGE(PG8_SA(0, 0), a2, voffA);
            PG8_BAR; PG8_WAIT_L(0); PG8_MMA(1, 0, At, B0); PG8_BAR; PG8_SCHED;
            PG8_STAGE(PG8_SB(0, 1), b2 + hstep, voffB);
            PG8_WAIT_V(6); PG8_BAR; PG8_MMA(1, 1, At, B1); PG8_BAR;
            PG8_LDB(B0, 1, 0); PG8_SCHED; PG8_LDA(At, 1, 0); PG8_STAGE(PG8_SA(0, 1), a2 + hstep, voffA);
            PG8_WAIT_L(8); PG8_BAR; PG8_WAIT_L(0); PG8_MMA(0, 0, At, B0); PG8_BAR; PG8_SCHED;
            PG8_LDB(B1, 1, 1); PG8_STAGE(PG8_SB(1, 0), b3, voffB);
            PG8_BAR; PG8_WAIT_L(0); PG8_MMA(0, 1, At, B1); PG8_BAR;
            PG8_LDA(At, 1, 1); PG8_STAGE(PG8_SA(1, 0), a3, voffA);
            PG8_BAR; PG8_WAIT_L(0); PG8_MMA(1, 0, At, B0); PG8_BAR; PG8_SCHED;
            PG8_STAGE(PG8_SB(1, 1), b3 + hstep, voffB);
            PG8_WAIT_V(6); PG8_BAR; PG8_MMA(1, 1, At, B1); PG8_BAR;
            }
        }
        if constexpr (ALIGN_EPI) { if (wr == 0) PG8_BAR; }
        if constexpr (!Epi::AFTER_DRAIN) { E(acc, cur, wr, wc, fr, fq); S.done(cur); }
        if (!has_next) break;
        if constexpr (!Epi::CHAIN) {
#pragma unroll
        for (int a = 0; a < 2; ++a)
#pragma unroll
            for (int b = 0; b < 2; ++b)
#pragma unroll
                for (int m = 0; m < 4; ++m)
#pragma unroll
                    for (int n = 0; n < 2; ++n) acc[a][b][m][n] = (f32x4){0.f, 0.f, 0.f, 0.f};
        }
        cur = nxt; cA = nA; cB = nB; ++ui;
        if constexpr (GATHER) {
#pragma unroll
            for (int h = 0; h < 2; ++h)
#pragma unroll
                for (int i = 0; i < 2; ++i) vC[h][i] = vN[h][i]; }
        if constexpr (ALIGN_EPI) { if (wr == 1) PG8_BAR; }
    }
    PG8_WAIT_V(0);
    if constexpr (!ALIGN_EPI) { if (wr == 0) PG8_BAR; }
    PG8_BAR;
    if constexpr (Epi::AFTER_DRAIN) { E.fused(acc, cur, wr, wc, fr, fq, lds, wid, lane); S.done(cur); }
#undef PG8_SA
#undef PG8_SB
#undef PG8_STAGE
#undef PG8_STAGEA
#undef PG8_LDA
#undef PG8_LDB
#undef PG8_MMA
#undef PG8_WAIT_V
#undef PG8_WAIT_L
#undef PG8_BAR
#undef PG8_SCHED
}
}

namespace pg8 {
__device__ __forceinline__ void map_tile(int L, int nM, int nN, int& pm, int& pn) {
    const int nwg = nM * nN; int wgid = L;
    { const int q = nwg / NXCD, r = nwg % NXCD, xcd = wgid % NXCD, off = wgid / NXCD; wgid = (xcd < r ? xcd * (q + 1) : r * (q + 1) + (xcd - r) * q) + off; }
    const int nig = WGM * nN, gid = wgid / nig, fm = gid * WGM, gsz = (nM - fm) < WGM ? (nM - fm) : WGM;
    pm = fm + ((wgid % nig) % gsz); pn = (wgid % nig) / gsz;
}
struct PlainOrder {
    int nM, nN, G, c;
    __device__ __forceinline__ bool next(int i, Unit& u) const { const long L = (long)i * G + c; if (L >= (long)nM * nN) return false; map_tile((int)L, nM, nN, u.pm, u.pn); u.aux = u.pn; return true; }
    __device__ __forceinline__ void a_ready(const Unit&) const {}
    __device__ __forceinline__ void done(const Unit&) const {}
};
struct MergeOrder {
    int nM, G, c;
    __device__ __forceinline__ bool next(int i, Unit& u) const { const int tr = i / 3, n = i - 3 * tr; const long L = (long)tr * G + c; if (L >= (long)nM * 4) return false;
        int pm, pn; map_tile((int)L, nM, 4, pm, pn); u.pm = n * (R / 256) + pm; u.pn = n * 4 + pn; u.aux = n; return true; }
    __device__ __forceinline__ void a_ready(const Unit&) const {}
    __device__ __forceinline__ void done(const Unit&) const {}
};
struct MoeOrder {
    int PM, nN, G, c;
    __device__ __forceinline__ bool next(int i, Unit& u) const { const long L = (long)i * G + c; if (L >= (long)NE * PM * nN) return false;
        int pm, pn; map_tile((int)L, NE * PM, nN, pm, pn); const int e = pm / PM, p = pm - e * PM; u.pm = e * 17 + p; u.pn = e * nN + pn; u.aux = pn; return true; }
    __device__ __forceinline__ void a_ready(const Unit&) const {}
    __device__ __forceinline__ void done(const Unit&) const {}
};

__device__ __forceinline__ unsigned gate_q8x4(float a, float b, float c, float d) { const float sc = 255.9999f;
    return (unsigned)(a * sc) | ((unsigned)(b * sc) << 8) | ((unsigned)(c * sc) << 16) | ((unsigned)(d * sc) << 24); }
__device__ __forceinline__ float gate_c(unsigned w, int j) { return (float)((w >> (8 * j)) & 0xffu) + 0.5f; }
__device__ __forceinline__ float gate_dq(unsigned w, int j) { return (float)((w >> (8 * j)) & 0xffu) * 0.00390625f + 0.001953125f; }
struct EpiInProj {
    static constexpr bool PERM = false, AFTER_DRAIN = false, CHAIN = false;
    unsigned char* ws; const float *qn, *kn; unsigned* nrm;
    __device__ __forceinline__ void operator()(const f32x4 (&acc)[2][2][4][2], const Unit& u, int wr, int wc, int fr_, int fq_) const {
        int fr = fr_, fq = fq_; asm volatile("" : "+v"(fr), "+v"(fq));
        const int pn = u.pn;
        bf16_t* dst; int ld, colbase; bool kv = false, rope = false, gm = false; const float* gain = nullptr; float scale = 1.f; int act = 0, trk = -1; float nmx = 0.f;
        if (pn < 2)       { dst = (bf16_t*)(ws + WS_QA); ld = 512; colbase = pn * 256 + wc * 64; gain = qn; rope = true; scale = C2; }
        else if (pn == 2) { if (wc < 2) { dst = (bf16_t*)(ws + WS_KA); ld = 128; colbase = wc * 64; kv = true; gain = kn; rope = true; } else { dst = (bf16_t*)(ws + WS_VA); ld = 128; colbase = (wc - 2) * 64; kv = true; } }
        else if (pn < 5)  { dst = (bf16_t*)(ws + WS_XB); ld = 512; colbase = (pn - 3) * 256 + wc * 64; }
        else if (pn < 7)  { dst = (bf16_t*)(ws + WS_GB); ld = 512; colbase = (pn - 5) * 256 + wc * 64; act = 1; }
        else if (pn < 9)  { dst = (bf16_t*)(ws + WS_QC); ld = 512; colbase = (pn - 7) * 256 + wc * 64; rope = true; scale = C2; trk = 0; }
        else if (pn < 11) { dst = (bf16_t*)(ws + WS_KC); ld = 512; colbase = (pn - 9) * 256 + wc * 64; kv = true; rope = true; trk = 1; }
        else if (pn < 13) { dst = (bf16_t*)(ws + WS_VC); ld = 512; colbase = (pn - 11) * 256 + wc * 64; kv = true; }
        else              { dst = (bf16_t*)(ws + WS_GM); ld = 3072; colbase = (pn - 13) * 256 + wc * 32; act = 2; gm = true; }
#pragma unroll
        for (int ai = 0; ai < 2; ++ai)
#pragma unroll
            for (int m = 0; m < 4; ++m) {
                const int r = u.pm * BM + ai * HALF + wr * 64 + m * 16 + fr;
                f32x4 v[2][2];
#pragma unroll
                for (int bj = 0; bj < 2; ++bj)
#pragma unroll
                    for (int n = 0; n < 2; ++n) v[bj][n] = acc[ai][bj][m][n];
                if (gain) {
                    float ss = 0.f;
#pragma unroll
                    for (int bj = 0; bj < 2; ++bj)
#pragma unroll
                        for (int n = 0; n < 2; ++n) ss += (v[bj][n][0] * v[bj][n][0] + v[bj][n][1] * v[bj][n][1]) + (v[bj][n][2] * v[bj][n][2] + v[bj][n][3] * v[bj][n][3]);
                    ss += __shfl_xor(ss, 16); ss += __shfl_xor(ss, 32);
                    const float rinv = __builtin_amdgcn_rsqf(ss * (1.0f / 64.0f) + RMS_EPS);
#pragma unroll
                    for (int bj = 0; bj < 2; ++bj)
#pragma unroll
                        for (int n = 0; n < 2; ++n) v[bj][n] = v[bj][n] * rinv * *(const f32x4*)(gain + 32 * bj + 16 * n + 4 * fq);
                }
                if (rope && r < T) {
                    const int s = r & (SEQ - 1); const float pos[2] = {(float)(s >> 6), (float)(s & 63)};
#pragma unroll
                    for (int bj = 0; bj < 2; ++bj)
#pragma unroll
                        for (int j = 0; j < 4; ++j) {
                            const float invf = __builtin_amdgcn_exp2f(-(float)(4 * fq + j) * (13.287712379549449f / 16.0f)) * 0.15915494309189535f;
                            float rev = pos[bj] * invf; rev = rev - floorf(rev);
                            const float sn = __builtin_amdgcn_sinf(rev), cs = __builtin_amdgcn_cosf(rev);
                            const float x1 = v[bj][0][j], x2 = v[bj][1][j];
                            v[bj][0][j] = x1 * cs - x2 * sn; v[bj][1][j] = x2 * cs + x1 * sn;
                        }
                }
                if (trk >= 0) { float ss = 0.f;
#pragma unroll
                    for (int bj = 0; bj < 2; ++bj)
#pragma unroll
                        for (int n = 0; n < 2; ++n) ss += (v[bj][n][0] * v[bj][n][0] + v[bj][n][1] * v[bj][n][1]) + (v[bj][n][2] * v[bj][n][2] + v[bj][n][3] * v[bj][n][3]);
                    ss += __shfl_xor(ss, 16); ss += __shfl_xor(ss, 32); nmx = __builtin_fmaxf(nmx, ss); }
                size_t drow = (size_t)r;
                if (kv) { if (r < T) drow = (size_t)(r >> 13) * KVL + CTX + (r & (SEQ - 1)); else { const int jj = r - T; drow = (size_t)(jj >> 8) * KVL + (jj & 255); } }
                bf16_t* rowp = dst + drow * ld + colbase + 4 * fq;
                if (gm) {
                    unsigned char* gp = (unsigned char*)dst + drow * 3072 + colbase + 8 * fq;
#pragma unroll
                    for (int bj = 0; bj < 2; ++bj) { const f32x4 a0 = v[bj][0], a1 = v[bj][1];
                        v2u w; w.x = gate_q8x4(sigmoid_f(a0[0]), sigmoid_f(a0[1]), sigmoid_f(a0[2]), sigmoid_f(a0[3])); w.y = gate_q8x4(sigmoid_f(a1[0]), sigmoid_f(a1[1]), sigmoid_f(a1[2]), sigmoid_f(a1[3]));
                        *(v2u*)(gp + bj * HALF) = w; }
                } else
#pragma unroll
                for (int bj = 0; bj < 2; ++bj)
#pragma unroll
                    for (int n = 0; n < 2; ++n) {
                        f32x4 o = v[bj][n] * scale;
                        if (act == 1) { o[0] = gelu_tanh_f(o[0]); o[1] = gelu_tanh_f(o[1]); o[2] = gelu_tanh_f(o[2]); o[3] = gelu_tanh_f(o[3]); }
                        if (act == 2) { o[0] = sigmoid_f(o[0]); o[1] = sigmoid_f(o[1]); o[2] = sigmoid_f(o[2]); o[3] = sigmoid_f(o[3]); }
                        v2u w; w.x = cvt_pk_bf16(o[0], o[1]); w.y = cvt_pk_bf16(o[2], o[3]);
                        *(v2u*)(rowp + 32 * bj + 16 * n) = w;
                    }
                __builtin_amdgcn_sched_barrier(0);
            }
        if (trk >= 0) { nmx = __builtin_fmaxf(nmx, __shfl_xor(nmx, 1)); nmx = __builtin_fmaxf(nmx, __shfl_xor(nmx, 2)); nmx = __builtin_fmaxf(nmx, __shfl_xor(nmx, 4)); nmx = __builtin_fmaxf(nmx, __shfl_xor(nmx, 8));
            if (fr == 0 && fq == 0) (void)__hip_atomic_fetch_max(nrm + trk, __float_as_uint(nmx), __ATOMIC_RELAXED, __HIP_MEMORY_SCOPE_AGENT); }
    }
};

struct EpiMerge {
    static constexpr bool PERM = true, AFTER_DRAIN = false, CHAIN = true;
    const unsigned char* GMF; bf16_t* MM;
    __device__ __forceinline__ void operator()(f32x4 (&acc)[2][2][4][2], const Unit& u, int wr, int wc, int fr, int fq) const {
        const int nb = u.aux, pm = u.pm - nb * (R / 256), pn = u.pn - nb * 4;
        const unsigned char* gt = GMF + (size_t)(pm * BM + wr * 64 + fr) * 3072 + nb * 1024 + pn * BM + wc * 32 + 8 * fq;
        const int row0 = pm * BM + wr * 64 + fr, col0 = pn * BM + wc * 32 + 8 * fq;
        constexpr int PD = 6;
        v2u ga[PD], gb[PD];
#define MG_LOAD(k_, s_) do { const int ai_ = (k_) >> 3, m_ = ((k_) >> 1) & 3, bj_ = (k_) & 1; const unsigned char* q_ = gt + (size_t)(ai_ * HALF + m_ * 16) * 3072 + bj_ * HALF; \
            ga[s_] = *(const v2u*)q_; gb[s_] = nb < 2 ? *(const v2u*)(q_ + 1024) : (v2u){0u, 0u}; } while (0)
#pragma unroll
        for (int k = 0; k < PD; ++k) MG_LOAD(k, k);
#pragma unroll
        for (int k = 0; k < 16; ++k) { const int ai = k >> 3, m = (k >> 1) & 3, bj = k & 1, s = k % PD;
            const v2u gw = ga[s], hw = gb[s];
            asm volatile("" :: "v"(gw), "v"(hw));
            if (k + PD < 16) MG_LOAD(k + PD, s);
            f32x4 o0 = acc[ai][bj][m][0], o1 = acc[ai][bj][m][1];
            if (nb < 2) {
#pragma unroll
                for (int j = 0; j < 4; ++j) { o0[j] *= gate_c(gw.x, j) * __builtin_amdgcn_rcpf(gate_c(hw.x, j)); o1[j] *= gate_c(gw.y, j) * __builtin_amdgcn_rcpf(gate_c(hw.y, j)); }
                acc[ai][bj][m][0] = o0; acc[ai][bj][m][1] = o1;
            } else {
#pragma unroll
                for (int j = 0; j < 4; ++j) { o0[j] *= gate_dq(gw.x, j); o1[j] *= gate_dq(gw.y, j); }
                u32x4 w; w.x = cvt_pk_bf16(o0[0], o0[1]); w.y = cvt_pk_bf16(o0[2], o0[3]); w.z = cvt_pk_bf16(o1[0], o1[1]); w.w = cvt_pk_bf16(o1[2], o1[3]);
                *(u32x4*)(MM + (size_t)(row0 + ai * HALF + m * 16) * 1024 + col0 + bj * HALF) = w;
                acc[ai][bj][m][0] = (f32x4){0.f, 0.f, 0.f, 0.f}; acc[ai][bj][m][1] = (f32x4){0.f, 0.f, 0.f, 0.f}; }
        }
#undef MG_LOAD
    }
};

struct EpiF32 {
    static constexpr bool PERM = false, AFTER_DRAIN = false, CHAIN = false;
    float* C; int ldc;
    __device__ __forceinline__ void operator()(const f32x4 (&acc)[2][2][4][2], const Unit& u, int wr, int wc, int fr, int fq) const {
        const int row0 = u.pm * BM + wr * 64 + fr, col0 = u.pn * BM + wc * 32 + 4 * fq;
#pragma unroll
        for (int ai = 0; ai < 2; ++ai)
#pragma unroll
            for (int m = 0; m < 4; ++m) { float* rowp = C + (size_t)(row0 + ai * HALF + m * 16) * ldc + col0;
#pragma unroll
                for (int bj = 0; bj < 2; ++bj)
#pragma unroll
                    for (int n = 0; n < 2; ++n) *(f32x4*)(rowp + bj * HALF + n * 16) = acc[ai][bj][m][n]; }
    }
};

struct EpiGateUp {
    static constexpr bool PERM = true, AFTER_DRAIN = false, CHAIN = false;
    bf16_t* ACT;
    __device__ __forceinline__ void operator()(const f32x4 (&acc)[2][2][4][2], const Unit& u, int wr, int wc, int fr, int fq) const {
        const int row0 = u.pm * BM + wr * 64 + fr, col0 = u.aux * 128 + wc * 32 + 8 * fq;
#pragma unroll
        for (int ai = 0; ai < 2; ++ai)
#pragma unroll
            for (int m = 0; m < 4; ++m) { bf16_t* rowp = ACT + (size_t)(row0 + ai * HALF + m * 16) * FFP + col0;
                const f32x4 g0 = acc[ai][0][m][0], g1 = acc[ai][0][m][1], u0 = acc[ai][1][m][0], u1 = acc[ai][1][m][1];
                u32x4 w; w.x = cvt_pk_bf16(silu_f(g0[0]) * u0[0], silu_f(g0[1]) * u0[1]); w.y = cvt_pk_bf16(silu_f(g0[2]) * u0[2], silu_f(g0[3]) * u0[3]);
                w.z = cvt_pk_bf16(silu_f(g1[0]) * u1[0], silu_f(g1[1]) * u1[1]); w.w = cvt_pk_bf16(silu_f(g1[2]) * u1[2], silu_f(g1[3]) * u1[3]);
                *(u32x4*)rowp = w; }
    }
};

__device__ __forceinline__ float clamp448(float x) { return __builtin_fminf(__builtin_fmaxf(x, -448.0f), 448.0f); }
__device__ __forceinline__ unsigned pk_fp8x4(float a, float b, float c, float d) { int w = 0; w = __builtin_amdgcn_cvt_pk_fp8_f32(clamp448(a), clamp448(b), w, false); w = __builtin_amdgcn_cvt_pk_fp8_f32(clamp448(c), clamp448(d), w, true); return (unsigned)w; }
struct EpiGateUp8 {
    static constexpr bool PERM = true, AFTER_DRAIN = false, CHAIN = false;
    unsigned char* ACT; float descale;
    __device__ __forceinline__ void operator()(const f32x4 (&acc)[2][2][4][2], const Unit& u, int wr, int wc, int fr, int fq) const {
        const int row0 = u.pm * BM + wr * 64 + fr, col0 = u.aux * 128 + wc * 32 + 8 * fq;
#pragma unroll
        for (int ai = 0; ai < 2; ++ai)
#pragma unroll
            for (int m = 0; m < 4; ++m) { unsigned char* rowp = ACT + (size_t)(row0 + ai * HALF + m * 16) * FFP + col0;
                const f32x4 g0 = acc[ai][0][m][0] * descale, g1 = acc[ai][0][m][1] * descale, u0 = acc[ai][1][m][0] * descale, u1 = acc[ai][1][m][1] * descale;
                v2u w; w.x = pk_fp8x4(silu_f(g0[0]) * u0[0], silu_f(g0[1]) * u0[1], silu_f(g0[2]) * u0[2], silu_f(g0[3]) * u0[3]);
                w.y = pk_fp8x4(silu_f(g1[0]) * u1[0], silu_f(g1[1]) * u1[1], silu_f(g1[2]) * u1[2], silu_f(g1[3]) * u1[3]);
                *(v2u*)rowp = w; }
    }
};

struct EpiGate8 {
    static constexpr bool PERM = false, AFTER_DRAIN = false, CHAIN = false;
    unsigned char* GM; float descale;
    __device__ __forceinline__ void operator()(const f32x4 (&acc)[2][2][4][2], const Unit& u, int wr, int wc, int fr, int fq) const {
        const int row0 = u.pm * BM + wr * 64 + fr, col0 = u.pn * BM + wc * 32 + 8 * fq;
#pragma unroll
        for (int ai = 0; ai < 2; ++ai)
#pragma unroll
            for (int m = 0; m < 4; ++m) { unsigned char* rowp = GM + (size_t)(row0 + ai * HALF + m * 16) * 3072 + col0;
#pragma unroll
                for (int bj = 0; bj < 2; ++bj) { const f32x4 a0 = acc[ai][bj][m][0], a1 = acc[ai][bj][m][1];
                    const float ce = -1.4426950408889634f * descale, cq = 1.0f / 255.999f;
                    unsigned q0[4], q1[4];
#pragma unroll
                    for (int j = 0; j < 4; ++j) { q0[j] = (unsigned)__builtin_amdgcn_rcpf(__builtin_fmaf(__builtin_amdgcn_exp2f(a0[j] * ce), cq, cq)); q1[j] = (unsigned)__builtin_amdgcn_rcpf(__builtin_fmaf(__builtin_amdgcn_exp2f(a1[j] * ce), cq, cq)); }
                    v2u w; w.x = q0[0] | (q0[1] << 8) | (q0[2] << 16) | (q0[3] << 24); w.y = q1[0] | (q1[1] << 8) | (q1[2] << 16) | (q1[3] << 24);
                    *(v2u*)(rowp + bj * HALF) = w; }
                __builtin_amdgcn_sched_barrier(0); }
    }
};

struct EpiBf16Out {
    static constexpr bool PERM = true, AFTER_DRAIN = false, CHAIN = false;
    bf16_t* O; int ldc; float scale;
    __device__ __forceinline__ void operator()(const f32x4 (&acc)[2][2][4][2], const Unit& u, int wr, int wc, int fr, int fq) const {
        const int row0 = u.pm * BM + wr * 64 + fr, col0 = u.aux * BM + wc * 32 + 8 * fq;
#pragma unroll
        for (int ai = 0; ai < 2; ++ai)
#pragma unroll
            for (int m = 0; m < 4; ++m) { bf16_t* rowp = O + (size_t)(row0 + ai * HALF + m * 16) * ldc + col0;
#pragma unroll
                for (int bj = 0; bj < 2; ++bj) { const f32x4 v0 = acc[ai][bj][m][0] * scale, v1 = acc[ai][bj][m][1] * scale;
                    u32x4 w; w.x = cvt_pk_bf16(v0[0], v0[1]); w.y = cvt_pk_bf16(v0[2], v0[3]); w.z = cvt_pk_bf16(v1[0], v1[1]); w.w = cvt_pk_bf16(v1[2], v1[3]);
                    *(u32x4*)(rowp + bj * HALF) = w; } }
    }
};
}
namespace attn_body {
using bf16=__hip_bfloat16;
using bf16x8=__attribute__((ext_vector_type(8)))short;
using s16x4=__attribute__((ext_vector_type(4)))short;
using f32x16=__attribute__((ext_vector_type(16)))float;
using u32x4=__attribute__((ext_vector_type(4)))unsigned;
constexpr int D=64;
constexpr int NW=8,QBLK=32,QB=QBLK*NW,KVBLK=64;
constexpr int ATTN_UNIT_ROWS=QB;
__device__ __forceinline__ int crow(int r,int hi){return (r&3)+8*(r>>2)+4*hi;}
#define SBAR() __builtin_amdgcn_sched_barrier(0)
constexpr int NSLOT=3, SLOTB=8192;
constexpr int LDS_K=0, LDS_V=NSLOT*SLOTB, LDS_WS=2*NSLOT*SLOTB, LDS_OST=LDS_WS+NW*64*4, LDS_BYTES=LDS_OST+NW*4096;
__device__ __forceinline__ void glds16(const void*gsrc,unsigned lds_dst){unsigned keep;
  asm volatile("s_mov_b32 %0, m0\n\ts_mov_b32 m0, %2\n\ts_nop 0\n\tglobal_load_lds_dwordx4 %1, off\n\ts_mov_b32 m0, %0":"=&s"(keep):"v"(gsrc),"s"(lds_dst):"memory");}
__device__ __forceinline__ float max3f(float a,float b,float c){float r;asm("v_max3_f32 %0, %1, %2, %3":"=v"(r):"v"(a),"v"(b),"v"(c));return r;}
__device__ __forceinline__ float max2f(float a,float b){float r;asm("v_max_f32_e32 %0, %1, %2":"=v"(r):"v"(a),"v"(b));return r;}
__device__ __forceinline__ float fadd_s(float a,float b){float r;asm("v_add_f32_e32 %0, %1, %2":"=v"(r):"v"(a),"v"(b));return r;}
__device__ __forceinline__ float fsub_s(float a,float b){float r;asm("v_sub_f32_e32 %0, %1, %2":"=v"(r):"v"(a),"v"(b));return r;}
typedef float f32x2_t __attribute__((ext_vector_type(2))); typedef __bf16 bf16x2_t __attribute__((ext_vector_type(2)));
__device__ __forceinline__ unsigned cvtpk_s(float lo,float hi){f32x2_t v={lo,hi};bf16x2_t b=__builtin_convertvector(v,bf16x2_t);return __builtin_bit_cast(unsigned,b);}
#define WAIT_BAR(N) asm volatile("s_waitcnt vmcnt(" #N ") lgkmcnt(0)\n\ts_barrier":::"memory")

__device__ __forceinline__ void qkt(f32x16&p0,f32x16&p1,const char*Kslot,const bf16x8*qr,const f32x16&negm,int r32,int hi){
  const char*kb=Kslot+hi*1024+r32*16;
  #pragma unroll
  for(int d0=0;d0<4;++d0){
    const bf16x8 b0=*reinterpret_cast<const bf16x8*>(kb+d0*2048);
    const bf16x8 b1=*reinterpret_cast<const bf16x8*>(kb+d0*2048+512);
    if(d0==0){p0=__builtin_amdgcn_mfma_f32_32x32x16_bf16(b0,qr[0],negm,0,0,0);p1=__builtin_amdgcn_mfma_f32_32x32x16_bf16(b1,qr[0],negm,0,0,0);}
    else{p0=__builtin_amdgcn_mfma_f32_32x32x16_bf16(b0,qr[d0],p0,0,0,0);p1=__builtin_amdgcn_mfma_f32_32x32x16_bf16(b1,qr[d0],p1,0,0,0);}}
}
typedef __attribute__((address_space(3))) const char* lds_cptr;
typedef short v4i16_t __attribute__((ext_vector_type(4)));
__device__ __forceinline__ void kload8(bf16x8*kf,lds_cptr kp){
  kf[0]=*(const __attribute__((address_space(3))) bf16x8*)(kp);      kf[1]=*(const __attribute__((address_space(3))) bf16x8*)(kp+512);
  kf[2]=*(const __attribute__((address_space(3))) bf16x8*)(kp+2048); kf[3]=*(const __attribute__((address_space(3))) bf16x8*)(kp+2560);
  kf[4]=*(const __attribute__((address_space(3))) bf16x8*)(kp+4096); kf[5]=*(const __attribute__((address_space(3))) bf16x8*)(kp+4608);
  kf[6]=*(const __attribute__((address_space(3))) bf16x8*)(kp+6144); kf[7]=*(const __attribute__((address_space(3))) bf16x8*)(kp+6656);
}
__device__ __forceinline__ void kload2(bf16x8*kf,lds_cptr kp,int j){ kf[2*j]=*(const __attribute__((address_space(3))) bf16x8*)(kp+j*2048); kf[2*j+1]=*(const __attribute__((address_space(3))) bf16x8*)(kp+j*2048+512); }
__device__ __forceinline__ s16x4 vtr(lds_cptr p){ return __builtin_bit_cast(s16x4,__builtin_amdgcn_ds_read_tr16_b64_v4i16((__attribute__((address_space(3))) v4i16_t*)p)); }
__device__ __forceinline__ float rowmax(const f32x16&p0,const f32x16&p1){
  float a=max3f(p0[0],p0[1],p1[0]),b=max3f(p0[2],p0[3],p1[1]);a=max3f(a,p1[2],p1[3]);
  #pragma unroll
  for(int r=4;r<16;r+=4){a=max3f(a,p0[r],p0[r+1]);b=max3f(b,p0[r+2],p0[r+3]);a=max3f(a,p1[r],p1[r+1]);b=max3f(b,p1[r+2],p1[r+3]);}
  const float m=max2f(a,b);
  auto rr=__builtin_amdgcn_permlane32_swap(__float_as_uint(m),__float_as_uint(m),false,false);
  return max2f(__uint_as_float(rr[0]),__uint_as_float(rr[1]));
}
__device__ __forceinline__ void pv(f32x16*o,int vb,bf16x8 pa0,bf16x8 pa1,bf16x8 pa2,bf16x8 pa3){
  #pragma unroll
  for(int d0=0;d0<2;++d0){s16x4 lo[4],hi[4];
    #pragma unroll
    for(int ks=0;ks<4;++ks){
      asm volatile("ds_read_b64_tr_b16 %0,%1 offset:%c2":"=&v"(lo[ks]):"v"(vb),"i"(d0*4096+ks*1024):"memory");
      asm volatile("ds_read_b64_tr_b16 %0,%1 offset:%c2":"=&v"(hi[ks]):"v"(vb),"i"(d0*4096+ks*1024+512):"memory");}
    asm volatile("s_waitcnt lgkmcnt(0)":::"memory");SBAR();
    #define PK(k) (bf16x8){lo[k][0],lo[k][1],lo[k][2],lo[k][3],hi[k][0],hi[k][1],hi[k][2],hi[k][3]}
    o[d0]=__builtin_amdgcn_mfma_f32_32x32x16_bf16(pa0,PK(0),o[d0],0,0,0);
    o[d0]=__builtin_amdgcn_mfma_f32_32x32x16_bf16(pa1,PK(1),o[d0],0,0,0);
    o[d0]=__builtin_amdgcn_mfma_f32_32x32x16_bf16(pa2,PK(2),o[d0],0,0,0);
    o[d0]=__builtin_amdgcn_mfma_f32_32x32x16_bf16(pa3,PK(3),o[d0],0,0,0);
    #undef PK
  }
}

#ifndef ATTN_STORE16
#define ATTN_STORE16(p,v) (*(u32x4*)(p)=(v))
#endif
template<int THRL,bool NOMAX=false> __device__ __forceinline__ void attn_unit(const bf16*Qu,int qp,const bf16*__restrict__ Kh,int kp,const bf16*__restrict__ Vh,int vp,bf16*Ou,int op,int NT,char*shm,int tid_in){
  int tid_=tid_in; asm volatile("":"+v"(tid_));
  const int tid=tid_,lane=tid&63,r32=lane&31,hi=lane>>5; const int wid=__builtin_amdgcn_readfirstlane(tid>>6);
  const bf16*Qw=Qu+(long)(wid*QBLK)*qp;
  const unsigned lds0=(unsigned)(uintptr_t)shm;
  float*wsf=(float*)(shm+LDS_WS)+wid*64;
  const bf16*ksrc=Kh+(long)lane*kp+wid*8;
  const bf16*vsrc=Vh+(long)(16*(wid&3)+(lane>>2))*vp+(wid>>2)*32+(lane&3)*8;
  const unsigned kdst=lds0+LDS_K+wid*1024, vdst=lds0+LDS_V+wid*1024;
  #define DMA_K(t,slot) glds16(ksrc+(long)(t)*KVBLK*kp,(unsigned)__builtin_amdgcn_readfirstlane(kdst+(slot)))
  #define DMA_V(t,slot) glds16(vsrc+(long)(t)*KVBLK*vp,(unsigned)__builtin_amdgcn_readfirstlane(vdst+(slot)))
  const int vb0=(int)(lds0+LDS_V)+((lane>>4)&1)*32+(lane&3)*8+(4*hi+((lane&15)>>2))*64;
  const char*Kbase=shm+LDS_K; bf16x8 kf[8];
  const lds_cptr shm3=(lds_cptr)shm; const lds_cptr kp0=shm3+LDS_K+hi*1024+r32*16; const lds_cptr vp0=shm3+LDS_V+((lane>>4)&1)*32+(lane&3)*8+(4*hi+((lane&15)>>2))*64;
  DMA_K(0,0);DMA_V(0,0);DMA_K(1,SLOTB);
  bf16x8 qr[4];
  #pragma unroll
  for(int d0=0;d0<4;++d0)qr[d0]=*reinterpret_cast<const bf16x8*>(&Qw[(long)r32*qp+d0*16+hi*8]);
  float mhat=0.f,l_reg=0.f;f32x16 o[2];o[0]=f32x16{};o[1]=f32x16{};f32x16 negm=f32x16{};asm volatile("":"+v"(negm));
  #define CMASK(P0,P1,t) do{}while(0)
  bool resc=false;
  #define START(P0,P1) do{ resc=false; if constexpr(!NOMAX){ const float rm=rowmax(P0,P1); \
    { const float dl=rm; mhat=fadd_s(mhat,dl); \
      _Pragma("unroll") for(int r=0;r<16;++r){P0[r]=fsub_s(P0[r],dl);P1[r]=fsub_s(P1[r],dl);} \
      _Pragma("unroll") for(int r=0;r<16;++r)negm[r]=-mhat; asm volatile("":"+v"(negm)); } } \
    _Pragma("unroll") for(int r=0;r<16;++r)P0[r]=__builtin_amdgcn_exp2f(P0[r]); }while(0)
  #define RESC() do{ if(resc){ asm volatile("s_waitcnt lgkmcnt(0)":::"memory"); \
      _Pragma("unroll") for(int d_=0;d_<2;++d_) _Pragma("unroll") for(int r=0;r<16;++r)o[d_][r]*=wsf[crow(r,hi)]; } }while(0)
  f32x16 pA0,pA1,pB0,pB1;
  int sl_prev=0,sl_cur=0,sl_next=SLOTB;
  #define ROT() do{sl_prev=sl_cur;sl_cur=sl_next;sl_next=(sl_next==(NSLOT-1)*SLOTB)?0:sl_next+SLOTB;}while(0)
  DMA_K(2,2*SLOTB);
  WAIT_BAR(3);
  qkt(pA0,pA1,Kbase,qr,negm,r32,hi);asm volatile("s_nop 15\n\ts_nop 7":"+v"(pA0),"+v"(pA1));CMASK(pA0,pA1,0);
  START(pA0,pA1);
  _Pragma("unroll") for(int r=0;r<16;++r)pA1[r]=__builtin_amdgcn_exp2f(pA1[r]);
  WAIT_BAR(0);
  DMA_K(3,0);DMA_V(1,SLOTB);
  ROT();
  kload8(kf,kp0+sl_cur);
  WAIT_BAR(2);
  s16x4 vlo[8],vhi[8]; u32x4 pw0,pw1,pw2,pw3;
  #define PKW(P,B) cvtpk_s(P[B],P[B+1])
  #define PAF(k) __builtin_bit_cast(bf16x8,pw##k)
  #define VFR(i) (bf16x8){vlo[i][0],vlo[i][1],vlo[i][2],vlo[i][3],vhi[i][0],vhi[i][1],vhi[i][2],vhi[i][3]}
  #define PIN(x) asm volatile("":"+v"(x))
  #define MX3(a,b,c) __builtin_fmaxf(__builtin_fmaxf((a),(b)),(c))
  #define GAPA(MF,A0,A1,A2,A3,W0,W1,PW) do{ MF; sacc+=A0; sacc+=A1; sacc+=A2; sacc+=A3; PIN(sacc); W0; W1; PIN(PW); SBAR(); }while(0)
  #define EX(v) __builtin_amdgcn_exp2f(v)
  #define GAPB(MF,X,B) do{ MF; X[B]=EX(X[B]); X[B+1]=EX(X[B+1]); X[B+2]=EX(X[B+2]); X[B+3]=EX(X[B+3]); PIN(X); SBAR(); }while(0)
  #define VRD(i) do{ vlo[i]=vtr(vp_+(((i)>>2)*4096+((i)&3)*1024)); vhi[i]=vtr(vp_+(((i)>>2)*4096+((i)&3)*1024+512)); }while(0)
  #define KRD(G,j) do{ if(G){ kload2(kf,kp0+sl_next,j); SBAR(); } }while(0)
  #define STEP(C0,C1,P0,P1,t,GK,GV,GL) do{ SBAR(); \
    const lds_cptr vp_=vp0+sl_prev; \
    VRD(0); SBAR(); float sacc=(P0[0]+P0[1]); \
    GAPA(C0=__builtin_amdgcn_mfma_f32_32x32x16_bf16(kf[0],qr[0],negm,0,0,0), P0[2],P0[3],P0[4],P0[5],     pw0[0]=PKW(P0,0), pw0[1]=PKW(P0,2), pw0); \
    VRD(4); SBAR(); GAPA(C1=__builtin_amdgcn_mfma_f32_32x32x16_bf16(kf[1],qr[0],negm,0,0,0), P0[6],P0[7],P0[8],P0[9],     pw0[2]=PKW(P0,4), pw0[3]=PKW(P0,6), pw0); \
    VRD(1); SBAR(); GAPA(C0=__builtin_amdgcn_mfma_f32_32x32x16_bf16(kf[2],qr[1],C0,0,0,0),   P0[10],P0[11],P0[12],P0[13], pw1[0]=PKW(P0,8), pw1[1]=PKW(P0,10), pw1); \
    VRD(5); SBAR(); GAPA(C1=__builtin_amdgcn_mfma_f32_32x32x16_bf16(kf[3],qr[1],C1,0,0,0),   P0[14],P0[15],P1[0],P1[1],   pw1[2]=PKW(P0,12),pw1[3]=PKW(P0,14), pw1); \
    VRD(2); SBAR(); GAPA(C0=__builtin_amdgcn_mfma_f32_32x32x16_bf16(kf[4],qr[2],C0,0,0,0),   P1[2],P1[3],P1[4],P1[5],     pw2[0]=PKW(P1,0), pw2[1]=PKW(P1,2), pw2); \
    VRD(6); SBAR(); GAPA(C1=__builtin_amdgcn_mfma_f32_32x32x16_bf16(kf[5],qr[2],C1,0,0,0),   P1[6],P1[7],P1[8],P1[9],     pw2[2]=PKW(P1,4), pw2[3]=PKW(P1,6), pw2); \
    VRD(3); SBAR(); GAPA(C0=__builtin_amdgcn_mfma_f32_32x32x16_bf16(kf[6],qr[3],C0,0,0,0),   P1[10],P1[11],P1[12],P1[13], pw3[0]=PKW(P1,8), pw3[1]=PKW(P1,10), pw3); \
    VRD(7); SBAR(); GAPA(C1=__builtin_amdgcn_mfma_f32_32x32x16_bf16(kf[7],qr[3],C1,0,0,0),   P1[14],P1[15],0.f,0.f,       pw3[2]=PKW(P1,12),pw3[3]=PKW(P1,14), pw3); \
    l_reg+=sacc; \
    if(GK){DMA_K((t)+3,sl_cur);} if(GV){DMA_V((t)+1,sl_next);} \
    CMASK(C0,C1,t); \
    if constexpr(!NOMAX){ float a=MX3(C0[0],C0[1],C1[0]),b=MX3(C0[2],C0[3],C1[1]); a=MX3(a,C1[2],C1[3]); \
      _Pragma("unroll") for(int r=4;r<16;r+=4){a=MX3(a,C0[r],C0[r+1]);b=MX3(b,C0[r+2],C0[r+3]);a=MX3(a,C1[r],C1[r+1]);b=MX3(b,C1[r+2],C1[r+3]);} \
      float rm=__builtin_fmaxf(a,b); { auto rr=__builtin_amdgcn_permlane32_swap(__float_as_uint(rm),__float_as_uint(rm),false,false); rm=__builtin_fmaxf(__uint_as_float(rr[0]),__uint_as_float(rr[1])); } \
      resc=false; \
      if(__builtin_expect(__any(rm>(float)THRL),0)){ const float dl=__builtin_fmaxf(rm,0.f); mhat+=dl; \
        _Pragma("unroll") for(int r=0;r<16;++r){C0[r]-=dl;C1[r]-=dl;} \
        _Pragma("unroll") for(int r=0;r<16;++r)negm[r]=-mhat; asm volatile("":"+v"(negm)); \
        const float f=__builtin_amdgcn_exp2f(-dl); l_reg*=f; if(hi==0)wsf[r32]=f; resc=true; } } \
    SBAR(); \
    GAPB(o[0]=__builtin_amdgcn_mfma_f32_32x32x16_bf16(PAF(0),VFR(0),o[0],0,0,0), C0,0); \
    GAPB(o[1]=__builtin_amdgcn_mfma_f32_32x32x16_bf16(PAF(0),VFR(4),o[1],0,0,0), C0,4); \
    KRD(GL,0); GAPB(o[0]=__builtin_amdgcn_mfma_f32_32x32x16_bf16(PAF(1),VFR(1),o[0],0,0,0), C0,8); \
    KRD(GL,1); GAPB(o[1]=__builtin_amdgcn_mfma_f32_32x32x16_bf16(PAF(1),VFR(5),o[1],0,0,0), C0,12); \
    KRD(GL,2); GAPB(o[0]=__builtin_amdgcn_mfma_f32_32x32x16_bf16(PAF(2),VFR(2),o[0],0,0,0), C1,0); \
    KRD(GL,3); GAPB(o[1]=__builtin_amdgcn_mfma_f32_32x32x16_bf16(PAF(2),VFR(6),o[1],0,0,0), C1,4); \
    GAPB(o[0]=__builtin_amdgcn_mfma_f32_32x32x16_bf16(PAF(3),VFR(3),o[0],0,0,0), C1,8); \
    GAPB(o[1]=__builtin_amdgcn_mfma_f32_32x32x16_bf16(PAF(3),VFR(7),o[1],0,0,0), C1,12); \
    }while(0)
  int t=1;
  #undef CMASK
  #define CMASK(P0,P1,t) do{}while(0)
  for(;t+5<NT;t+=2){
    STEP(pB0,pB1,pA0,pA1,t,true,true,true);     WAIT_BAR(2); RESC(); ROT();
    STEP(pA0,pA1,pB0,pB1,t+1,true,true,true);   WAIT_BAR(2); RESC(); ROT();
  }
  #undef CMASK
  #define CMASK(P0,P1,t) do{}while(0)
  #define ENDW(tt) do{ if((tt)+3<NT){WAIT_BAR(2);} else if((tt)+2<NT){WAIT_BAR(1);} else {WAIT_BAR(0);} }while(0)
  for(;t+1<NT;t+=2){
    STEP(pB0,pB1,pA0,pA1,t,(t+3<NT),(t+1<NT),(t+1<NT));       ENDW(t);   RESC(); ROT();
    STEP(pA0,pA1,pB0,pB1,t+1,(t+4<NT),(t+2<NT),(t+2<NT));     ENDW(t+1); RESC(); ROT();
  }
  STEP(pB0,pB1,pA0,pA1,NT-1,false,false,false); RESC();
  { float sacc=pB0[0]+pB0[1]; _Pragma("unroll") for(int r=2;r<16;++r)sacc+=pB0[r]; _Pragma("unroll") for(int r=0;r<16;++r)sacc+=pB1[r]; l_reg+=sacc;
    pw0=(u32x4){PKW(pB0,0),PKW(pB0,2),PKW(pB0,4),PKW(pB0,6)};pw1=(u32x4){PKW(pB0,8),PKW(pB0,10),PKW(pB0,12),PKW(pB0,14)};pw2=(u32x4){PKW(pB1,0),PKW(pB1,2),PKW(pB1,4),PKW(pB1,6)};pw3=(u32x4){PKW(pB1,8),PKW(pB1,10),PKW(pB1,12),PKW(pB1,14)};
    SBAR(); pv(o,vb0+sl_cur,PAF(0),PAF(1),PAF(2),PAF(3)); }
  #undef PKW
  #undef PAF
  #undef VFR
  #undef PIN
  #undef MX3
  #undef GAPA
  #undef GAPB
  #undef EX
  #undef VRD
  #undef KRD
  #undef STEP
  #undef ENDW
  {auto rr=__builtin_amdgcn_permlane32_swap(__float_as_uint(l_reg),__float_as_uint(l_reg),false,false);l_reg=__uint_as_float(rr[0])+__uint_as_float(rr[1]);}
  if(hi==0)wsf[32+r32]=l_reg;asm volatile("s_waitcnt lgkmcnt(0)":::"memory");
  float rli[16];
  #pragma unroll
  for(int r=0;r<16;++r)rli[r]=__builtin_amdgcn_rcpf(wsf[32+crow(r,hi)]);
  bf16*Ow=Ou+(long)(wid*QBLK)*op;
  { bf16*stg=(bf16*)(shm+LDS_OST)+wid*2048;
    #pragma unroll
    for(int r=0;r<16;++r){const int orow=crow(r,hi);
      #pragma unroll
      for(int d0=0;d0<2;++d0)stg[orow*64+d0*32+r32]=__float2bfloat16(o[d0][r]*rli[r]);}
    asm volatile("s_waitcnt lgkmcnt(0)":::"memory");
    #pragma unroll
    for(int i=0;i<4;++i){const int row=i*8+(lane>>3),ch=lane&7; const u32x4 v=*(const u32x4*)(stg+row*64+ch*8); ATTN_STORE16(Ow+(long)row*op+ch*8,v);} }
  asm volatile("s_waitcnt lgkmcnt(0)\n\ts_barrier":::"memory");
  #undef DMA_K
  #undef DMA_V
  #undef CMASK
  #undef START
  #undef RESC
  #undef ROT
}

constexpr int U2_K=0, U2_V=4*SLOTB, U2_WS=8*SLOTB, U2_OST=U2_WS+NW*64*4;
__device__ __forceinline__ void attn_unit2(const bf16*Qu,int qp,const bf16*__restrict__ Kh,int kp,const bf16*__restrict__ Vh,int vp,bf16*Ou,int op,int NT,char*shm,int tid_in){
  int tid_=tid_in; asm volatile("":"+v"(tid_));
  const int tid=tid_,lane=tid&63,r32=lane&31,hi=lane>>5; const int wid=__builtin_amdgcn_readfirstlane(tid>>6);
  const bf16*Qw=Qu+(long)(wid*64)*qp;
  const unsigned lds0=(unsigned)(uintptr_t)shm;
  float*wsf=(float*)(shm+U2_WS)+wid*64;
  const bf16*ksrc=Kh+(long)lane*kp+wid*8;
  const bf16*vsrc=Vh+(long)(16*(wid&3)+(lane>>2))*vp+(wid>>2)*32+(lane&3)*8;
  const unsigned kdst=lds0+U2_K+wid*1024, vdst=lds0+U2_V+wid*1024;
  #define DMA_K(t,slot) glds16(ksrc+(long)(t)*KVBLK*kp,(unsigned)__builtin_amdgcn_readfirstlane(kdst+(slot)))
  #define DMA_V(t,slot) glds16(vsrc+(long)(t)*KVBLK*vp,(unsigned)__builtin_amdgcn_readfirstlane(vdst+(slot)))
  const lds_cptr shm3=(lds_cptr)shm; const lds_cptr kp0=shm3+U2_K+hi*1024+r32*16; const lds_cptr vp0=shm3+U2_V+((lane>>4)&1)*32+(lane&3)*8+(4*hi+((lane&15)>>2))*64;
  DMA_K(0,0);DMA_V(0,0);DMA_K(1,SLOTB);DMA_V(1,SLOTB);DMA_K(2,2*SLOTB);DMA_V(2,2*SLOTB);
  bf16x8 qa[4],qb[4];
  #pragma unroll
  for(int d0=0;d0<4;++d0){qa[d0]=*reinterpret_cast<const bf16x8*>(&Qw[(long)r32*qp+d0*16+hi*8]);qb[d0]=*reinterpret_cast<const bf16x8*>(&Qw[(long)(32+r32)*qp+d0*16+hi*8]);}
  float la=0.f,lb=0.f; f32x16 oa[2],ob[2]; oa[0]=f32x16{};oa[1]=f32x16{};ob[0]=f32x16{};ob[1]=f32x16{};
  asm volatile("s_waitcnt vmcnt(0) lgkmcnt(0)\n\ts_barrier":::"memory");
  int sl_cur=0,sl_n1=SLOTB,sl_n3=3*SLOTB;
  bf16x8 kf[8]; kload8(kf,kp0);
  for(int t=0;t<NT;++t){
    if(t>0){ if(t+2<NT) asm volatile("s_waitcnt vmcnt(2) lgkmcnt(0)\n\ts_barrier":::"memory"); else asm volatile("s_waitcnt vmcnt(0) lgkmcnt(0)\n\ts_barrier":::"memory"); }
    if(t+3<NT){DMA_K(t+3,sl_n3);DMA_V(t+3,sl_n3);}
    f32x16 a0,a1,b0,b1; const f32x16 z16=f32x16{};
    #pragma unroll
    for(int d0=0;d0<4;++d0){ a0=__builtin_amdgcn_mfma_f32_32x32x16_bf16(kf[2*d0],qa[d0],d0==0?z16:a0,0,0,0); a1=__builtin_amdgcn_mfma_f32_32x32x16_bf16(kf[2*d0+1],qa[d0],d0==0?z16:a1,0,0,0); }
    SBAR();
    const lds_cptr vq=vp0+sl_cur; s16x4 vlo[8],vhi[8];
    #pragma unroll
    for(int i=0;i<8;++i){ vlo[i]=vtr(vq+((i>>2)*4096+(i&3)*1024)); vhi[i]=vtr(vq+((i>>2)*4096+(i&3)*1024+512)); }
    SBAR();
    #define X4(P,B) do{ P[B]=__builtin_amdgcn_exp2f(P[B]); P[B+1]=__builtin_amdgcn_exp2f(P[B+1]); P[B+2]=__builtin_amdgcn_exp2f(P[B+2]); P[B+3]=__builtin_amdgcn_exp2f(P[B+3]); asm volatile("":"+v"(P)); SBAR(); }while(0)
    b0=__builtin_amdgcn_mfma_f32_32x32x16_bf16(kf[0],qb[0],z16,0,0,0); X4(a0,0);
    b1=__builtin_amdgcn_mfma_f32_32x32x16_bf16(kf[1],qb[0],z16,0,0,0); X4(a0,4);
    b0=__builtin_amdgcn_mfma_f32_32x32x16_bf16(kf[2],qb[1],b0,0,0,0);  X4(a0,8);
    b1=__builtin_amdgcn_mfma_f32_32x32x16_bf16(kf[3],qb[1],b1,0,0,0);  X4(a0,12);
    b0=__builtin_amdgcn_mfma_f32_32x32x16_bf16(kf[4],qb[2],b0,0,0,0);  X4(a1,0);
    b1=__builtin_amdgcn_mfma_f32_32x32x16_bf16(kf[5],qb[2],b1,0,0,0);  X4(a1,4);
    b0=__builtin_amdgcn_mfma_f32_32x32x16_bf16(kf[6],qb[3],b0,0,0,0);  X4(a1,8);
    b1=__builtin_amdgcn_mfma_f32_32x32x16_bf16(kf[7],qb[3],b1,0,0,0);  X4(a1,12);
    #define VF(i) (bf16x8){vlo[i][0],vlo[i][1],vlo[i][2],vlo[i][3],vhi[i][0],vhi[i][1],vhi[i][2],vhi[i][3]}
    float sa=0.f,sb=0.f;
    #pragma unroll
    for(int r=0;r<16;++r) sa+=a0[r]+a1[r];
    u32x4 pa[4],pb[4];
    pa[0]=(u32x4){cvtpk_s(a0[0],a0[1]),cvtpk_s(a0[2],a0[3]),cvtpk_s(a0[4],a0[5]),cvtpk_s(a0[6],a0[7])}; pa[1]=(u32x4){cvtpk_s(a0[8],a0[9]),cvtpk_s(a0[10],a0[11]),cvtpk_s(a0[12],a0[13]),cvtpk_s(a0[14],a0[15])};
    pa[2]=(u32x4){cvtpk_s(a1[0],a1[1]),cvtpk_s(a1[2],a1[3]),cvtpk_s(a1[4],a1[5]),cvtpk_s(a1[6],a1[7])}; pa[3]=(u32x4){cvtpk_s(a1[8],a1[9]),cvtpk_s(a1[10],a1[11]),cvtpk_s(a1[12],a1[13]),cvtpk_s(a1[14],a1[15])};
    SBAR();
    #define PVA(ks,d0) oa[d0]=__builtin_amdgcn_mfma_f32_32x32x16_bf16(__builtin_bit_cast(bf16x8,pa[ks]),VF((ks)+4*(d0)),oa[d0],0,0,0)
    #define PVB(ks,d0) ob[d0]=__builtin_amdgcn_mfma_f32_32x32x16_bf16(__builtin_bit_cast(bf16x8,pb[ks]),VF((ks)+4*(d0)),ob[d0],0,0,0)
    PVA(0,0); X4(b0,0); PVA(0,1); X4(b0,4); PVA(1,0); X4(b0,8); PVA(1,1); X4(b0,12);
    PVA(2,0); X4(b1,0); PVA(2,1); X4(b1,4); PVA(3,0); X4(b1,8); PVA(3,1); X4(b1,12);
    #pragma unroll
    for(int r=0;r<16;++r) sb+=b0[r]+b1[r];
    pb[0]=(u32x4){cvtpk_s(b0[0],b0[1]),cvtpk_s(b0[2],b0[3]),cvtpk_s(b0[4],b0[5]),cvtpk_s(b0[6],b0[7])}; pb[1]=(u32x4){cvtpk_s(b0[8],b0[9]),cvtpk_s(b0[10],b0[11]),cvtpk_s(b0[12],b0[13]),cvtpk_s(b0[14],b0[15])};
    pb[2]=(u32x4){cvtpk_s(b1[0],b1[1]),cvtpk_s(b1[2],b1[3]),cvtpk_s(b1[4],b1[5]),cvtpk_s(b1[6],b1[7])}; pb[3]=(u32x4){cvtpk_s(b1[8],b1[9]),cvtpk_s(b1[10],b1[11]),cvtpk_s(b1[12],b1[13]),cvtpk_s(b1[14],b1[15])};
    la+=sa; lb+=sb;
    SBAR();
    if(t+1<NT) kload8(kf,kp0+sl_n1);
    PVB(0,0); PVB(0,1); PVB(1,0); PVB(1,1); PVB(2,0); PVB(2,1); PVB(3,0); PVB(3,1);
    SBAR();
    #undef X4
    #undef VF
    #undef PVA
    #undef PVB
    sl_cur=(sl_cur==3*SLOTB)?0:sl_cur+SLOTB; sl_n1=(sl_n1==3*SLOTB)?0:sl_n1+SLOTB; sl_n3=(sl_n3==3*SLOTB)?0:sl_n3+SLOTB;
  }
  bf16*stg=(bf16*)(shm+U2_OST)+wid*2048;
  #pragma unroll
  for(int blk=0;blk<2;++blk){ float l_reg=blk?lb:la; const f32x16 o0=blk?ob[0]:oa[0], o1=blk?ob[1]:oa[1];
    {auto rr=__builtin_amdgcn_permlane32_swap(__float_as_uint(l_reg),__float_as_uint(l_reg),false,false);l_reg=__uint_as_float(rr[0])+__uint_as_float(rr[1]);}
    if(hi==0)wsf[32+r32]=l_reg;asm volatile("s_waitcnt lgkmcnt(0)":::"memory");
    float rli[16];
    #pragma unroll
    for(int r=0;r<16;++r)rli[r]=__builtin_amdgcn_rcpf(wsf[32+crow(r,hi)]);
    #pragma unroll
    for(int r=0;r<16;++r){const int orow=crow(r,hi); stg[orow*64+r32]=__float2bfloat16(o0[r]*rli[r]); stg[orow*64+32+r32]=__float2bfloat16(o1[r]*rli[r]);}
    asm volatile("s_waitcnt lgkmcnt(0)":::"memory");
    bf16*Ow=Ou+(long)(wid*64+blk*32)*op;
    #pragma unroll
    for(int i=0;i<4;++i){const int row=i*8+(lane>>3),ch=lane&7; const u32x4 v=*(const u32x4*)(stg+row*64+ch*8); ATTN_STORE16(Ow+(long)row*op+ch*8,v);}
    asm volatile("s_waitcnt lgkmcnt(0)":::"memory"); }
  asm volatile("s_waitcnt lgkmcnt(0)\n\ts_barrier":::"memory");
  #undef DMA_K
  #undef DMA_V
}
constexpr int V2_LDS_K=0, V2_LDS_V=3*8192, V2_LDS_WS=V2_LDS_V+3*16384, V2_LDS_OST=V2_LDS_WS+NW*64*4, V2_LDS_BYTES=V2_LDS_OST+NW*4096;
__device__ __forceinline__ void qkt0(f32x16&p0,f32x16&p1,const char*Kslot,const bf16x8*qr,int r32,int hi){
  const char*kb=Kslot+hi*1024+r32*16; const f32x16 z=f32x16{};
  #pragma unroll
  for(int d0=0;d0<4;++d0){
    const bf16x8 b0=*reinterpret_cast<const bf16x8*>(kb+d0*2048);
    const bf16x8 b1=*reinterpret_cast<const bf16x8*>(kb+d0*2048+512);
    if(d0==0){p0=__builtin_amdgcn_mfma_f32_32x32x16_bf16(b0,qr[0],z,0,0,0);p1=__builtin_amdgcn_mfma_f32_32x32x16_bf16(b1,qr[0],z,0,0,0);}
    else{p0=__builtin_amdgcn_mfma_f32_32x32x16_bf16(b0,qr[d0],p0,0,0,0);p1=__builtin_amdgcn_mfma_f32_32x32x16_bf16(b1,qr[d0],p1,0,0,0);}}
}
__device__ __forceinline__ void pv4(f32x16*o,int vb,bf16x8 pa0,bf16x8 pa1,bf16x8 pa2,bf16x8 pa3){
  #pragma unroll
  for(int d0=0;d0<4;++d0){s16x4 lo[4],hi[4];
    #pragma unroll
    for(int ks=0;ks<4;++ks){
      asm volatile("ds_read_b64_tr_b16 %0,%1 offset:%c2":"=&v"(lo[ks]):"v"(vb),"i"(d0*4096+ks*1024):"memory");
      asm volatile("ds_read_b64_tr_b16 %0,%1 offset:%c2":"=&v"(hi[ks]):"v"(vb),"i"(d0*4096+ks*1024+512):"memory");}
    asm volatile("s_waitcnt lgkmcnt(0)":::"memory");SBAR();
    #define PK(k) (bf16x8){lo[k][0],lo[k][1],lo[k][2],lo[k][3],hi[k][0],hi[k][1],hi[k][2],hi[k][3]}
    o[d0]=__builtin_amdgcn_mfma_f32_32x32x16_bf16(pa0,PK(0),o[d0],0,0,0);
    o[d0]=__builtin_amdgcn_mfma_f32_32x32x16_bf16(pa1,PK(1),o[d0],0,0,0);
    o[d0]=__builtin_amdgcn_mfma_f32_32x32x16_bf16(pa2,PK(2),o[d0],0,0,0);
    o[d0]=__builtin_amdgcn_mfma_f32_32x32x16_bf16(pa3,PK(3),o[d0],0,0,0);
    #undef PK
  }
}
template<int THRL,bool NOMAX=false> __device__ __forceinline__ void attn_unit_v128(const bf16*Qu,int qp,const bf16*__restrict__ Kh,int kp,const bf16*__restrict__ Vh,int vp,bf16*Ou,int op,int NT,char*shm,int tid_in){
  int tid_=tid_in; asm volatile("":"+v"(tid_));
  const int tid=tid_,lane=tid&63,r32=lane&31,hi=lane>>5; const int wid=__builtin_amdgcn_readfirstlane(tid>>6);
  const bf16*Qw=Qu+(long)(wid*QBLK)*qp;
  const unsigned lds0=(unsigned)(uintptr_t)shm;
  float*wsf=(float*)(shm+V2_LDS_WS)+wid*64;
  const bf16*ksrc=Kh+(long)lane*kp+wid*8;
  const bf16*vsrc=Vh+(long)(16*(wid&3)+(lane>>2))*vp+(wid>>2)*32+(lane&3)*8;
  const unsigned kdst=lds0+V2_LDS_K+wid*1024, vdst=lds0+V2_LDS_V+wid*1024;
  #define DMA_K(t,slot) glds16(ksrc+(long)(t)*KVBLK*kp,(unsigned)__builtin_amdgcn_readfirstlane(kdst+(slot)))
  #define DMA_V(t,slot) do{ glds16(vsrc+(long)(t)*KVBLK*vp,(unsigned)__builtin_amdgcn_readfirstlane(vdst+2*(slot))); glds16(vsrc+64+(long)(t)*KVBLK*vp,(unsigned)__builtin_amdgcn_readfirstlane(vdst+2*(slot)+8192)); }while(0)
  const int vb0=(int)(lds0+V2_LDS_V)+((lane>>4)&1)*32+(lane&3)*8+(4*hi+((lane&15)>>2))*64;
  const char*Kbase=shm+V2_LDS_K; bf16x8 kf[8];
  const lds_cptr shm3=(lds_cptr)shm; const lds_cptr kp0=shm3+V2_LDS_K+hi*1024+r32*16; const lds_cptr vp0=shm3+V2_LDS_V+((lane>>4)&1)*32+(lane&3)*8+(4*hi+((lane&15)>>2))*64;
  DMA_K(0,0);DMA_V(0,0);DMA_K(1,SLOTB);
  bf16x8 qr[4];
  #pragma unroll
  for(int d0=0;d0<4;++d0)qr[d0]=*reinterpret_cast<const bf16x8*>(&Qw[(long)r32*qp+d0*16+hi*8]);
  float mhat=0.f,l_reg=0.f;f32x16 o[4];o[0]=f32x16{};o[1]=f32x16{};o[2]=f32x16{};o[3]=f32x16{};
  const f32x16 zero16=f32x16{};
  bool resc=false;
  #define START(P0,P1) do{ resc=false; if constexpr(NOMAX){ _Pragma("unroll") for(int r=0;r<16;++r){P0[r]=__builtin_amdgcn_exp2f(P0[r]);} } \
    else { const float rm=rowmax(P0,P1); mhat=rm; _Pragma("unroll") for(int r=0;r<16;++r){P0[r]=__builtin_amdgcn_exp2f(fsub_s(P0[r],mhat));} } }while(0)
  #define RESC() do{ if(resc){ asm volatile("s_waitcnt lgkmcnt(0)":::"memory"); \
      _Pragma("unroll") for(int d_=0;d_<4;++d_) _Pragma("unroll") for(int r=0;r<16;++r)o[d_][r]*=wsf[crow(r,hi)]; } }while(0)
  f32x16 pA0,pA1,pB0,pB1;
  int sl_prev=0,sl_cur=0,sl_next=SLOTB;
  #define ROT() do{sl_prev=sl_cur;sl_cur=sl_next;sl_next=(sl_next==(NSLOT-1)*SLOTB)?0:sl_next+SLOTB;}while(0)
  DMA_K(2,2*SLOTB);
  WAIT_BAR(3);
  qkt0(pA0,pA1,Kbase,qr,r32,hi);asm volatile("s_nop 15\n\ts_nop 7":"+v"(pA0),"+v"(pA1));
  START(pA0,pA1);
  if constexpr(NOMAX){ _Pragma("unroll") for(int r=0;r<16;++r)pA1[r]=__builtin_amdgcn_exp2f(pA1[r]); } else { _Pragma("unroll") for(int r=0;r<16;++r)pA1[r]=__builtin_amdgcn_exp2f(fsub_s(pA1[r],mhat)); }
  WAIT_BAR(0);
  DMA_K(3,0);DMA_V(1,SLOTB);
  ROT();
  kload8(kf,kp0+sl_cur);
  WAIT_BAR(3);
  s16x4 vwl[5],vwh[5]; u32x4 pw0,pw1,pw2,pw3;
  #define PKW(P,B) cvtpk_s(P[B],P[B+1])
  #define PAF(k) __builtin_bit_cast(bf16x8,pw##k)
  #define VWF(s) (bf16x8){vwl[s][0],vwl[s][1],vwl[s][2],vwl[s][3],vwh[s][0],vwh[s][1],vwh[s][2],vwh[s][3]}
  #define PIN(x) asm volatile("":"+v"(x))
  #define MX3(a,b,c) __builtin_fmaxf(__builtin_fmaxf((a),(b)),(c))
  #define GAPA(MF,A0,A1,A2,A3,W0,W1,PW) do{ MF; sacc+=A0; sacc+=A1; sacc+=A2; sacc+=A3; PIN(sacc); W0; W1; PIN(PW); SBAR(); }while(0)
  #define EXS(v) (NOMAX?__builtin_amdgcn_exp2f(v):__builtin_amdgcn_exp2f((v)-mhat))
  #define GAPB(MF,X,B) do{ MF; X[B]=EXS(X[B]); X[B+1]=EXS(X[B+1]); PIN(X); SBAR(); }while(0)
  #define VRD(f,s) do{ vwl[s]=vtr(vp_+(((f)>>2)*4096+((f)&3)*1024)); vwh[s]=vtr(vp_+(((f)>>2)*4096+((f)&3)*1024+512)); }while(0)
  #define KRD(G,j) do{ if(G){ kload2(kf,kp0+sl_next,j); SBAR(); } }while(0)
  #define PVM(i) o[(i)&3]=__builtin_amdgcn_mfma_f32_32x32x16_bf16(PAF_SEL((i)>>2),VWF((i)%5),o[(i)&3],0,0,0)
  #define PAF_SEL(k) ((k)==0?PAF(0):(k)==1?PAF(1):(k)==2?PAF(2):PAF(3))
  #define VNEXT(i) do{ if((i)+5<16){ VRD((((i)+5)>>2)+4*(((i)+5)&3),(i)%5); SBAR(); } }while(0)
  #define STEP(C0,C1,P0,P1,t,GK,GV,GL) do{ SBAR(); \
    const lds_cptr vp_=vp0+2*sl_prev; \
    float sacc=(P0[0]+P0[1]); \
    GAPA(C0=__builtin_amdgcn_mfma_f32_32x32x16_bf16(kf[0],qr[0],zero16,0,0,0), P0[2],P0[3],P0[4],P0[5],     pw0[0]=PKW(P0,0), pw0[1]=PKW(P0,2), pw0); \
    GAPA(C1=__builtin_amdgcn_mfma_f32_32x32x16_bf16(kf[1],qr[0],zero16,0,0,0), P0[6],P0[7],P0[8],P0[9],     pw0[2]=PKW(P0,4), pw0[3]=PKW(P0,6), pw0); \
    GAPA(C0=__builtin_amdgcn_mfma_f32_32x32x16_bf16(kf[2],qr[1],C0,0,0,0),   P0[10],P0[11],P0[12],P0[13], pw1[0]=PKW(P0,8), pw1[1]=PKW(P0,10), pw1); \
    VRD(0,0); SBAR(); GAPA(C1=__builtin_amdgcn_mfma_f32_32x32x16_bf16(kf[3],qr[1],C1,0,0,0),   P0[14],P0[15],P1[0],P1[1],   pw1[2]=PKW(P0,12),pw1[3]=PKW(P0,14), pw1); \
    VRD(4,1); SBAR(); GAPA(C0=__builtin_amdgcn_mfma_f32_32x32x16_bf16(kf[4],qr[2],C0,0,0,0),   P1[2],P1[3],P1[4],P1[5],     pw2[0]=PKW(P1,0), pw2[1]=PKW(P1,2), pw2); \
    VRD(8,2); SBAR(); GAPA(C1=__builtin_amdgcn_mfma_f32_32x32x16_bf16(kf[5],qr[2],C1,0,0,0),   P1[6],P1[7],P1[8],P1[9],     pw2[2]=PKW(P1,4), pw2[3]=PKW(P1,6), pw2); \
    VRD(12,3); SBAR(); GAPA(C0=__builtin_amdgcn_mfma_f32_32x32x16_bf16(kf[6],qr[3],C0,0,0,0),   P1[10],P1[11],P1[12],P1[13], pw3[0]=PKW(P1,8), pw3[1]=PKW(P1,10), pw3); \
    VRD(1,4); SBAR(); GAPA(C1=__builtin_amdgcn_mfma_f32_32x32x16_bf16(kf[7],qr[3],C1,0,0,0),   P1[14],P1[15],0.f,0.f,       pw3[2]=PKW(P1,12),pw3[3]=PKW(P1,14), pw3); \
    l_reg+=sacc; \
    if(GK){DMA_K((t)+3,sl_cur);} if(GV){DMA_V((t)+1,sl_next);} \
    if constexpr(!NOMAX){ float a=MX3(C0[0],C0[1],C1[0]),b=MX3(C0[2],C0[3],C1[1]); a=MX3(a,C1[2],C1[3]); \
      _Pragma("unroll") for(int r=4;r<16;r+=4){a=MX3(a,C0[r],C0[r+1]);b=MX3(b,C0[r+2],C0[r+3]);a=MX3(a,C1[r],C1[r+1]);b=MX3(b,C1[r+2],C1[r+3]);} \
      float rm=__builtin_fmaxf(a,b); { auto rr=__builtin_amdgcn_permlane32_swap(__float_as_uint(rm),__float_as_uint(rm),false,false); rm=__builtin_fmaxf(__uint_as_float(rr[0]),__uint_as_float(rr[1])); } \
      resc=false; const float rel=rm-mhat; \
      if(__builtin_expect(__any(rel>(float)THRL),0)){ const float dl=__builtin_fmaxf(rel,0.f); mhat+=dl; \
        const float f=__builtin_amdgcn_exp2f(-dl); l_reg*=f; if(hi==0)wsf[r32]=f; resc=true; } } \
    SBAR(); \
    GAPB(PVM(0),C0,0);  VNEXT(0); \
    GAPB(PVM(1),C0,2);  VNEXT(1); \
    GAPB(PVM(2),C0,4);  VNEXT(2); \
    GAPB(PVM(3),C0,6);  VNEXT(3); \
    KRD(GL,0); GAPB(PVM(4),C0,8);  VNEXT(4); \
    GAPB(PVM(5),C0,10); VNEXT(5); \
    GAPB(PVM(6),C0,12); VNEXT(6); \
    KRD(GL,1); GAPB(PVM(7),C0,14); VNEXT(7); \
    GAPB(PVM(8),C1,0);  VNEXT(8); \
    GAPB(PVM(9),C1,2);  VNEXT(9); \
    KRD(GL,2); GAPB(PVM(10),C1,4); VNEXT(10); \
    GAPB(PVM(11),C1,6); \
    GAPB(PVM(12),C1,8); \
    KRD(GL,3); GAPB(PVM(13),C1,10); \
    GAPB(PVM(14),C1,12); \
    GAPB(PVM(15),C1,14); \
    }while(0)
  int t=1;
  for(;t+5<NT;t+=2){
    STEP(pB0,pB1,pA0,pA1,t,true,true,true);     WAIT_BAR(3); RESC(); ROT();
    STEP(pA0,pA1,pB0,pB1,t+1,true,true,true);   WAIT_BAR(3); RESC(); ROT();
  }
  #define ENDW(tt) do{ if((tt)+3<NT){WAIT_BAR(3);} else if((tt)+2<NT){WAIT_BAR(2);} else {WAIT_BAR(0);} }while(0)
  for(;t+1<NT;t+=2){
    STEP(pB0,pB1,pA0,pA1,t,(t+3<NT),(t+1<NT),(t+1<NT));       ENDW(t);   RESC(); ROT();
    STEP(pA0,pA1,pB0,pB1,t+1,(t+4<NT),(t+2<NT),(t+2<NT));     ENDW(t+1); RESC(); ROT();
  }
  STEP(pB0,pB1,pA0,pA1,NT-1,false,false,false); RESC();
  { float sacc=pB0[0]+pB0[1]; _Pragma("unroll") for(int r=2;r<16;++r)sacc+=pB0[r]; _Pragma("unroll") for(int r=0;r<16;++r)sacc+=pB1[r]; l_reg+=sacc;
    pw0=(u32x4){PKW(pB0,0),PKW(pB0,2),PKW(pB0,4),PKW(pB0,6)};pw1=(u32x4){PKW(pB0,8),PKW(pB0,10),PKW(pB0,12),PKW(pB0,14)};pw2=(u32x4){PKW(pB1,0),PKW(pB1,2),PKW(pB1,4),PKW(pB1,6)};pw3=(u32x4){PKW(pB1,8),PKW(pB1,10),PKW(pB1,12),PKW(pB1,14)};
    SBAR(); pv4(o,vb0+2*sl_cur,PAF(0),PAF(1),PAF(2),PAF(3)); }
  #undef PKW
  #undef PAF
  #undef VWF
  #undef PIN
  #undef MX3
  #undef GAPA
  #undef GAPB
  #undef EXS
  #undef VRD
  #undef KRD
  #undef PVM
  #undef PAF_SEL
  #undef VNEXT
  #undef STEP
  #undef ENDW
  {auto rr=__builtin_amdgcn_permlane32_swap(__float_as_uint(l_reg),__float_as_uint(l_reg),false,false);l_reg=__uint_as_float(rr[0])+__uint_as_float(rr[1]);}
  if(hi==0)wsf[32+r32]=l_reg;asm volatile("s_waitcnt lgkmcnt(0)":::"memory");
  float rli[16];
  #pragma unroll
  for(int r=0;r<16;++r)rli[r]=__builtin_amdgcn_rcpf(wsf[32+crow(r,hi)]);
  bf16*Ow=Ou+(long)(wid*QBLK)*op;
  { bf16*stg=(bf16*)(shm+V2_LDS_OST)+wid*2048;
    #pragma unroll
    for(int rd=0;rd<2;++rd){
      #pragma unroll
      for(int r=0;r<16;++r){const int orow=crow(r,hi);
        #pragma unroll
        for(int d0=0;d0<2;++d0)stg[orow*64+d0*32+r32]=__float2bfloat16(o[2*rd+d0][r]*rli[r]);}
      asm volatile("s_waitcnt lgkmcnt(0)":::"memory");
      #pragma unroll
      for(int i=0;i<4;++i){const int row=i*8+(lane>>3),ch=lane&7; const u32x4 v=*(const u32x4*)(stg+row*64+ch*8); ATTN_STORE16(Ow+(long)row*op+rd*64+ch*8,v);}
      asm volatile("s_waitcnt lgkmcnt(0)":::"memory"); } }
  asm volatile("s_waitcnt lgkmcnt(0)\n\ts_barrier":::"memory");
  #undef DMA_K
  #undef DMA_V
  #undef START
  #undef RESC
  #undef ROT
}
#undef SBAR
#undef WAIT_BAR
}
#define XB_TMO      128
#define XB_XCNT(j)  (256  + 64 * (j))
#define XB_XSUB(j)  (1280 + 64 * (j))
#define XB_XGEN(j)  (2304 + 64 * (j))
#define XB_TOP      3328
#define XB_TOPGEN   3392
#define XCD_BAR_WORDS 3456
#define XB_SPIN_CAP (1u << 18)

__device__ __forceinline__ unsigned xb_ld(unsigned* p)              { return __hip_atomic_load(p, __ATOMIC_RELAXED, __HIP_MEMORY_SCOPE_AGENT); }
__device__ __forceinline__ unsigned xb_add(unsigned* p, unsigned v) { return __hip_atomic_fetch_add(p, v, __ATOMIC_RELAXED, __HIP_MEMORY_SCOPE_AGENT); }
__device__ __forceinline__ unsigned xb_xcc_id() { return (unsigned)__builtin_amdgcn_s_getreg((3 << 11) | 20) & 0xFu; }
#define XB_SPIN(cond, bar) do { unsigned _sp = 0; while (cond) { __builtin_amdgcn_s_sleep(1); \
    if ((++_sp & 255u) == 0u) { if (xb_ld(&(bar)[XB_TMO])) break; if (_sp > XB_SPIN_CAP) { atomicAdd(&(bar)[XB_TMO], 1u); break; } } } } while (0)

struct XcdBarrier {
    unsigned* bar; unsigned x;
    volatile LAS unsigned* st;
};

__device__ __forceinline__ XcdBarrier xcd_barrier_post(unsigned* bar, volatile LAS unsigned* st, int tid) {
    XcdBarrier b; b.bar = bar; b.x = xb_xcc_id(); b.st = st;
    if (tid == 0) (void)xb_add(&bar[XB_XCNT(b.x)], 1u);
    return b;
}
__device__ __forceinline__ void xcd_barrier_complete(unsigned* bar, unsigned x, unsigned& nloc, unsigned& nx) {
    const unsigned G = gridDim.x * gridDim.y * gridDim.z;
    unsigned sum, cnt, mine, sp = 0u;
    for (;;) {
        sum = 0u; cnt = 0u; mine = 0u;
#pragma unroll
        for (unsigned j = 0; j < 16; ++j) { const unsigned c = xb_ld(&bar[XB_XCNT(j)]); sum += c; cnt += (c > 0u) ? 1u : 0u; mine = (j == x) ? c : mine; }
        if (sum == G) break;
        __builtin_amdgcn_s_sleep(1);
        if ((++sp & 255u) == 0u) { if (xb_ld(&bar[XB_TMO])) break; if (sp > XB_SPIN_CAP) { atomicAdd(&bar[XB_TMO], 1u); break; } }
    }
    nloc = mine > 0u ? mine : 1u; nx = cnt > 0u ? cnt : 1u;
}

__device__ __forceinline__ void xcd_barrier(const XcdBarrier& b, int tid) {
    asm volatile("s_waitcnt vmcnt(0)" ::: "memory");
    __syncthreads();
    if (tid == 0) {
        unsigned* bar = b.bar;
        __builtin_amdgcn_s_waitcnt(0);
        unsigned nloc = b.st[0], nx = b.st[1];
        if (nloc == 0u) { xcd_barrier_complete(bar, b.x, nloc, nx); b.st[0] = nloc; b.st[1] = nx; }
        const unsigned old = xb_add(&bar[XB_XSUB(b.x)], 1u);
        const unsigned gen = old / nloc;
        if (old + 1u == (gen + 1u) * nloc) {
            __builtin_amdgcn_fence(__ATOMIC_RELEASE, "agent");
            asm volatile("s_waitcnt vmcnt(0)" ::: "memory");
            const unsigned og = xb_add(&bar[XB_TOP], 1u);
            const unsigned tg = og / nx;
            if (og + 1u == (tg + 1u) * nx) xb_add(&bar[XB_TOPGEN], 1u);
            else XB_SPIN(xb_ld(&bar[XB_TOPGEN]) == tg, bar);
            __builtin_amdgcn_fence(__ATOMIC_ACQUIRE, "agent");
            xb_add(&bar[XB_XGEN(b.x)], 1u);
            asm volatile("s_waitcnt vmcnt(0)" ::: "memory");
        } else {
            XB_SPIN(xb_ld(&bar[XB_XGEN(b.x)]) == gen, bar);
            __builtin_amdgcn_fence(__ATOMIC_ACQUIRE, "agent");
            asm volatile("s_waitcnt vmcnt(0)" ::: "memory");
        }
    }
    __syncthreads();
}

struct Ctx { LAS unsigned char* lds; int tid, lane, wave, G, vcu; unsigned char* ws; };
struct Args { const float* in[28]; float* out; unsigned char* ws; int ph_lo, ph_hi, rep_mask, pad; };
typedef const __attribute__((address_space(4))) Args* CArgs;
__device__ __forceinline__ const float* inp(CArgs a, int i) { return (const float*)(GAS const float*)a->in[i]; }
enum { I_X = 0, I_C, I_CTX, I_CCTX, I_WADA, I_BADA, I_WIN, I_AQN, I_AKN, I_CONVW, I_CONVB, I_LWA, I_LBA, I_LWX, I_LBX, I_LLAM, I_DLAM, I_DSUB, I_WBR, I_WOUT, I_LN1G, I_LN1B, I_WR, I_WG, I_WU, I_WDN, I_LN2G, I_LN2B };

__device__ __forceinline__ void tr_item64(const float* W, int ldw, int k0, int n0, bf16* dst0, bf16* dst1, int pitch, LAS bf16* scr, int lane, bool permd = false) {
    f32x4 v[16];
    const float* src = W + (size_t)(k0 + (lane >> 4)) * ldw + n0 + 4 * (lane & 15);
#pragma unroll
    for (int i = 0; i < 16; ++i) v[i] = *(const f32x4*)(src + (size_t)(4 * i) * ldw);
#pragma unroll
    for (int i = 0; i < 16; ++i) { const unsigned p0 = cvt_pk_bf16(v[i][0], v[i][1]), p1 = cvt_pk_bf16(v[i][2], v[i][3]);
        LAS unsigned* q = (LAS unsigned*)(scr + (4 * i + (lane >> 4)) * 66 + 4 * (lane & 15)); q[0] = p0; q[1] = p1; }
    LDS_WAIT(); asm volatile("" ::: "memory");
    const int c = lane & 7;
#pragma unroll
    for (int j = 0; j < 8; ++j) { const int n = (lane >> 3) + 8 * j; const LAS bf16* t = scr + (8 * c) * 66 + n;
        v4u o; o.x = (unsigned)t[0] | ((unsigned)t[66] << 16); o.y = (unsigned)t[2 * 66] | ((unsigned)t[3 * 66] << 16);
        o.z = (unsigned)t[4 * 66] | ((unsigned)t[5 * 66] << 16); o.w = (unsigned)t[6 * 66] | ((unsigned)t[7 * 66] << 16);
        const int nl = n & 31, nr = permd ? (16 * ((nl >> 2) & 1) + 4 * (nl >> 3) + (nl & 3)) : nl;
        bf16* d = ((j < 4) ? dst0 : dst1) + (size_t)nr * pitch;
        *(GAS v4u*)(d + 8 * c) = o; }
    LDS_WAIT(); asm volatile("" ::: "memory");
}

__device__ __forceinline__ void tr_item64_f8(const float* W, int ldw, int k0, int n0, unsigned char* dst0, unsigned char* dst1, int pitch, float scale, LAS bf16* scr, int lane, bool permd = false) {
    f32x4 v[16];
    const float* src = W + (size_t)(k0 + (lane >> 4)) * ldw + n0 + 4 * (lane & 15);
#pragma unroll
    for (int i = 0; i < 16; ++i) v[i] = *(const f32x4*)(src + (size_t)(4 * i) * ldw);
#pragma unroll
    for (int i = 0; i < 16; ++i) { const unsigned p0 = cvt_pk_bf16(v[i][0], v[i][1]), p1 = cvt_pk_bf16(v[i][2], v[i][3]);
        LAS unsigned* q = (LAS unsigned*)(scr + (4 * i + (lane >> 4)) * 66 + 4 * (lane & 15)); q[0] = p0; q[1] = p1; }
    LDS_WAIT(); asm volatile("" ::: "memory");
    const int c = lane & 3;
#pragma unroll
    for (int j = 0; j < 4; ++j) { const int n = (lane >> 2) + 16 * j; const LAS bf16* t = scr + (16 * c) * 66 + n;
        float f[16];
#pragma unroll
        for (int q = 0; q < 16; ++q) f[q] = __uint_as_float((unsigned)t[q * 66] << 16) * scale;
        v4u o; o.x = pg8::pk_fp8x4(f[0], f[1], f[2], f[3]); o.y = pg8::pk_fp8x4(f[4], f[5], f[6], f[7]); o.z = pg8::pk_fp8x4(f[8], f[9], f[10], f[11]); o.w = pg8::pk_fp8x4(f[12], f[13], f[14], f[15]);
        const int nl8 = n & 31, nr8 = permd ? (16 * ((nl8 >> 2) & 1) + 4 * (nl8 >> 3) + (nl8 & 3)) : nl8;
        unsigned char* d = ((j < 2) ? dst0 : dst1) + (size_t)nr8 * pitch;
        *(GAS v4u*)(d + 16 * c) = o; }
    LDS_WAIT(); asm volatile("" ::: "memory");
}

struct CvItem { const float* src; unsigned voff; int ldw; unsigned char* d0; unsigned char* d1; int pitch; float scale; };
__device__ __forceinline__ void cv_load(f32x4 (&v)[16], const CvItem& c) {
#pragma unroll
    for (int i = 0; i < 16; ++i) v[i] = *(const f32x4*)((const char*)uni(c.src + (size_t)(4 * i) * c.ldw) + c.voff);
}
__device__ __forceinline__ void cv_finish(const f32x4 (&v)[16], const CvItem& ci, LAS bf16* scr, int lane) {
#pragma unroll
    for (int i = 0; i < 16; ++i) { const unsigned p0 = cvt_pk_bf16(v[i][0], v[i][1]), p1 = cvt_pk_bf16(v[i][2], v[i][3]);
        LAS unsigned* q = (LAS unsigned*)(scr + (4 * i + (lane >> 4)) * 66 + 4 * (lane & 15)); q[0] = p0; q[1] = p1; }
    LDS_WAIT(); asm volatile("" ::: "memory");
    const int c = lane & 3;
#pragma unroll
    for (int j = 0; j < 4; ++j) { const int n = (lane >> 2) + 16 * j; const LAS bf16* t = scr + (16 * c) * 66 + n;
        float f[16];
#pragma unroll
        for (int q = 0; q < 16; ++q) f[q] = __uint_as_float((unsigned)t[q * 66] << 16) * ci.scale;
        v4u o; o.x = pg8::pk_fp8x4(f[0], f[1], f[2], f[3]); o.y = pg8::pk_fp8x4(f[4], f[5], f[6], f[7]); o.z = pg8::pk_fp8x4(f[8], f[9], f[10], f[11]); o.w = pg8::pk_fp8x4(f[12], f[13], f[14], f[15]);
        unsigned char* d = (j < 2) ? ci.d0 + (size_t)n * ci.pitch : ci.d1 + (size_t)(n - 32) * ci.pitch;
        *(GAS v4u*)(d + 16 * c) = o; }
    LDS_WAIT(); asm volatile("" ::: "memory");
}
__device__ __forceinline__ void cv_pack(const f32x4 (&v)[16], unsigned (&pk)[32]) {
#pragma unroll
    for (int i = 0; i < 16; ++i) { pk[2 * i] = cvt_pk_bf16(v[i][0], v[i][1]); pk[2 * i + 1] = cvt_pk_bf16(v[i][2], v[i][3]); }
}
__device__ __forceinline__ void cv_finish_p(const unsigned (&pk)[32], const CvItem& ci, LAS bf16* scr, int lane) {
#pragma unroll
    for (int i = 0; i < 16; ++i) { LAS unsigned* q = (LAS unsigned*)(scr + (4 * i + (lane >> 4)) * 66 + 4 * (lane & 15)); q[0] = pk[2 * i]; q[1] = pk[2 * i + 1]; }
    LDS_WAIT(); asm volatile("" ::: "memory");
    const int c = lane & 3;
#pragma unroll
    for (int j = 0; j < 4; ++j) { const int n = (lane >> 2) + 16 * j; const LAS bf16* t = scr + (16 * c) * 66 + n;
        float f[16];
#pragma unroll
        for (int q = 0; q < 16; ++q) f[q] = __uint_as_float((unsigned)t[q * 66] << 16) * ci.scale;
        v4u o; o.x = pg8::pk_fp8x4(f[0], f[1], f[2], f[3]); o.y = pg8::pk_fp8x4(f[4], f[5], f[6], f[7]); o.z = pg8::pk_fp8x4(f[8], f[9], f[10], f[11]); o.w = pg8::pk_fp8x4(f[12], f[13], f[14], f[15]);
        unsigned char* d = (j < 2) ? ci.d0 + (size_t)n * ci.pitch : ci.d1 + (size_t)(n - 32) * ci.pitch;
        *(GAS v4u*)(d + 16 * c) = o; }
    LDS_WAIT(); asm volatile("" ::: "memory");
}
__device__ __forceinline__ void cv_pack8(const f32x4 (&v)[16], float scale, unsigned (&P)[4][4]) {
#pragma unroll
    for (int j = 0; j < 4; ++j)
#pragma unroll
        for (int g = 0; g < 4; ++g) P[j][g] = pg8::pk_fp8x4(v[4 * g][j] * scale, v[4 * g + 1][j] * scale, v[4 * g + 2][j] * scale, v[4 * g + 3][j] * scale);
}
__device__ __forceinline__ void cv_store8(const unsigned (&P)[4][4], const CvItem& ci, int lane) {
    const int n = 4 * (lane & 15) + (lane >> 4);
    unsigned char* d = (n < 32) ? ci.d0 + (size_t)n * ci.pitch : ci.d1 + (size_t)(n - 32) * ci.pitch;
#pragma unroll
    for (int g = 0; g < 4; ++g) {
        const auto a = __builtin_amdgcn_permlane16_swap(P[0][g], P[1][g], false, false); const auto b = __builtin_amdgcn_permlane16_swap(P[2][g], P[3][g], false, false);
        const auto c = __builtin_amdgcn_permlane32_swap(a[0], b[0], false, false); const auto e = __builtin_amdgcn_permlane32_swap(a[1], b[1], false, false);
        const unsigned q0 = c[0], q2 = c[1], q1 = e[0], q3 = e[1];
        const unsigned t0 = __builtin_amdgcn_perm(q1, q0, 0x05010400u), t1 = __builtin_amdgcn_perm(q1, q0, 0x07030602u), t2 = __builtin_amdgcn_perm(q3, q2, 0x05010400u), t3 = __builtin_amdgcn_perm(q3, q2, 0x07030602u);
        v4u o; o.x = __builtin_amdgcn_perm(t2, t0, 0x05040100u); o.y = __builtin_amdgcn_perm(t2, t0, 0x07060302u); o.z = __builtin_amdgcn_perm(t3, t1, 0x05040100u); o.w = __builtin_amdgcn_perm(t3, t1, 0x07060302u);
        *(GAS v4u*)(d + 16 * g) = o; }
}
constexpr int CV_ITEMS = 3 * 11008, CV_IN_LRU = 0, CV_IN_ATT = 16;
__device__ __forceinline__ CvItem cv_make(CArgs a, unsigned char* ws, int l, int it, int lane) {
    CvItem c; const int which = it / 11008, r = it % 11008, e = r / 688, q = r % 688;
    if (which < 2) { const int kb = q / 43, nb = q % 43, n0 = nb * 64, k0 = kb * 64;
        const float* W = inp(a, which == 0 ? I_WG : I_WU) + ((size_t)(l * NE + e) * D) * FF;
        const int drow = e * 5632 + (n0 >> 7) * 256 + (n0 & 127) + which * 128; unsigned char* d0 = ws + WS_WGU + (size_t)drow * D + k0;
        c.src = W + (size_t)k0 * FF + n0; c.voff = (unsigned)((lane >> 4) * FF + 4 * (lane & 15)) * 4u; c.ldw = FF; c.d0 = d0; c.d1 = d0 + (size_t)32 * D; c.pitch = D; c.scale = WSC_GU; }
    else { const int kb = q / 16, nb = q % 16, n0 = nb * 64, k0 = kb * 64;
        const float* W = inp(a, I_WDN) + ((size_t)(l * NE + e) * FF) * D; unsigned char* d0 = ws + WS_WD + ((size_t)e * D + n0) * FFP + k0;
        c.src = W + (size_t)k0 * D + n0; c.voff = (unsigned)((lane >> 4) * D + 4 * (lane & 15)) * 4u; c.ldw = D; c.d0 = d0; c.d1 = d0 + (size_t)32 * FFP; c.pitch = FFP; c.scale = WSC_D; }
    return c;
}

__device__ __forceinline__ void ph_prologue(const Ctx& X, CArgs a) {
    float* MOD = (float*)(X.ws + WS_MOD);
    if ((int)blockIdx.x < 384) {
        LAS float* SV = (LAS float*)X.lds;
        LAS float* RED = (LAS float*)(X.lds + 5 * 1024 * 4);
        for (int i = X.tid; i < 5 * 1024; i += 512) { const int v = i >> 10, k = i & 1023; const float cv = v < 4 ? inp(a, I_C)[v * 1024 + k] : inp(a, I_CCTX)[k]; SV[i] = silu_f(cv); }
        __syncthreads();
        for (int it = blockIdx.x; it < 384; it += X.G) {
            const int l = it / 192, n0 = (it % 192) * 32, kg = X.tid >> 5, cn = X.tid & 31;
            const float* W = inp(a, I_WADA) + (size_t)l * 1024 * 6144 + n0 + cn;
            float acc[5] = {0.f, 0.f, 0.f, 0.f, 0.f};
#pragma unroll 16
            for (int k = kg; k < 1024; k += 16) { const float w = W[(size_t)k * 6144];
#pragma unroll
                for (int v = 0; v < 5; ++v) acc[v] += SV[v * 1024 + k] * w; }
#pragma unroll
            for (int v = 0; v < 5; ++v) RED[(kg * 5 + v) * 32 + cn] = acc[v];
            __syncthreads();
            if (X.tid < 160) { const int v = X.tid >> 5; float s = 0.f;
                for (int q = 0; q < 16; ++q) s += RED[(q * 5 + v) * 32 + cn];
                MOD[(l * 5 + v) * 6144 + n0 + cn] = s + inp(a, I_BADA)[l * 6144 + n0 + cn]; }
            __syncthreads();
        }
    }
    LAS bf16* scr = (LAS bf16*)(X.lds + 32768 + X.wave * 8448);
    const int gw = X.vcu * NWAVES + X.wave, NGW = X.G * NWAVES;
    bf16* WIN = (bf16*)(X.ws + WS_WIN); bf16* WBR = (bf16*)(X.ws + WS_WBR); bf16* WOUT = (bf16*)(X.ws + WS_WOUT);
    for (int it = gw; it < 3200 + 768 + 512; it += NGW) {
        if (it < 3200) { const int l = it / 1600, r = it % 1600, kb = r / 100, nb = r % 100, n0 = nb * 64, k0 = kb * 64;
            const int tile = n0 >> 8, wc = (n0 & 255) >> 6, drow = tile * 256 + 32 * wc;
            bf16* d0 = WIN + (size_t)l * DIN * D + (size_t)drow * D + k0;
            if (n0 < 3328) tr_item64(inp(a, I_WIN) + (size_t)l * D * DIN, DIN, k0, n0, d0, d0 + (size_t)128 * D, D, scr, X.lane);
            else { unsigned char* e0 = (unsigned char*)(WIN + (size_t)l * DIN * D + (size_t)3328 * D) + (size_t)(n0 - 3328) * D + k0;
                tr_item64_f8(inp(a, I_WIN) + (size_t)l * D * DIN, DIN, k0, n0, e0, e0 + (size_t)32 * D, D, WSC_GU, scr, X.lane, true); } }
        else if (it < 3200 + 768) { const int q = it - 3200, ln = q / 128, r = q % 128, kb = r / 16, nb = r % 16, n0 = nb * 64, k0 = kb * 64;
            bf16* d0 = WBR + (size_t)ln * 1024 * 512 + (size_t)n0 * 512 + k0;
            tr_item64(inp(a, I_WBR) + (size_t)ln * 512 * 1024, 1024, k0, n0, d0, d0 + (size_t)32 * 512, 512, scr, X.lane); }
        else { const int q = it - 3968, l = q / 256, r = q % 256, kb = r / 16, nb = r % 16, n0 = nb * 64, k0 = kb * 64;
            bf16* d0 = WOUT + (size_t)l * D * D + (size_t)n0 * D + k0;
            tr_item64(inp(a, I_WOUT) + (size_t)l * D * D, D, k0, n0, d0, d0 + (size_t)32 * D, D, scr, X.lane); }
    }
    bf16* LW = (bf16*)(X.ws + WS_LRUW);
    for (int i = gw * 64 + X.lane; i < 2 * 2 * 2 * 8 * 4096; i += NGW * 64) {
        const int k = i & 63, n = (i >> 6) & 63, g = (i >> 12) & 7, gate = (i >> 15) & 1, d = (i >> 16) & 1, l = i >> 17;
        const float* src = gate ? inp(a, I_LWX) : inp(a, I_LWA);
        const float w = src[((((size_t)l * 2 + d) * 8 + g) * 64 + k) * 64 + n];
        LW[i] = (bf16)(cvt_pk_bf16(w, 0.f) & 0xffffu);
    }
}

__device__ __forceinline__ const float* xrow_ptr(CArgs a, unsigned char* ws, int l, int r) {
    if (l == 0) return r < T ? inp(a, I_X) + (size_t)r * D : inp(a, I_CTX) + (size_t)(r - T) * D;
    return (const float*)(ws + WS_X2) + (size_t)r * D;
}
__device__ __forceinline__ const float* mod_ptr(unsigned char* ws, int l, int r) { const int v = r < T ? (r >> 13) : 4; return (const float*)(ws + WS_MOD) + (size_t)(l * 5 + v) * 6144; }

__device__ __forceinline__ void ph_make_xh0(const Ctx& X, CArgs a) {
    const int gw = X.vcu * NWAVES + X.wave, NGW = X.G * NWAVES;
    bf16* XH = (bf16*)(X.ws + WS_SA);
    for (int r0 = gw * 4; r0 < R; r0 += NGW * 4) {
        const float* md = mod_ptr(X.ws, 0, r0);
        f32x4 x[4][4];
#pragma unroll
        for (int q = 0; q < 4; ++q) { const float* xr = xrow_ptr(a, X.ws, 0, r0 + q);
#pragma unroll
            for (int j = 0; j < 4; ++j) x[q][j] = *(const f32x4*)(xr + 4 * X.lane + 256 * j); }
#pragma unroll
        for (int j = 0; j < 4; ++j) { const int c = 4 * X.lane + 256 * j; const f32x4 sh = *(const f32x4*)(md + c), sc = *(const f32x4*)(md + 1024 + c) + 1.0f;
#pragma unroll
            for (int q = 0; q < 4; ++q) { const f32x4 h = x[q][j] * sc + sh; v2u w; w.x = cvt_pk_bf16(h[0], h[1]); w.y = cvt_pk_bf16(h[2], h[3]);
                *(v2u*)(XH + (size_t)(r0 + q) * D + c) = w; *(unsigned*)(X.ws + WS_XH8 + (size_t)(r0 + q) * D + c) = pg8::pk_fp8x4(h[0], h[1], h[2], h[3]); } }
    }
}

__device__ __forceinline__ f32x2 lru_comp(f32x2 first, f32x2 second) { return (f32x2){first.x * second.x, second.x * first.y + second.y}; }
template <int PASS> __device__ __forceinline__ void ph_lru(const Ctx& X, CArgs a, int l, bool need_ctx) {
    LAS float* U = (LAS float*)X.lds;
    LAS f32x2* WAG = (LAS f32x2*)(X.lds + 34816);
    LAS float* PRE = (LAS float*)(X.lds + 34816 + 8192);
    LAS f32x2* CAR = (LAS f32x2*)(X.lds + 34816 + 8192 + 4096);
    LAS v4u* BW = (LAS v4u*)(X.lds + 51200);
    LAS float* CW = (LAS float*)(X.lds + 51200 + 32768);
    unsigned char* wsl = X.ws;
#define LRU_WS(off) (wsl + (off))
#define XB ((const bf16*)LRU_WS(WS_XB))
#define GB ((const bf16*)LRU_WS(WS_GB))
#define YB ((bf16*)LRU_WS(WS_BR) + (size_t)R * 512)
#define LW ((const bf16*)LRU_WS(WS_LRUW) + (size_t)l * 2 * 2 * 8 * 4096)
#define AGG ((f32x2*)LRU_WS(WS_AGG))
#define LBQ ((v4u*)LRU_WS(WS_MM32))
    const int w = X.wave;
    int tid_o = X.tid; asm volatile("" : "+v"(tid_o));
    int quad = (tid_o & 63) >> 4, l16 = tid_o & 15, tt = tid_o >> 2, c16 = (tid_o & 3) * 16;
    int gcur = -1; float cba[2][4], cbx[2][4], csp[2][4];
#define LRU_ITEM(it_, b_, sc_, g_) const int b_ = (it_) / 528, sc_ = ((it_) % 528) >> 3, g_ = (it_) & 7
#define LRU_LOADX(dst, it_) do { LRU_ITEM(it_, b__, sc__, g__); const int slo = sc__ < 2 ? T + b__ * CTX : b__ * SEQ, sln = sc__ < 2 ? CTX : SEQ, tq = (sc__ < 2 ? sc__ * 128 : (sc__ - 2) * 128) + tt - 2; \
        _Pragma("unroll") for (int j = 0; j < 4; ++j) { const int t = tq + j; const bool ok = t >= 0 && t < sln; const bf16* p = XB + (size_t)(slo + (ok ? t : 0)) * 512 + g__ * 64 + c16; \
            dst[j][0] = ok ? *(const v4u*)p : (v4u){0u, 0u, 0u, 0u}; dst[j][1] = ok ? *(const v4u*)(p + 8) : (v4u){0u, 0u, 0u, 0u}; } } while (0)
    v4u xc[4][2];
    int item = blockIdx.x;
    while (item < NB * 66 * 8 && PASS == 2 && !need_ctx && ((item % 528) >> 3) < 2) item += X.G;
    if (PASS == 1 && item < NB * 66 * 8) LRU_LOADX(xc, item);
    int cvk = 0;
    while (item < NB * 66 * 8) {
        LRU_ITEM(item, b, sc, g);
        { unsigned long long w_ = (unsigned long long)X.ws; asm volatile("" : "+s"(w_)); wsl = (unsigned char*)(GAS unsigned char*)w_; }
        asm volatile("" : "+v"(tid_o)); quad = (tid_o & 63) >> 4; l16 = tid_o & 15; tt = tid_o >> 2; c16 = (tid_o & 3) * 16;
        int nitem = item + X.G;
        f32x4 cvv[16]; CvItem cvi; const bool cvh = PASS == 2 && cvk < CV_IN_LRU;
        while (nitem < NB * 66 * 8 && PASS == 2 && !need_ctx && ((nitem % 528) >> 3) < 2) nitem += X.G;
        const int seqlo = sc < 2 ? T + b * CTX : b * SEQ, t0 = sc < 2 ? sc * 128 : (sc - 2) * 128;
        if (PASS == 1 && g != gcur) {
            __syncthreads();
            CArgs a2 = a; asm volatile("" : "+s"(a2));
            const bf16* lw_ = LW;
            for (int i = X.tid; i < 2048; i += 512) { const int slot = i >> 6, ln = i & 63, ks = slot & 1, nt = (slot >> 1) & 3, dg = slot >> 3;
                BW[i] = *(const v4u*)(lw_ + ((size_t)(dg * 8 + g) * 64 + nt * 16 + (ln & 15)) * 64 + ks * 32 + 8 * (ln >> 4)); }
            if (X.tid < 320) { const int j = X.tid >> 6, ch = X.tid & 63; CW[X.tid] = j < 4 ? inp(a2, I_CONVW)[(l * 4 + j) * 512 + g * 64 + ch] : inp(a2, I_CONVB)[l * 512 + g * 64 + ch]; }
#pragma unroll
            for (int d = 0; d < 2; ++d)
#pragma unroll
                for (int nt = 0; nt < 4; ++nt) { const int ch = g * 64 + nt * 16 + l16;
                    cba[d][nt] = inp(a2, I_LBA)[(l * 2 + d) * 512 + ch]; cbx[d][nt] = inp(a2, I_LBX)[(l * 2 + d) * 512 + ch];
                    const float el = fast_exp(-inp(a2, I_LLAM)[(l * 2 + d) * 512 + ch]);
                    csp[d][nt] = el < 0.03f ? el * (1.0f - el * (0.5f - el * (0.33333334f - el * 0.25f))) : __builtin_amdgcn_logf(1.0f + el) * 0.6931471805599453f; }
            gcur = g;
            __syncthreads();
        }
        if (PASS == 2) {
        { const int dc = tid_o & 127, d = dc >> 6, ch = dc & 63, sg = tid_o >> 7;
          const f32x2* ag = AGG + (size_t)(b * 2 + d) * 66 * 512 + g * 64 + ch;
          const int npos = d == 0 ? sc : (sc == 1 ? 0 : (sc == 0 ? 1 : 67 - sc));
          f32x2 qv[17];
#pragma unroll
          for (int k = 0; k < 17; ++k) { const int p = sg * 17 + k; const int c = d == 0 ? p : (p == 0 ? 1 : (p == 1 ? 0 : 67 - p));
              qv[k] = p < npos ? ag[(size_t)c * 512] : (f32x2){1.f, 0.f}; }
          f32x2 part = {1.f, 0.f};
#pragma unroll
          for (int k = 0; k < 17; ++k) part = lru_comp(part, qv[k]);
          CAR[sg * 128 + dc] = part; }
        }
        if (PASS == 1) { float u[16];
#pragma unroll
          for (int k = 0; k < 16; k += 4) { const f32x4 bvv = *(const LAS f32x4*)(CW + 256 + c16 + k); u[k] = bvv[0]; u[k + 1] = bvv[1]; u[k + 2] = bvv[2]; u[k + 3] = bvv[3]; }
#pragma unroll
          for (int j = 0; j < 4; ++j) { const unsigned xw[8] = {xc[j][0].x, xc[j][0].y, xc[j][0].z, xc[j][0].w, xc[j][1].x, xc[j][1].y, xc[j][1].z, xc[j][1].w};
#pragma unroll
              for (int k = 0; k < 16; k += 4) { const f32x4 wv = *(const LAS f32x4*)(CW + j * 64 + c16 + k);
                  u[k] += wv[0] * bf_lo(xw[k >> 1]); u[k + 1] += wv[1] * bf_hi(xw[k >> 1]); u[k + 2] += wv[2] * bf_lo(xw[(k >> 1) + 1]); u[k + 3] += wv[3] * bf_hi(xw[(k >> 1) + 1]); } }
#pragma unroll
          for (int k = 0; k < 16; k += 4) *(LAS f32x4*)(U + tt * 68 + c16 + k) = (f32x4){u[k], u[k + 1], u[k + 2], u[k + 3]}; }
        if (PASS == 1 && nitem < NB * 66 * 8) LRU_LOADX(xc, nitem);
        const int rowb = seqlo + t0 + 16 * w + 4 * quad;
        unsigned short gbq[4][4];
        if (PASS == 2) {
#pragma unroll
            for (int nt = 0; nt < 4; ++nt)
#pragma unroll
                for (int i = 0; i < 4; ++i) gbq[nt][i] = GB[(size_t)(rowb + i) * 512 + g * 64 + nt * 16 + l16]; }
        v4u lbq[8];
        if (PASS == 2) {
#pragma unroll
            for (int k = 0; k < 8; ++k) lbq[k] = LBQ[((size_t)item * 8 + k) * 512 + tid_o]; }
        if (cvh) { cvi = cv_make(a, X.ws, l, (X.vcu * NWAVES + w) + cvk * (X.G * NWAVES), tid_o & 63); cv_load(cvv, cvi); }
        if (PASS == 1) __syncthreads();
        float av[2][4][4], bv[2][4][4];
        if (PASS == 1) {
        bf16x8 af[2];
#pragma unroll
        for (int ks = 0; ks < 2; ++ks) { const LAS float* up = U + (16 * w + l16) * 68 + ks * 32 + 8 * quad; const f32x4 p0 = *(const LAS f32x4*)up, p1 = *(const LAS f32x4*)(up + 4);
            v4u pk; pk.x = cvt_pk_bf16(p0[0], p0[1]); pk.y = cvt_pk_bf16(p0[2], p0[3]); pk.z = cvt_pk_bf16(p1[0], p1[1]); pk.w = cvt_pk_bf16(p1[2], p1[3]); af[ks] = __builtin_bit_cast(bf16x8, pk); }
#pragma unroll
        for (int d = 0; d < 2; ++d)
#pragma unroll
            for (int nt = 0; nt < 4; ++nt) {
                f32x4 cr = {0.f, 0.f, 0.f, 0.f}, ci = {0.f, 0.f, 0.f, 0.f};
#pragma unroll
                for (int ks = 0; ks < 2; ++ks) {
                    const bf16x8 br = __builtin_bit_cast(bf16x8, BW[((((d * 2 + 0) * 4 + nt) * 2 + ks) << 6) + (tid_o & 63)]);
                    const bf16x8 bi = __builtin_bit_cast(bf16x8, BW[((((d * 2 + 1) * 4 + nt) * 2 + ks) << 6) + (tid_o & 63)]);
                    cr = __builtin_amdgcn_mfma_f32_16x16x32_bf16(af[ks], br, cr, 0, 0, 0);
                    ci = __builtin_amdgcn_mfma_f32_16x16x32_bf16(af[ks], bi, ci, 0, 0, 0);
                }
                const float ba = cba[d][nt], bx = cbx[d][nt], sp = csp[d][nt];
                unsigned pkw[4];
#pragma unroll
                for (int i = 0; i < 4; ++i) {
                    const float uu = U[(16 * w + 4 * quad + i) * 68 + nt * 16 + l16];
                    const float rr = sigmoid_f(cr[i] + ba), ii = sigmoid_f(ci[i] + bx);
                    const float la = -8.0f * rr * sp, x2 = 2.0f * la;
                    const float om = x2 > -0.25f ? -x2 * (1.0f + x2 * (0.5f + x2 * (0.16666667f + x2 * (0.041666668f + x2 * (0.008333334f + x2 * 0.0013888889f))))) : 1.0f - fast_exp(x2);
                    av[d][nt][i] = fast_exp(la); bv[d][nt][i] = __builtin_amdgcn_sqrtf(om) * (ii * uu);
                    pkw[i] = (unsigned)__builtin_bit_cast(unsigned short, (_Float16)la) | cvt_pk_bf16(0.f, bv[d][nt][i]);
                }
                LBQ[((size_t)item * 8 + d * 4 + nt) * 512 + tid_o] = (v4u){pkw[0], pkw[1], pkw[2], pkw[3]};
            }
        } else {
#pragma unroll
        for (int d = 0; d < 2; ++d)
#pragma unroll
            for (int nt = 0; nt < 4; ++nt) { const v4u q4 = lbq[d * 4 + nt]; const unsigned qq[4] = {q4.x, q4.y, q4.z, q4.w};
#pragma unroll
                for (int i = 0; i < 4; ++i) { av[d][nt][i] = fast_exp((float)__builtin_bit_cast(_Float16, (unsigned short)(qq[i] & 0xffffu))); bv[d][nt][i] = __uint_as_float(qq[i] & 0xffff0000u); } }
        }
        f32x2 seg[2][4];
#pragma unroll
        for (int nt = 0; nt < 4; ++nt) {
            { float A = 1.f, H = 0.f;
#pragma unroll
              for (int i = 0; i < 4; ++i) { H = av[0][nt][i] * H + bv[0][nt][i]; A *= av[0][nt][i]; } seg[0][nt] = (f32x2){A, H}; }
            { float A = 1.f, H = 0.f;
#pragma unroll
              for (int i = 3; i >= 0; --i) { H = av[1][nt][i] * H + bv[1][nt][i]; A *= av[1][nt][i]; } seg[1][nt] = (f32x2){A, H}; }
        }
#pragma unroll
        for (int d = 0; d < 2; ++d)
#pragma unroll
            for (int nt = 0; nt < 4; ++nt) {
                f32x2 tot = seg[d][nt];
#pragma unroll
                for (int off = 16; off <= 32; off <<= 1) {
                    const f32x2 o = (f32x2){__shfl_xor(tot.x, off), __shfl_xor(tot.y, off)};
                    const bool me_low = (X.lane & off) == 0;
                    const bool me_first = (d == 0) ? me_low : !me_low;
                    tot = me_first ? lru_comp(tot, o) : lru_comp(o, tot);
                }
                if (quad == 0) WAG[(d * 8 + w) * 64 + nt * 16 + l16] = tot;
            }
        __syncthreads();
        if (PASS == 1) {
            if (X.tid < 128) { const int d = X.tid >> 6, ch = X.tid & 63; f32x2 tot = (f32x2){1.f, 0.f};
                for (int q = 0; q < 8; ++q) { const int ww = d == 0 ? q : 7 - q; tot = lru_comp(tot, WAG[(d * 8 + ww) * 64 + ch]); }
                AGG[((size_t)(b * 2 + d) * 66 + sc) * 512 + g * 64 + ch] = tot; }
            __syncthreads();
        } else {
            if (X.tid < 128) { const int d = X.tid >> 6, ch = X.tid & 63; float st = 0.f;
#pragma unroll
                for (int sg = 0; sg < 4; ++sg) { const f32x2 q = CAR[sg * 128 + X.tid]; st = q.x * st + q.y; }
                for (int q = 0; q < 8; ++q) { const int ww = d == 0 ? q : 7 - q; PRE[(d * 8 + ww) * 64 + ch] = st; const f32x2 t2 = WAG[(d * 8 + ww) * 64 + ch]; st = t2.x * st + t2.y; } }
            __syncthreads();
#pragma unroll
            for (int nt = 0; nt < 4; ++nt) {
                float y[4];
                { float s = PRE[(0 * 8 + w) * 64 + nt * 16 + l16];
#pragma unroll
                  for (int q = 0; q < 4; ++q) { const float A = __shfl(seg[0][nt].x, q * 16 + l16), H = __shfl(seg[0][nt].y, q * 16 + l16); if (q < quad) s = A * s + H; }
#pragma unroll
                  for (int i = 0; i < 4; ++i) { s = av[0][nt][i] * s + bv[0][nt][i]; y[i] = s; } }
                { float s = PRE[(1 * 8 + w) * 64 + nt * 16 + l16];
#pragma unroll
                  for (int q = 3; q >= 0; --q) { const float A = __shfl(seg[1][nt].x, q * 16 + l16), H = __shfl(seg[1][nt].y, q * 16 + l16); if (q > quad) s = A * s + H; }
#pragma unroll
                  for (int i = 3; i >= 0; --i) { s = av[1][nt][i] * s + bv[1][nt][i]; y[i] += s; } }
                const int ch = g * 64 + nt * 16 + l16;
#pragma unroll
                for (int i = 0; i < 4; ++i) { const size_t o = (size_t)(rowb + i) * 512 + ch; const float gbv = __uint_as_float((unsigned)gbq[nt][i] << 16);
                    YB[o] = (bf16)(cvt_pk_bf16(y[i] * gbv, 0.f) & 0xffffu); }
            }
            __syncthreads();
        }
        if (cvh) { cv_finish(cvv, cvi, (LAS bf16*)(X.lds + 51200 + w * 8448), tid_o & 63); ++cvk; }
        item = nitem;
    }
    for (; PASS == 2 && cvk < CV_IN_LRU; ++cvk) {
        const CvItem ci = cv_make(a, X.ws, l, (X.vcu * NWAVES + w) + cvk * (X.G * NWAVES), tid_o & 63); f32x4 v[16]; cv_load(v, ci); cv_finish(v, ci, (LAS bf16*)(X.lds + 51200 + w * 8448), tid_o & 63); }
#undef LRU_ITEM
#undef LRU_LOADX
#undef LRU_WS
#undef XB
#undef GB
#undef YB
#undef LW
#undef AGG
#undef LBQ
}

__device__ __forceinline__ void ph_diff_combine(const Ctx& X, CArgs a, int l, int nrows) {
    const int gw = X.vcu * NWAVES + X.wave, NGW = X.G * NWAVES;
    const float lam_init = l == 0 ? 0.2f : 0.35550906759096926f;
    const float* dl = inp(a, I_DLAM) + l * 256;
    const float s1 = wave_sum(dl[X.lane] * dl[64 + X.lane]), s2 = wave_sum(dl[128 + X.lane] * dl[192 + X.lane]);
    const float lam = expf(s1) - expf(s2) + lam_init;
    const bf16* DO0 = (const bf16*)(X.ws + WS_DO); const bf16* DO1 = DO0 + (size_t)R * 512; bf16* YC = (bf16*)(X.ws + WS_BR) + (size_t)2 * R * 512;
    const float* sub = inp(a, I_DSUB) + l * 128 + (8 * X.lane & 127);
    const f32x4 g0 = *(const f32x4*)sub, g1 = *(const f32x4*)(sub + 4);
    const float post = 1.0f - lam_init;
    for (int r = gw; r < nrows; r += NGW) {
        const v4u p = *(const v4u*)(DO0 + (size_t)r * 512 + 8 * X.lane), q = *(const v4u*)(DO1 + (size_t)r * 512 + 8 * X.lane);
        float v[8] = {bf_lo(p.x) - lam * bf_lo(q.x), bf_hi(p.x) - lam * bf_hi(q.x), bf_lo(p.y) - lam * bf_lo(q.y), bf_hi(p.y) - lam * bf_hi(q.y),
                      bf_lo(p.z) - lam * bf_lo(q.z), bf_hi(p.z) - lam * bf_hi(q.z), bf_lo(p.w) - lam * bf_lo(q.w), bf_hi(p.w) - lam * bf_hi(q.w)};
        float ss = 0.f;
#pragma unroll
        for (int k = 0; k < 8; ++k) ss += v[k] * v[k];
        ss += __shfl_xor(ss, 1); ss += __shfl_xor(ss, 2); ss += __shfl_xor(ss, 4); ss += __shfl_xor(ss, 8);
        const float rinv = __builtin_amdgcn_rsqf(ss * (1.0f / 128.0f) + RMS_EPS) * post;
        v4u o; o.x = cvt_pk_bf16(v[0] * rinv * g0[0], v[1] * rinv * g0[1]); o.y = cvt_pk_bf16(v[2] * rinv * g0[2], v[3] * rinv * g0[3]);
        o.z = cvt_pk_bf16(v[4] * rinv * g1[0], v[5] * rinv * g1[1]); o.w = cvt_pk_bf16(v[6] * rinv * g1[2], v[7] * rinv * g1[3]);
        *(v4u*)(YC + (size_t)r * 512 + 8 * X.lane) = o;
    }
}

__device__ __forceinline__ void ph_ln1_router(const Ctx& X, CArgs a, int l, int nrows) {
    const int gw = X.vcu * NWAVES + X.wave, NGW = X.G * NWAVES;
    LAS float* WR = (LAS float*)X.lds;
    for (int i = X.tid; i < 16 * 1024; i += 512) { const int c = i >> 4, e = i & 15; WR[e * 1024 + c] = inp(a, I_WR)[(size_t)l * 1024 * 16 + i]; }
    __syncthreads();
    const bf16* O16 = (const bf16*)(X.ws + WS_GM); float* X1 = (float*)(X.ws + WS_X1); unsigned char* H2 = X.ws + WS_SA; float* AFF = (float*)(X.ws + WS_AFF);
    const float* lg = uni(inp(a, I_LN1G) + l * D); const float* lb = uni(inp(a, I_LN1B) + l * D);
    f32x4 xn[2][4]; v2u on[2][4];
#define LN1_FETCH(rr_) do { unsigned lp_ = 4u * (unsigned)X.lane; asm volatile("" : "+v"(lp_)); \
        const float* p0_ = uni(xrow_ptr(a, X.ws, l, (rr_))); const float* p1_ = uni(xrow_ptr(a, X.ws, l, (rr_) + 1)); const bf16* po_ = uni(O16 + (size_t)(rr_) * D); \
        _Pragma("unroll") for (int j = 0; j < 4; ++j) { xn[0][j] = *(const f32x4*)(p0_ + (lp_ + 256u * j)); xn[1][j] = *(const f32x4*)(p1_ + (lp_ + 256u * j)); } \
        _Pragma("unroll") for (int j = 0; j < 4; ++j) { on[0][j] = *(const v2u*)(po_ + (lp_ + 256u * j)); on[1][j] = *(const v2u*)(po_ + (lp_ + 1024u + 256u * j)); } } while (0)
    if (gw * 2 < nrows) LN1_FETCH(gw * 2);
    for (int r0 = gw * 2; r0 < nrows; r0 += NGW * 2) {
        const float* md = uni(mod_ptr(X.ws, l, r0));
        unsigned l4 = 4u * (unsigned)X.lane; asm volatile("" : "+v"(l4));
        float* x1p = uni(X1 + (size_t)r0 * D); unsigned char* h2p = uni(H2 + (size_t)r0 * D);
        f32x4 v[2][4]; float s[2] = {0.f, 0.f};
#pragma unroll
        for (int j = 0; j < 4; ++j) { v[0][j] = xn[0][j]; v[1][j] = xn[1][j]; }
#pragma unroll
        for (int j = 0; j < 4; ++j) { const f32x4 g1 = *(const f32x4*)(md + (l4 + 2048u + 256u * j));
#pragma unroll
            for (int q = 0; q < 2; ++q) { const v2u ow = on[q][j]; const f32x4 of = {bf_lo(ow.x), bf_hi(ow.x), bf_lo(ow.y), bf_hi(ow.y)};
                v[q][j] = v[q][j] * DN_ALPHA + g1 * of;
                s[q] += (v[q][j][0] + v[q][j][1]) + (v[q][j][2] + v[q][j][3]); } }
        float mean[2], rstd[2];
#pragma unroll
        for (int q = 0; q < 2; ++q) mean[q] = wave_sum(s[q]) * (1.0f / D);
#pragma unroll
        for (int q = 0; q < 2; ++q) { float qq = 0.f;
#pragma unroll
            for (int j = 0; j < 4; ++j) { v[q][j] = v[q][j] - mean[q]; qq += (v[q][j][0] * v[q][j][0] + v[q][j][1] * v[q][j][1]) + (v[q][j][2] * v[q][j][2] + v[q][j][3] * v[q][j][3]); }
            s[q] = qq; }
#pragma unroll
        for (int q = 0; q < 2; ++q) rstd[q] = 1.0f / sqrtf(wave_sum(s[q]) * (1.0f / D) + LN_EPS);
#pragma unroll
        for (int j = 0; j < 4; ++j) { const unsigned c = l4 + 256u * j;
            const f32x4 g4 = *(const f32x4*)(lg + c), b4 = *(const f32x4*)(lb + c), sc4 = *(const f32x4*)(md + (c + 4096u)) + 1.0f, sh4 = *(const f32x4*)(md + (c + 3072u));
#pragma unroll
            for (int q = 0; q < 2; ++q) { const f32x4 y = v[q][j] * rstd[q] * g4 + b4;
                *(f32x4*)(x1p + (c + 1024u * q)) = y;
                const f32x4 h = y * sc4 + sh4; v[q][j] = h;
                *(unsigned*)(h2p + (c + 1024u * q)) = pg8::pk_fp8x4(h[0], h[1], h[2], h[3]); } }
        __builtin_amdgcn_sched_barrier(0);
        if (r0 + NGW * 2 < nrows) LN1_FETCH(r0 + NGW * 2);
        __builtin_amdgcn_sched_barrier(0);
        float lgt[2][16];
#pragma unroll
        for (int q = 0; q < 2; ++q) {
            unsigned cq = l4; asm volatile("" : "+v"(cq));
#pragma unroll
            for (int e = 0; e < 16; ++e) lgt[q][e] = 0.f;
#pragma unroll
            for (int j = 0; j < 4; ++j)
#pragma unroll
                for (int e = 0; e < 16; ++e) { const f32x4 wr = *(const LAS f32x4*)(WR + e * 1024 + cq + 256u * j);
                    lgt[q][e] += (v[q][j][0] * wr[0] + v[q][j][1] * wr[1]) + (v[q][j][2] * wr[2] + v[q][j][3] * wr[3]);
                    asm volatile("" : "+v"(lgt[q][e]));
                    if ((e & 7) == 7) __builtin_amdgcn_sched_barrier(0); }
        }
#pragma unroll
        for (int q = 0; q < 2; ++q) {
            float k8[8], k4[4], k2[2], k1;
            { const bool hi = (X.lane & 32) != 0;
#pragma unroll
              for (int e = 0; e < 8; ++e) { const float send = hi ? lgt[q][e] : lgt[q][e + 8], keep = hi ? lgt[q][e + 8] : lgt[q][e]; k8[e] = keep + __shfl_xor(send, 32); } }
            { const bool hi = (X.lane & 16) != 0;
#pragma unroll
              for (int e = 0; e < 4; ++e) { const float send = hi ? k8[e] : k8[e + 4], keep = hi ? k8[e + 4] : k8[e]; k4[e] = keep + __shfl_xor(send, 16); } }
            { const bool hi = (X.lane & 8) != 0;
#pragma unroll
              for (int e = 0; e < 2; ++e) { const float send = hi ? k4[e] : k4[e + 2], keep = hi ? k4[e + 2] : k4[e]; k2[e] = keep + __shfl_xor(send, 8); } }
            { const bool hi = (X.lane & 4) != 0; const float send = hi ? k2[0] : k2[1], keep = hi ? k2[1] : k2[0]; k1 = keep + __shfl_xor(send, 4); }
            k1 += __shfl_xor(k1, 2); k1 += __shfl_xor(k1, 1);
            float mx = k1;
            mx = fmaxf(mx, __shfl_xor(mx, 32)); mx = fmaxf(mx, __shfl_xor(mx, 16)); mx = fmaxf(mx, __shfl_xor(mx, 8)); mx = fmaxf(mx, __shfl_xor(mx, 4));
            const float ex = expf(k1 - mx); float den = ex;
            den += __shfl_xor(den, 32); den += __shfl_xor(den, 16); den += __shfl_xor(den, 8); den += __shfl_xor(den, 4);
            const int eidx = ((X.lane >> 5) & 1) * 8 + ((X.lane >> 4) & 1) * 4 + ((X.lane >> 3) & 1) * 2 + ((X.lane >> 2) & 1);
            if ((X.lane & 3) == 0) AFF[(size_t)(r0 + q) * 16 + eidx] = ex / den;
        }
    }
#undef LN1_FETCH
    __syncthreads();
}

__device__ __forceinline__ void ph_topk_convert(const Ctx& X, CArgs a, int l, bool need_ctx) {
    LAS unsigned* HIST = (LAS unsigned*)X.lds;
    LAS unsigned* SH = HIST + 256;
    const float* AFF = (const float*)(X.ws + WS_AFF); int* SLOT = (int*)(X.ws + WS_SLOT); int* SRC = (int*)(X.ws + WS_SRC);
    const int nitems = need_ctx ? 128 : 64;
    for (int it = blockIdx.x; it < nitems; it += X.G) {
        const bool isc = it >= 64; const int q = it & 63, b = q >> 4, e = q & 15;
        const int n = isc ? CTX : SEQ, cap = isc ? CAPC : CAP, rbase = isc ? T + b * CTX : b * SEQ;
        unsigned key[16];
#pragma unroll
        for (int i = 0; i < 16; ++i) { const int t = i * 512 + X.tid; key[i] = t < n ? __float_as_uint(AFF[(size_t)(rbase + t) * 16 + e]) : 0u; }
        unsigned prefix = 0u, need = (unsigned)cap;
        for (int pass = 0; pass < 4; ++pass) {
            const int shift = 24 - 8 * pass;
            if (X.tid < 256) HIST[X.tid] = 0u;
            __syncthreads();
            if (pass == 0) {
#pragma unroll
                for (int i = 0; i < 16; ++i) { bool act = (i * 512 + X.tid) < n; const unsigned bin = key[i] >> 24;
#pragma unroll
                    for (int rep = 0; rep < 4; ++rep) { const unsigned long long am = __ballot(act);
                        if (am != 0ull) { const int leader = __builtin_ctzll(am); const unsigned vv = (unsigned)__builtin_amdgcn_readlane((int)bin, leader); const unsigned long long mm = __ballot(act && bin == vv);
                            if (X.lane == leader) __hip_atomic_fetch_add(&HIST[vv], (unsigned)__popcll(mm), __ATOMIC_RELAXED, __HIP_MEMORY_SCOPE_WORKGROUP);
                            act = act && bin != vv; } }
                    if (act) __hip_atomic_fetch_add(&HIST[bin], 1u, __ATOMIC_RELAXED, __HIP_MEMORY_SCOPE_WORKGROUP); }
            } else {
#pragma unroll
            for (int i = 0; i < 16; ++i) { const bool ok = ((key[i] >> (shift + 8)) == (prefix >> (shift + 8)));
                if (ok && (i * 512 + X.tid) < n) __hip_atomic_fetch_add(&HIST[(key[i] >> shift) & 255u], 1u, __ATOMIC_RELAXED, __HIP_MEMORY_SCOPE_WORKGROUP); }
            }
            __syncthreads();
            if (X.wave == 0) {
                const unsigned c0 = HIST[4 * X.lane], c1 = HIST[4 * X.lane + 1], c2 = HIST[4 * X.lane + 2], c3 = HIST[4 * X.lane + 3];
                const unsigned s = c0 + c1 + c2 + c3; unsigned suf = s;
#pragma unroll
                for (int off = 1; off < 64; off <<= 1) { const unsigned o = __shfl_down(suf, off); if (X.lane + off < 64) suf += o; }
                const unsigned above = suf - s;
                if (above < need && need <= above + s) {
                    unsigned cum = above; int bin;
                    if (need <= cum + c3) bin = 3; else { cum += c3; if (need <= cum + c2) bin = 2; else { cum += c2; if (need <= cum + c1) bin = 1; else { cum += c1; bin = 0; } } }
                    SH[0] = prefix | ((unsigned)(4 * X.lane + bin) << shift); SH[1] = need - cum;
                }
            }
            __syncthreads();
            prefix = SH[0]; need = SH[1];
            __syncthreads();
        }
        const unsigned K = prefix;
        const int niter = isc ? 1 : 16;
        LAS unsigned* CNT = SH + 32;
#pragma unroll
        for (int i = 0; i < 16; ++i) { if (i < niter) { const int t = i * 512 + X.tid; const bool valid = t < n;
            const unsigned long long mg = __ballot(valid && key[i] > K), me = __ballot(valid && key[i] == K);
            if (X.lane == 0) CNT[i * 8 + X.wave] = (unsigned)__popcll(mg) | ((unsigned)__popcll(me) << 16); } }
        __syncthreads();
        if (X.wave == 0) { const int ne = niter * 8;
            const unsigned c0 = 2 * X.lane < ne ? CNT[2 * X.lane] : 0u, c1 = 2 * X.lane + 1 < ne ? CNT[2 * X.lane + 1] : 0u;
            const unsigned sm = c0 + c1; unsigned inc = sm;
#pragma unroll
            for (int off = 1; off < 64; off <<= 1) { const unsigned o = __shfl_up(inc, off); if (X.lane >= off) inc += o; }
            const unsigned exc = inc - sm;
            if (2 * X.lane < ne) CNT[2 * X.lane] = exc;
            if (2 * X.lane + 1 < ne) CNT[2 * X.lane + 1] = exc + c0; }
        __syncthreads();
#pragma unroll
        for (int i = 0; i < 16; ++i) { if (i < niter) { const int t = i * 512 + X.tid; const bool valid = t < n;
            const bool gt = valid && key[i] > K, eq = valid && key[i] == K;
            const unsigned long long mg = __ballot(gt), me = __ballot(eq);
            const unsigned long long lower = (1ull << X.lane) - 1ull;
            const unsigned bs = CNT[i * 8 + X.wave];
            const unsigned ngt = (bs & 0xffffu) + (unsigned)__popcll(mg & lower), neq = (bs >> 16) + (unsigned)__popcll(me & lower);
            const bool sel = gt || (eq && neq < need);
            const unsigned pos = ngt + (neq < need ? neq : need);
            if (valid) { SLOT[(size_t)(rbase + t) * 16 + e] = sel ? (int)pos : -1;
                if (sel) SRC[e * EROWS + (isc ? 4096 + b * CAPC : b * CAP) + (int)pos] = rbase + t; } } }
        __syncthreads();
    }
    if (need_ctx) { const int gt = blockIdx.x * 512 + X.tid; if (gt < NE * 128) SRC[(gt >> 7) * EROWS + 4224 + (gt & 127)] = -1; }
    LAS bf16* scr = (LAS bf16*)(X.lds + 32768 + X.wave * 8448);
    const int gw = X.vcu * NWAVES + X.wave, NGW = X.G * NWAVES;
    unsigned char* WGU = X.ws + WS_WGU; unsigned char* WD = X.ws + WS_WD;
    __syncthreads();
    for (int it = gw + CV_IN_ATT * NGW; it < CV_ITEMS; it += NGW) {
        const CvItem ci = cv_make(a, X.ws, l, it, X.lane); f32x4 v[16]; unsigned P[4][4]; cv_load(v, ci); cv_pack8(v, ci.scale, P); cv_store8(P, ci, X.lane); }
    unsigned zz = 0u; asm volatile("" : "+v"(zz)); const v4u zero4 = {zz, zz, zz, zz};
    for (int i = gw * 64 + X.lane; i < NE * 128 * 64; i += NGW * 64) {
        const int e = i >> 13, rr = (i >> 6) & 127, pc = i & 63; const int row = e * 5632 + 21 * 256 + (rr >> 6) * 128 + 64 + (rr & 63);
        *(v4u*)(WGU + (size_t)row * D + pc * 16) = zero4; }
    for (int i = gw * 64 + X.lane; i < NE * 1024 * 4; i += NGW * 64) {
        const int rowi = i >> 2, pc = i & 3; *(v4u*)(WD + (size_t)rowi * FFP + FF + pc * 16) = zero4; }
}

__device__ __forceinline__ void ph_gather(const Ctx& X, bool need_ctx) {
    const int gw = X.vcu * NWAVES + X.wave, NGW = X.G * NWAVES;
    const int* SRC = (const int*)(X.ws + WS_SRC); const unsigned char* H2 = X.ws + WS_SA; unsigned char* XG = X.ws + WS_XG;
    const int per_e = need_ctx ? EROWS : 4096;
    for (int i0 = gw * 8; i0 < NE * per_e; i0 += NGW * 8) {
        const int e = i0 / per_e, q0 = i0 - e * per_e, mr0 = e * EROWS + q0;
        int src[8]; v4u v0[8];
#pragma unroll
        for (int q = 0; q < 8; ++q) src[q] = SRC[mr0 + q];
#pragma unroll
        for (int q = 0; q < 8; ++q) { v0[q] = (v4u){0u, 0u, 0u, 0u}; if (src[q] >= 0) v0[q] = *(const v4u*)(H2 + (size_t)src[q] * D + 16 * X.lane); }
#pragma unroll
        for (int q = 0; q < 8; ++q) *(v4u*)(XG + (size_t)(mr0 + q) * D + 16 * X.lane) = v0[q];
    }
}

__device__ __forceinline__ void ph_ln2(const Ctx& X, CArgs a, int l, int nrows) {
    const int gw = X.vcu * NWAVES + X.wave, NGW = X.G * NWAVES;
    const float* X1 = (const float*)(X.ws + WS_X1); const float* AFF = (const float*)(X.ws + WS_AFF); const int* SLOT = (const int*)(X.ws + WS_SLOT);
    const bf16* EO = (const bf16*)(X.ws + WS_EO); float* X2 = (float*)(X.ws + WS_X2); bf16* XH = (bf16*)(X.ws + WS_SA);
    const float* lg = inp(a, I_LN2G) + l * D; const float* lb = inp(a, I_LN2B) + l * D;
    int slv_n = -1; float afv_n = 0.f; f32x4 xn[2][4];
#define LN2_FETCH(rr_) do { unsigned lp_ = 4u * (unsigned)X.lane; asm volatile("" : "+v"(lp_)); \
        slv_n = X.lane < 32 ? SLOT[(size_t)(rr_) * 16 + X.lane] : -1; afv_n = X.lane < 32 ? AFF[(size_t)(rr_) * 16 + X.lane] : 0.f; \
        _Pragma("unroll") for (int q = 0; q < 2; ++q) _Pragma("unroll") for (int j = 0; j < 4; ++j) xn[q][j] = *(const f32x4*)(X1 + (size_t)((rr_) + q) * D + (lp_ + 256u * j)); } while (0)
    if (gw * 2 < nrows) LN2_FETCH(gw * 2);
    for (int r0 = gw * 2; r0 < nrows; r0 += NGW * 2) {
        const float* md = mod_ptr(X.ws, l, r0);
        const bool isc = r0 >= T; const int b = isc ? (r0 - T) >> 8 : r0 >> 13;
        const int slv = slv_n; const float afv = afv_n;
        f32x4 v[2][4], mo[2][4];
#pragma unroll
        for (int q = 0; q < 2; ++q)
#pragma unroll
            for (int j = 0; j < 4; ++j) { v[q][j] = xn[q][j]; mo[q][j] = (f32x4){0.f, 0.f, 0.f, 0.f}; }
        const unsigned long long bal = __ballot(slv >= 0);
        unsigned msk[2] = {(unsigned)(bal & 0xffffull), (unsigned)((bal >> 16) & 0xffffull)};
        const size_t rb = (size_t)(isc ? 4096 + b * CAPC : b * CAP);
        while ((msk[0] | msk[1]) != 0u) {
            v2u wv[2][4][4]; float af[2][4];
#pragma unroll
            for (int q = 0; q < 2; ++q) { unsigned m = msk[q];
#pragma unroll
                for (int k = 0; k < 4; ++k) { const bool has = m != 0u; const int e = has ? __builtin_ctz(m) : 0; m = has ? (m & (m - 1u)) : 0u;
                    int sl = 0; float aq = 0.f;
                    if (has) { sl = __builtin_amdgcn_readlane(slv, q * 16 + e); aq = __builtin_bit_cast(float, __builtin_amdgcn_readlane(__builtin_bit_cast(int, afv), q * 16 + e)); }
                    af[q][k] = aq; const size_t er = (size_t)e * EROWS + rb + sl;
#pragma unroll
                    for (int j = 0; j < 4; ++j) wv[q][k][j] = *(const v2u*)(EO + er * D + 4 * X.lane + 256 * j); }
                msk[q] = m; }
#pragma unroll
            for (int q = 0; q < 2; ++q)
#pragma unroll
                for (int k = 0; k < 4; ++k)
#pragma unroll
                    for (int j = 0; j < 4; ++j) { const v2u w2 = wv[q][k][j]; const float aq = af[q][k];
                        mo[q][j][0] += aq * bf_lo(w2.x); mo[q][j][1] += aq * bf_hi(w2.x); mo[q][j][2] += aq * bf_lo(w2.y); mo[q][j][3] += aq * bf_hi(w2.y); }
        }
        __builtin_amdgcn_sched_barrier(0);
        if (r0 + NGW * 2 < nrows) LN2_FETCH(r0 + NGW * 2);
        __builtin_amdgcn_sched_barrier(0);
        float s[2] = {0.f, 0.f}, mean[2], rstd[2];
#pragma unroll
        for (int q = 0; q < 2; ++q)
#pragma unroll
            for (int j = 0; j < 4; ++j) { const int c = 4 * X.lane + 256 * j;
                v[q][j] = v[q][j] * DN_ALPHA + *(const f32x4*)(md + 5120 + c) * mo[q][j];
                s[q] += (v[q][j][0] + v[q][j][1]) + (v[q][j][2] + v[q][j][3]); }
#pragma unroll
        for (int q = 0; q < 2; ++q) mean[q] = wave_sum(s[q]) * (1.0f / D);
#pragma unroll
        for (int q = 0; q < 2; ++q) { float qq = 0.f;
#pragma unroll
            for (int j = 0; j < 4; ++j) { v[q][j] = v[q][j] - mean[q]; qq += (v[q][j][0] * v[q][j][0] + v[q][j][1] * v[q][j][1]) + (v[q][j][2] * v[q][j][2] + v[q][j][3] * v[q][j][3]); }
            s[q] = qq; }
#pragma unroll
        for (int q = 0; q < 2; ++q) rstd[q] = 1.0f / sqrtf(wave_sum(s[q]) * (1.0f / D) + LN_EPS);
        const float* md1 = (const float*)(X.ws + WS_MOD) + (size_t)(1 * 5 + (isc ? 4 : b)) * 6144;
#pragma unroll
        for (int j = 0; j < 4; ++j) { const int c = 4 * X.lane + 256 * j; const f32x4 g4 = *(const f32x4*)(lg + c), b4 = *(const f32x4*)(lb + c);
#pragma unroll
            for (int q = 0; q < 2; ++q) { const f32x4 y = v[q][j] * rstd[q] * g4 + b4;
                if (l == 0) { *(f32x4*)(X2 + (size_t)(r0 + q) * D + c) = y;
                    const f32x4 h = y * (*(const f32x4*)(md1 + 1024 + c) + 1.0f) + *(const f32x4*)(md1 + c);
                    v2u wv; wv.x = cvt_pk_bf16(h[0], h[1]); wv.y = cvt_pk_bf16(h[2], h[3]); *(v2u*)(XH + (size_t)(r0 + q) * D + c) = wv;
                    *(unsigned*)(X.ws + WS_XH8 + (size_t)(r0 + q) * D + c) = pg8::pk_fp8x4(h[0], h[1], h[2], h[3]); }
                else *(f32x4*)((float*)(GAS float*)a->out + (size_t)(r0 + q) * D + c) = y; } }
    }
#undef LN2_FETCH
}
__device__ __forceinline__ int lane_now() { int l_; asm volatile("v_mbcnt_lo_u32_b32 %0, -1, 0\n\tv_mbcnt_hi_u32_b32 %0, -1, %0" : "=v"(l_)); return l_; }
__device__ __forceinline__ void ph_attention(const Ctx& X, CArgs a, int l, unsigned char* lds_generic, bool need_ctx) {
    using attn_body::attn_unit; using attn_body::attn_unit_v128; typedef attn_body::bf16 abf;
    const abf* QA = (const abf*)(X.ws + WS_QA); const abf* KA = (const abf*)(X.ws + WS_KA); const abf* VA = (const abf*)(X.ws + WS_VA);
    const abf* QC = (const abf*)(X.ws + WS_QC); const abf* KC = (const abf*)(X.ws + WS_KC); const abf* VC = (const abf*)(X.ws + WS_VC);
    abf* YA = (abf*)(X.ws + WS_BR); abf* DO = (abf*)(X.ws + WS_DO);
    int cvk = CV_IN_LRU; const int gwc = X.vcu * NWAVES + X.wave, ngwc = X.G * NWAVES;
    bool nomax; { float gq = fabsf(inp(a, I_AQN)[l * 64 + lane_now()]), gk = fabsf(inp(a, I_AKN)[l * 64 + lane_now()]);
#pragma unroll
        for (int o = 1; o < 64; o <<= 1) { gq = fmaxf(gq, __shfl_xor(gq, o)); gk = fmaxf(gk, __shfl_xor(gk, o)); }
        const float bound = 64.0f * C2 * gq * gk * 1.02f;
        nomax = __builtin_amdgcn_readfirstlane((int)(bound < 40.0f)) != 0; }
    bool nomaxd; { const unsigned* nw = (const unsigned*)(X.ws + WS_CTL) + CW_NRM + 2 * l;
        const float mq = __uint_as_float(__hip_atomic_load(nw, __ATOMIC_RELAXED, __HIP_MEMORY_SCOPE_AGENT)), mk = __uint_as_float(__hip_atomic_load(nw + 1, __ATOMIC_RELAXED, __HIP_MEMORY_SCOPE_AGENT));
        const float boundd = C2 * sqrtf(mq * mk) * 1.02f;
        nomaxd = __builtin_amdgcn_readfirstlane((int)(boundd < 60.0f && mq > 0.0f && mk > 0.0f)) != 0; }
#define ATT_CV() do { if (cvk < CV_IN_ATT) { const bool two_ = cvk + 1 < CV_IN_ATT; \
        CvItem c0_ = cv_make(a, X.ws, l, gwc + cvk * ngwc, lane_now()); f32x4 v_[16]; unsigned pk_[4][4]; cv_load(v_, c0_); cv_pack8(v_, c0_.scale, pk_); \
        asm volatile("" ::: "memory"); __builtin_amdgcn_sched_barrier(0); \
        CvItem c1_ = c0_; if (two_) { c1_ = cv_make(a, X.ws, l, gwc + (cvk + 1) * ngwc, lane_now()); cv_load(v_, c1_); } \
        __builtin_amdgcn_sched_barrier(0); cv_store8(pk_, c0_, lane_now()); \
        if (two_) { cv_pack8(v_, c1_.scale, pk_); cv_store8(pk_, c1_, lane_now()); } cvk += 2; } } while (0)
    const int ng = nomax ? 512 : 1024, nun2 = ng + 1024 + (need_ctx ? 64 : 0);
    for (int U = X.vcu; U < nun2; U += X.G) {
        if (U < ng) {
            if (nomax) { const int qb = U & 15, h = (U >> 4) & 7, b = U >> 7; const size_t qrow = (size_t)b * SEQ + qb * 512;
                attn_body::attn_unit2(QA + qrow * 512 + h * 64, 512, KA + (size_t)b * KVL * 128 + (h >> 2) * 64, 128, VA + (size_t)b * KVL * 128 + (h >> 2) * 64, 128, YA + qrow * 512 + h * 64, 512, KVL / 64, (char*)lds_generic + RING_OFF, (X.wave << 6) | lane_now());
                ATT_CV(); }
            else { const int qb = U & 31, h = (U >> 5) & 7, b = U >> 8; const size_t qrow = (size_t)b * SEQ + qb * 256;
                attn_unit<8, false>(QA + qrow * 512 + h * 64, 512, KA + (size_t)b * KVL * 128 + (h >> 2) * 64, 128, VA + (size_t)b * KVL * 128 + (h >> 2) * 64, 128, YA + qrow * 512 + h * 64, 512, KVL / 64, (char*)lds_generic + RING_OFF, (X.wave << 6) | lane_now()); }
        } else if (U >= ng + 1024 && U < ng + 1024 + 32) { const int V = U - ng - 1024, h = V & 7, b = V >> 3; const size_t qrow = (size_t)T + b * CTX;
            if (nomax) attn_unit<8, true>(QA + qrow * 512 + h * 64, 512, KA + (size_t)b * KVL * 128 + (h >> 2) * 64, 128, VA + (size_t)b * KVL * 128 + (h >> 2) * 64, 128, YA + qrow * 512 + h * 64, 512, CTX / 64, (char*)lds_generic + RING_OFF, (X.wave << 6) | lane_now());
            else attn_unit<8, false>(QA + qrow * 512 + h * 64, 512, KA + (size_t)b * KVL * 128 + (h >> 2) * 64, 128, VA + (size_t)b * KVL * 128 + (h >> 2) * 64, 128, YA + qrow * 512 + h * 64, 512, CTX / 64, (char*)lds_generic + RING_OFF, (X.wave << 6) | lane_now());
        } else { int b, hj, NT; size_t qrow;
            if (U < ng + 1024) { const int V = U - ng, qb = V & 31; hj = (V >> 5) & 7; b = V >> 8; qrow = (size_t)b * SEQ + qb * 256; NT = KVL / 64; }
            else { const int V = U - ng - 1024 - 32; hj = V & 7; b = V >> 3; qrow = (size_t)T + b * CTX; NT = CTX / 64; }
            const int hc = hj >> 1, j = hj & 1;
            if (nomaxd) attn_unit_v128<8, true>(QC + qrow * 512 + hj * 64, 512, KC + (size_t)b * KVL * 512 + hj * 64, 512, VC + (size_t)b * KVL * 512 + hc * 128, 512, DO + (size_t)j * R * 512 + qrow * 512 + hc * 128, 512, NT, (char*)lds_generic + RING_OFF, (X.wave << 6) | lane_now());
            else attn_unit_v128<8, false>(QC + qrow * 512 + hj * 64, 512, KC + (size_t)b * KVL * 512 + hj * 64, 512, VC + (size_t)b * KVL * 512 + hc * 128, 512, DO + (size_t)j * R * 512 + qrow * 512 + hc * 128, 512, NT, (char*)lds_generic + RING_OFF, (X.wave << 6) | lane_now());
        }
        ATT_CV();
    }
    while (cvk < CV_IN_ATT) ATT_CV();
#undef ATT_CV
}

__device__ __forceinline__ bool grid_bar_fn(const XcdBarrier& bar, int tid) { XcdBarrier b2_ = bar; asm volatile("" : "+s"(b2_.x)); xcd_barrier(b2_, tid); return true; }
constexpr int PH_PER_LAYER = 12, N_PHASES = 2 + DEPTH * PH_PER_LAYER;
__global__ void __launch_bounds__(NWAVES * 64, 2) fwd_kernel(Args args) {
    extern __shared__ __attribute__((aligned(16))) unsigned char lds[];
    Ctx X;
    const int wave0 = __builtin_amdgcn_readfirstlane((int)threadIdx.x >> 6);
#define MK_TID() ({ int l_; asm volatile("v_mbcnt_lo_u32_b32 %0, -1, 0\n\tv_mbcnt_hi_u32_b32 %0, -1, %0" : "=v"(l_)); (wave0 << 6) | l_; })
    X.lds = (LAS unsigned char*)lds; X.tid = MK_TID(); X.lane = X.tid & 63; X.wave = wave0;
    X.G = gridDim.x; { const int bx = blockIdx.x; X.vcu = (X.G % 8 == 0) ? (bx % 8) * (X.G / 8) + bx / 8 : bx; }
    X.ws = args.ws;
    gu32* ctl = (gu32*)(args.ws + WS_CTL);
    volatile LAS unsigned* MISC = (volatile LAS unsigned*)(X.lds + MISC_OFF);
    for (int u = X.tid; u < (LDS_BYTES - LDSCTL_OFF) / 4; u += NWAVES * 64) ((LAS unsigned*)(X.lds + LDSCTL_OFF))[u] = 0u;
    __syncthreads();
#if MK_PER_PHASE
#define GRID_BAR() do { } while (0)
#else
    XcdBarrier bar = xcd_barrier_post((unsigned*)(ctl + CW_BAR), MISC + 8, X.tid);
#define GRID_BAR() ((void)grid_bar_fn(bar, MK_TID()))
#endif
#if MK_PER_PHASE
    const int lo = args.ph_lo, hi = args.ph_hi;
#endif
    CArgs A = (CArgs)__builtin_amdgcn_kernarg_segment_ptr(); int bx_ = (int)blockIdx.x;
#define OPQ() do { int t_ = MK_TID(); asm volatile("" : "+v"(t_)); X.tid = t_; X.lane = t_ & 63; X.wave = wave0; unsigned long long w_ = (unsigned long long)args.ws; asm volatile("" : "+s"(w_)); X.ws = (unsigned char*)(GAS unsigned char*)w_; A = (CArgs)__builtin_amdgcn_kernarg_segment_ptr(); asm volatile("" : "+s"(A)); bx_ = (int)blockIdx.x; asm volatile("" : "+s"(bx_)); } while (0)
#if MK_PER_PHASE
#define IN(k) (lo <= (k) && (k) < hi)
#else
#define IN(k) true
#endif
#ifdef MK_REP_MASK
#define REP(k) for (int rep_ = 0; rep_ <= ((MK_REP_MASK >> (k)) & 1); ++rep_) if (rep_ ? grid_bar_fn(bar, MK_TID()) : true)
#else
#define REP(k)
#endif
#define SEAM(k) do { if (IN(k) && IN((k) + 1)) GRID_BAR(); } while (0)
#define SA ((pg8::bf16_t*)(X.ws + WS_SA))

    REP(12) { if (IN(0)) { OPQ(); ph_prologue(X, A); } } SEAM(0);
    REP(13) { if (IN(1)) { OPQ(); ph_make_xh0(X, A); } } SEAM(1);

    for (int l = 0; l < DEPTH; ++l) {
        const int P = 2 + l * PH_PER_LAYER; const bool need_ctx = l < DEPTH - 1; const int nrows = need_ctx ? R : T;
        REP(0) { if (IN(P + 0)) { OPQ();
            { pg8::Gemm g{SA, (const pg8::bf16_t*)(X.ws + WS_WIN) + (size_t)l * DIN * D, R, 3328, D, nullptr};
              pg8::PlainOrder S{R / 256, 13, X.G, bx_};
              pg8::EpiInProj E{X.ws, inp(A, I_AQN) + l * 64, inp(A, I_AKN) + l * 64, (unsigned*)(X.ws + WS_CTL) + CW_NRM + 2 * l};
              pg8::gemm_phase<pg8::EpiInProj, pg8::PlainOrder, true, true>(X.lds + RING_OFF, g, S, E, X.tid); }
            OPQ();
            { pg8::Gemm g{(const pg8::bf16_t*)(X.ws + WS_XH8), (const pg8::bf16_t*)(X.ws + WS_WIN) + (size_t)l * DIN * D + (size_t)3328 * D, R, 3072, D / 2, nullptr};
              pg8::PlainOrder S{R / 256, 12, X.G, X.G - 1 - bx_};
              pg8::EpiGate8 E{X.ws + WS_GM, 1.0f / WSC_GU};
              pg8::gemm_phase<pg8::EpiGate8, pg8::PlainOrder, true, true, true>(X.lds + RING_OFF, g, S, E, X.tid); }
        } }
        SEAM(P + 0);
        REP(1) { if (IN(P + 1)) { OPQ(); ph_lru<1>(X, A, l, need_ctx); } }
#if MK_PER_PHASE
        SEAM(P + 1);
#endif
        REP(2) { if (IN(P + 2)) { OPQ(); ph_attention(X, A, l, lds, need_ctx); } } SEAM(P + 2);
        REP(3) { if (IN(P + 3)) { OPQ(); ph_lru<2>(X, A, l, need_ctx); ph_diff_combine(X, A, l, nrows); } } SEAM(P + 3);
        REP(4) { if (IN(P + 4)) { OPQ();
            pg8::Gemm g{(const pg8::bf16_t*)(X.ws + WS_BR), (const pg8::bf16_t*)(X.ws + WS_WBR) + (size_t)l * 3 * 1024 * 512, 3 * R, 3 * 1024, 512, nullptr};
            pg8::MergeOrder S{nrows / 256, X.G, bx_};
            pg8::EpiMerge E{(const unsigned char*)(X.ws + WS_GM), SA};
            pg8::gemm_phase<pg8::EpiMerge, pg8::MergeOrder, true, true>(X.lds + RING_OFF, g, S, E, X.tid);
        } }
        SEAM(P + 4);
        REP(5) { if (IN(P + 5)) { OPQ();
            pg8::Gemm g{SA, (const pg8::bf16_t*)(X.ws + WS_WOUT) + (size_t)l * D * D, R, D, D, nullptr};
            pg8::PlainOrder S{nrows / 256, 4, X.G, bx_};
            pg8::EpiBf16Out E{(pg8::bf16_t*)(X.ws + WS_GM), D, 1.0f};
            pg8::gemm_phase<pg8::EpiBf16Out, pg8::PlainOrder, true, true>(X.lds + RING_OFF, g, S, E, X.tid);
        } }
        SEAM(P + 5);
        REP(6) { if (IN(P + 6)) { OPQ(); ph_ln1_router(X, A, l, nrows); } } SEAM(P + 6);
        REP(7) { if (IN(P + 7)) { OPQ(); ph_topk_convert(X, A, l, need_ctx); } } do { if (IN(P + 7) && IN(P + 9)) GRID_BAR(); } while (0);
        REP(9) { if (IN(P + 9)) { OPQ();
            pg8::Gemm g{(const pg8::bf16_t*)(X.ws + WS_SA), (const pg8::bf16_t*)(X.ws + WS_WGU), MROWS, NE * 5632, D / 2, (const int*)(X.ws + WS_SRC)};
            pg8::MoeOrder S{need_ctx ? 17 : 16, 22, X.G, bx_};
            pg8::EpiGateUp8 E{X.ws + WS_ACT, 1.0f / WSC_GU};
            pg8::gemm_phase<pg8::EpiGateUp8, pg8::MoeOrder, true, true, true, true>(X.lds + RING_OFF, g, S, E, X.tid);
        } }
        SEAM(P + 9);
        REP(10) { if (IN(P + 10)) { OPQ();
            pg8::Gemm g{(const pg8::bf16_t*)(X.ws + WS_ACT), (const pg8::bf16_t*)(X.ws + WS_WD), MROWS, NE * 1024, FFP / 2, nullptr};
            pg8::MoeOrder S{need_ctx ? 17 : 16, 4, X.G, bx_};
            pg8::EpiBf16Out E{(pg8::bf16_t*)(X.ws + WS_EO), D, 1.0f / WSC_D};
            pg8::gemm_phase<pg8::EpiBf16Out, pg8::MoeOrder, true, true, true>(X.lds + RING_OFF, g, S, E, X.tid);
        } }
        SEAM(P + 10);
        REP(11) { if (IN(P + 11)) { OPQ(); ph_ln2(X, A, l, nrows); } }
        if (l + 1 < DEPTH) SEAM(P + 11);
    }
#undef IN
#undef MK_TID
#undef REP
#undef SA
#undef OPQ
#undef SEAM
#undef GRID_BAR
}

extern "C" void kernel_launch(void* const* d_in, const int* in_sizes, int n_in, void* d_out, int out_size, void* d_ws, size_t ws_size, hipStream_t stream) {
    static int grid = 0;
    if (grid == 0) {
        if (n_in != 28 || out_size != T * D || ws_size < WS_END) { fprintf(stderr, "kernel_launch: unexpected shapes: n_in %d out %d ws %zu (need %zu)\n", n_in, out_size, ws_size, (size_t)WS_END); grid = -1; return; }
        int dev = 0, cus = 0, per_cu = 0;
        if (hipGetDevice(&dev) != hipSuccess || hipDeviceGetAttribute(&cus, hipDeviceAttributeMultiprocessorCount, dev) != hipSuccess) { grid = -1; return; }
        if (hipFuncSetAttribute((const void*)fwd_kernel, hipFuncAttributeMaxDynamicSharedMemorySize, LDS_BYTES) != hipSuccess) { fprintf(stderr, "kernel_launch: hipFuncSetAttribute failed\n"); grid = -1; return; }
        if (hipOccupancyMaxActiveBlocksPerMultiprocessor(&per_cu, (const void*)fwd_kernel, NWAVES * 64, LDS_BYTES) != hipSuccess || per_cu < 1)
            fprintf(stderr, "kernel_launch: occupancy query reports %d workgroups per CU\n", per_cu);
        (void)hipGetLastError();
        grid = cus;
    }
    if (grid < 0) return;
    if (hipMemsetAsync((char*)d_ws + WS_CTL, 0, CTL_BYTES, stream) != hipSuccess) return;
    Args a{};
    for (int i = 0; i < 28; ++i) a.in[i] = (const float*)d_in[i];
    a.out = (float*)d_out; a.ws = (unsigned char*)d_ws;
#if MK_PER_PHASE
    for (int p = 0; p < N_PHASES; ++p) { a.ph_lo = p; a.ph_hi = p + 1; hipLaunchKernelGGL(fwd_kernel, dim3(grid), dim3(NWAVES * 64), LDS_BYTES, stream, a); }
#else
    a.ph_lo = 0; a.ph_hi = N_PHASES;
    hipLaunchKernelGGL(fwd_kernel, dim3(grid), dim3(NWAVES * 64), LDS_BYTES, stream, a);
#endif
    const hipError_t le = hipPeekAtLastError();
    if (le != hipSuccess) fprintf(stderr, "kernel_launch: launch failed: %s\n", hipGetErrorName(le));
}
```

```cpp
#include <hip/hip_runtime.h>
#include <hip/hip_bf16.h>
#include <cstdio>
#include <cstdint>
#include <cmath>

#ifndef MK_PER_PHASE
#define MK_PER_PHASE 0
#endif

constexpr int D = 1024, NB = 4, SEQ = 8192, CTX = 256, DEPTH = 2;
constexpr int T = NB * SEQ;
constexpr int TC = NB * CTX;
constexpr int R = T + TC;
constexpr int KVL = CTX + SEQ;
constexpr int DIN = 6400;
constexpr int NE = 16, FF = 2752, FFP = 2816, CAP = 1024, CAPC = 32;
constexpr int EROWS = 4352;
constexpr int MROWS = NE * EROWS;
constexpr float LN_EPS = 1e-5f, RMS_EPS = 1e-6f;
constexpr float DN_ALPHA = 1.41421356237309515f;
constexpr float WSC_GU = 32.0f, WSC_D = 128.0f;
constexpr float C2 = 0.125f * 1.4426950408889634f;

constexpr size_t al256(size_t x) { return (x + 255) & ~(size_t)255; }
constexpr size_t WS_CTL = 0, CTL_BYTES = 65536;
constexpr size_t WS_MOD  = WS_CTL + CTL_BYTES;
constexpr size_t WS_LRUW = al256(WS_MOD + (size_t)2 * 5 * 6144 * 4);
constexpr size_t WS_AGG  = al256(WS_LRUW + (size_t)2 * 2 * 2 * 8 * 4096 * 2);
constexpr size_t WS_AFF  = al256(WS_AGG + (size_t)4 * 2 * 66 * 512 * 8);
constexpr size_t WS_SLOT = al256(WS_AFF + (size_t)R * 16 * 4);
constexpr size_t WS_SRC  = al256(WS_SLOT + (size_t)R * 16 * 4);
constexpr size_t WS_WIN  = al256(WS_SRC + (size_t)MROWS * 4);
constexpr size_t WS_WBR  = al256(WS_WIN + (size_t)2 * DIN * D * 2);
constexpr size_t WS_WOUT = al256(WS_WBR + (size_t)2 * 3 * 1024 * 512 * 2);
constexpr size_t WS_WGU  = al256(WS_WOUT + (size_t)2 * D * D * 2);
constexpr size_t WS_WD   = al256(WS_WGU + (size_t)NE * 5632 * D * 2);
constexpr size_t WS_X1   = al256(WS_WD + (size_t)NE * D * FFP * 2);
constexpr size_t WS_X2   = al256(WS_X1 + (size_t)R * D * 4);
constexpr size_t WS_SA   = al256(WS_X2 + (size_t)R * D * 4);
constexpr size_t WS_OV   = al256(WS_SA + (size_t)R * D * 2);
constexpr size_t WS_QA = WS_OV;
constexpr size_t WS_KA = al256(WS_QA + (size_t)R * 512 * 2);
constexpr size_t WS_VA = al256(WS_KA + (size_t)R * 128 * 2);
constexpr size_t WS_XB = al256(WS_VA + (size_t)R * 128 * 2);
constexpr size_t WS_GB = al256(WS_XB + (size_t)R * 512 * 2);
constexpr size_t WS_QC = al256(WS_GB + (size_t)R * 512 * 2);
constexpr size_t WS_KC = al256(WS_QC + (size_t)R * 512 * 2);
constexpr size_t WS_VC = al256(WS_KC + (size_t)R * 512 * 2);
constexpr size_t WS_GM = al256(WS_VC + (size_t)R * 512 * 2);
constexpr size_t WS_BR = al256(WS_GM + (size_t)R * 3072 * 2);
constexpr size_t WS_DO = al256(WS_BR + (size_t)3 * R * 512 * 2);
constexpr size_t WS_MM32 = al256(WS_DO + (size_t)2 * R * 512 * 2);
constexpr size_t WS_MIX_END = al256(WS_MM32 + (size_t)R * D * 4);
constexpr size_t WS_XH8 = WS_MIX_END - al256((size_t)R * D);
constexpr size_t WS_XG  = WS_OV;
constexpr size_t WS_ACT = al256(WS_XG + (size_t)MROWS * D * 2);
constexpr size_t WS_EO  = al256(WS_ACT + (size_t)MROWS * FFP * 2);
constexpr size_t WS_MOE_END = al256(WS_EO + (size_t)MROWS * D * 2);
constexpr size_t WS_END = WS_MIX_END > WS_MOE_END ? WS_MIX_END : WS_MOE_END;
static_assert(WS_END <= (size_t)1442840576, "d_ws map exceeds 4 x largest tensor");
static_assert(WS_XH8 >= WS_MOE_END, "XH8 is written while the MoE outputs are read");
static_assert((size_t)R * D * 4 <= (size_t)R * 3072 * 2, "O32 fits in GM's place");

constexpr int CW_TMO = 0, CW_BAR = 1024, CW_NRM = 8192;

constexpr int RING_OFF = 0, RING_BYTES = 131072;
constexpr int LDSCTL_OFF = RING_BYTES, MISC_OFF = LDSCTL_OFF + 320;
constexpr int LDS_BYTES = 147456;
constexpr int NWAVES = 8;

#define GAS __attribute__((address_space(1)))
#define LAS __attribute__((address_space(3)))
typedef unsigned short bf16;
typedef unsigned v4u __attribute__((ext_vector_type(4)));
typedef unsigned v2u __attribute__((ext_vector_type(2)));
typedef float f32x4 __attribute__((ext_vector_type(4)));
typedef float f32x2 __attribute__((ext_vector_type(2)));
typedef short bf16x8 __attribute__((ext_vector_type(8)));
typedef GAS unsigned gu32;
#define RLX_AGENT __ATOMIC_RELAXED, __HIP_MEMORY_SCOPE_AGENT
#define LDS_WAIT() asm volatile("s_waitcnt lgkmcnt(0)" ::: "memory")
#define VM_WAIT() asm volatile("s_waitcnt vmcnt(0)" ::: "memory")
typedef float f32x2_cv __attribute__((ext_vector_type(2))); typedef __bf16 bf16x2_cv __attribute__((ext_vector_type(2)));
__device__ __forceinline__ unsigned cvt_pk_bf16(float lo, float hi) { const f32x2_cv v = {lo, hi}; const bf16x2_cv b = __builtin_convertvector(v, bf16x2_cv); return __builtin_bit_cast(unsigned, b); }
__device__ __forceinline__ float bf_lo(unsigned w) { return __uint_as_float(w << 16); }
__device__ __forceinline__ float bf_hi(unsigned w) { return __uint_as_float(w & 0xffff0000u); }
__device__ __forceinline__ float fast_exp(float x) { return __builtin_amdgcn_exp2f(x * 1.4426950408889634f); }
__device__ __forceinline__ float sigmoid_f(float x) { return __builtin_amdgcn_rcpf(1.0f + fast_exp(-x)); }
__device__ __forceinline__ float silu_f(float x) { return x * sigmoid_f(x); }
__device__ __forceinline__ float gelu_tanh_f(float x) { const float z = 0.7978845608028654f * (x + 0.044715f * x * x * x); return x * sigmoid_f(2.0f * z); }
__device__ __forceinline__ float wave_sum(float v) {
#pragma unroll
    for (int o = 1; o < 64; o <<= 1) v += __shfl_xor(v, o);
    return v;
}
template <class Tp> __device__ __forceinline__ Tp* uni(Tp* p) { const unsigned long long v = (unsigned long long)p;
    const unsigned lo = __builtin_amdgcn_readfirstlane((unsigned)v), hi = __builtin_amdgcn_readfirstlane((unsigned)(v >> 32));
    return (Tp*)(GAS Tp*)(((unsigned long long)hi << 32) | lo); }
namespace pg8 {
#define PG8_LAS __attribute__((address_space(3)))
typedef unsigned short bf16_t;
typedef short bf16x8 __attribute__((ext_vector_type(8)));
typedef float f32x4 __attribute__((ext_vector_type(4)));
typedef unsigned u32x4 __attribute__((ext_vector_type(4)));
constexpr int BM = 256, BK = 64, HALF = 128, HTB = HALF * BK * 2  , STAGE_BYTES = 8 * HTB, NXCD = 8, WGM = 8;

__host__ __device__ __forceinline__ int lds_byte(int r, int c) { const int st = (r >> 4) * 2 + (c >> 5), rr = r & 15, cc = c & 31, ob = rr * 64 + cc * 2; return st * 1024 + (ob ^ (((ob >> 9) & 1) << 5)); }
__host__ __device__ __forceinline__ void stage_rc(int b, int& R, int& C) { const int st = b / 1024, sb = b % 1024, swz = sb ^ (((sb >> 9) & 1) << 5); R = (st >> 1) * 16 + swz / 64; C = (st & 1) * 32 + (swz % 64) / 2; }
__host__ __device__ __forceinline__ int perm32(int rho) { const int n = rho >> 4, i = rho & 15; return 8 * (i >> 2) + 4 * n + (i & 3); }

struct Unit { int pm, pn, aux; };
struct Gemm { const bf16_t* A; const bf16_t* Bt; int M, N, K; const int* rowsrc; };

struct StaticOrder {
    int nM, nN, nwg, G, c;
    __host__ __device__ void init(int M, int N, int G_, int c_) { nM = M / BM; nN = N / BM; nwg = nM * nN; G = G_; c = c_; }
    __host__ __device__ bool next(int i, Unit& u) const {
        const long L = (long)i * G + c; if (L >= nwg) return false;
        int wgid = (int)L; { const int q = nwg / NXCD, r = nwg % NXCD, xcd = wgid % NXCD, off = wgid / NXCD; wgid = (xcd < r ? xcd * (q + 1) : r * (q + 1) + (xcd - r) * q) + off; }
        const int nig = WGM * nN, gid = wgid / nig, fm = gid * WGM, gsz = (nM - fm) < WGM ? (nM - fm) : WGM;
        u.pm = fm + ((wgid % nig) % gsz); u.pn = (wgid % nig) / gsz; return true;
    }
    __device__ __forceinline__ void a_ready(const Unit&) const {}
    __device__ __forceinline__ void done(const Unit&) const {}
};

typedef float f32x2 __attribute__((ext_vector_type(2)));

template <class Epi, class Sched, bool ALIGN_EPI = false, bool SP2 = false, bool F8 = false, bool GATHER = false>
__device__ __forceinline__ void gemm_phase(PG8_LAS unsigned char* lds, const Gemm g, const Sched& S, const Epi& E, const int tid_in) {
    int tid_ = tid_in; asm volatile("" : "+v"(tid_));
    const int tid = tid_, wid = __builtin_amdgcn_readfirstlane(tid >> 6), lane = tid & 63, wr = wid >> 2, wc = wid & 3, fr = lane & 15, fq = lane >> 4;
    const int K = g.K, nt = K / BK;
    unsigned voffA[2], voffB[2];
#pragma unroll
    for (int i = 0; i < 2; ++i) { int R, C; stage_rc(tid * 16 + i * 8192, R, C); const int Rb = Epi::PERM ? ((R & ~31) + perm32(R & 31)) : R;
        voffA[i] = (unsigned)(R * K + C) * 2u; voffB[i] = (unsigned)(Rb * K + C) * 2u; }
    const size_t kstep = (size_t)(BK * 2);
    static_assert(!GATHER || SP2, "GATHER is written for the SP2 loop");
    int grow[2]; { int R0, C0, R1, C1; stage_rc(tid * 16, R0, C0); stage_rc(tid * 16 + 8192, R1, C1); grow[0] = R0; grow[1] = R1; }
    unsigned gcol[2]; { gcol[0] = voffA[0] - (unsigned)(grow[0] * K) * 2u; gcol[1] = voffA[1] - (unsigned)(grow[1] * K) * 2u; }
    unsigned vC[2][2], vN[2][2];
    constexpr int GIDX_OFF = STAGE_BYTES + 1024;
    const size_t hstep = (size_t)HALF * K * 2;
    const size_t tstep = 2 * hstep;
    const unsigned ldsw = (unsigned)wid * 1024u;
    const int aoff = lds_byte(wr * 64 + fr, fq * 8), boff = lds_byte(wc * 32 + fr, fq * 8);
#define PG8_SA(b, h) (((b) * 2 + (h)) * HTB)
#define PG8_SB(b, h) ((4 + (b) * 2 + (h)) * HTB)
#define PG8_STAGE(bufoff, gbase, voff) do { _Pragma("unroll") for (int _i = 0; _i < 2; ++_i) \
        __builtin_amdgcn_global_load_lds((const unsigned*)((const char*)(gbase) + (voff)[_i]), (PG8_LAS unsigned*)(lds + (bufoff) + ldsw + _i * 8192), 16, 0, 0); } while (0)
#define PG8_LDA(dst, b, h) do { if constexpr (F8) { _Pragma("unroll") for (int m = 0; m < 4; ++m) dst##8[m] = __builtin_shufflevector(*(const PG8_LAS v4i_*)(lds + PG8_SA(b, h) + aoff + m * 2048), *(const PG8_LAS v4i_*)(lds + PG8_SA(b, h) + aoff + m * 2048 + 1024), 0, 1, 2, 3, 4, 5, 6, 7); } \
        else { _Pragma("unroll") for (int m = 0; m < 4; ++m) _Pragma("unroll") for (int k = 0; k < 2; ++k) dst[m][k] = *(const PG8_LAS bf16x8*)(lds + PG8_SA(b, h) + aoff + m * 2048 + k * 1024); } } while (0)
#define PG8_LDB(dst, b, h) do { if constexpr (F8) { _Pragma("unroll") for (int n = 0; n < 2; ++n) dst##8[n] = __builtin_shufflevector(*(const PG8_LAS v4i_*)(lds + PG8_SB(b, h) + boff + n * 2048), *(const PG8_LAS v4i_*)(lds + PG8_SB(b, h) + boff + n * 2048 + 1024), 0, 1, 2, 3, 4, 5, 6, 7); } \
        else { _Pragma("unroll") for (int n = 0; n < 2; ++n) _Pragma("unroll") for (int k = 0; k < 2; ++k) dst[n][k] = *(const PG8_LAS bf16x8*)(lds + PG8_SB(b, h) + boff + n * 2048 + k * 1024); } } while (0)
#define PG8_MMA(ai, bj, At, Bt) do { if constexpr (F8) __builtin_amdgcn_sched_barrier(0); __builtin_amdgcn_s_setprio(1); \
        if constexpr (F8) { _Pragma("unroll") for (int m = 0; m < 4; ++m) _Pragma("unroll") for (int n = 0; n < 2; ++n) \
            acc[ai][bj][m][n] = __builtin_amdgcn_mfma_scale_f32_16x16x128_f8f6f4(Bt##8[n], At##8[m], acc[ai][bj][m][n], 0, 0, 0, 0x7f7f7f7f, 0, 0x7f7f7f7f); } \
        else { _Pragma("unroll") for (int m = 0; m < 4; ++m) _Pragma("unroll") for (int n = 0; n < 2; ++n) _Pragma("unroll") for (int k = 0; k < 2; ++k) \
            acc[ai][bj][m][n] = __builtin_amdgcn_mfma_f32_16x16x32_bf16(Bt[n][k], At[m][k], acc[ai][bj][m][n], 0, 0, 0); } \
        __builtin_amdgcn_s_setprio(0); \
        if constexpr (F8) { _Pragma("unroll") for (int m = 0; m < 4; ++m) asm volatile("" : "+v"(acc[ai][bj][m][0]), "+v"(acc[ai][bj][m][1]));     \
            __builtin_amdgcn_sched_barrier(0); } } while (0)
#define PG8_WAIT_V(n) asm volatile("s_waitcnt vmcnt(" #n ")" ::: "memory")
#define PG8_WAIT_L(n) asm volatile("s_waitcnt lgkmcnt(" #n ")" ::: "memory")
#define PG8_BAR __builtin_amdgcn_s_barrier()
#define PG8_SCHED __builtin_amdgcn_sched_barrier(0)
    Unit cur, nxt; int ui = 0;
    if (!S.next(0, cur)) return;
    f32x4 acc[2][2][4][2];
#pragma unroll
    for (int a = 0; a < 2; ++a)
#pragma unroll
        for (int b = 0; b < 2; ++b)
#pragma unroll
            for (int m = 0; m < 4; ++m)
#pragma unroll
                for (int n = 0; n < 2; ++n) acc[a][b][m][n] = (f32x4){0.f, 0.f, 0.f, 0.f};
    typedef int v4i_ __attribute__((ext_vector_type(4))); typedef int v8i_ __attribute__((ext_vector_type(8)));
    bf16x8 At[4][2], B0[2][2], B1[2][2]; v8i_ At8[4], B08[2], B18[2];
    const char* cA = (const char*)g.A + (GATHER ? (size_t)0 : (size_t)cur.pm * tstep); const char* cB = (const char*)g.Bt + (size_t)cur.pn * tstep;
    if constexpr (GATHER) {
#pragma unroll
        for (int h = 0; h < 2; ++h)
#pragma unroll
            for (int i = 0; i < 2; ++i) { int r = g.rowsrc[cur.pm * BM + h * HALF + grow[i]]; r = r < 0 ? 0 : r; vC[h][i] = (unsigned)r * (unsigned)(K * 2) + gcol[i]; vN[h][i] = vC[h][i]; }
    }
#define PG8_STAGEA(bufoff, gbase, h, vsel) do { if constexpr (GATHER) { PG8_STAGE(bufoff, gbase, vsel[h]); } else { PG8_STAGE(bufoff, (gbase) + (h) * hstep, voffA); } } while (0)
    S.a_ready(cur);
    if constexpr (SP2) {
        PG8_STAGE(PG8_SB(0, 0), cB, voffB); PG8_STAGE(PG8_SB(0, 1), cB + hstep, voffB); PG8_STAGEA(PG8_SA(0, 0), cA, 0, vC); PG8_STAGEA(PG8_SA(0, 1), cA, 1, vC);
        if (wr == 1) PG8_BAR;
        PG8_WAIT_V(2); PG8_BAR;
        PG8_STAGE(PG8_SB(1, 0), cB + kstep, voffB); PG8_STAGEA(PG8_SA(1, 0), cA + kstep, 0, vC); PG8_STAGE(PG8_SB(1, 1), cB + hstep + kstep, voffB);
        PG8_WAIT_V(6); PG8_BAR;
    } else {
        PG8_STAGE(PG8_SB(0, 0), cB, voffB); PG8_STAGE(PG8_SA(0, 0), cA, voffA); PG8_STAGE(PG8_SB(0, 1), cB + hstep, voffB); PG8_STAGE(PG8_SA(0, 1), cA + hstep, voffA);
        if (wr == 1) PG8_BAR;
        PG8_WAIT_V(4); PG8_BAR;
        PG8_STAGE(PG8_SB(1, 0), cB + kstep, voffB); PG8_STAGE(PG8_SA(1, 0), cA + kstep, voffA); PG8_STAGE(PG8_SB(1, 1), cB + hstep + kstep, voffB);
        PG8_WAIT_V(6); PG8_BAR;
    }
    for (;;) {
        const bool has_next = S.next(ui + 1, nxt);
        const char* nA = (has_next && !GATHER) ? (const char*)g.A + (size_t)nxt.pm * tstep : cA; const char* nB = has_next ? (const char*)g.Bt + (size_t)nxt.pn * tstep : cB;
        if constexpr (GATHER) { if (has_next) {
#pragma unroll
            for (int h = 0; h < 2; ++h)
#pragma unroll
                for (int i = 0; i < 2; ++i) __builtin_amdgcn_global_load_lds((const unsigned*)(g.rowsrc + (nxt.pm * BM + h * HALF + grow[i])), (PG8_LAS unsigned*)(lds + GIDX_OFF + ((h * 2 + i) * 8 + wid) * 256), 4, 0, 0); } }
        for (int t = 0; t < nt; t += 2) {
            const bool last = (t == nt - 2);
            const char* a1 = cA + (size_t)(t + 1) * kstep;
            const char* a2 = last ? nA : cA + (size_t)(t + 2) * kstep; const char* b2 = last ? nB : cB + (size_t)(t + 2) * kstep;
            const char* a3 = a2 + kstep; const char* b3 = b2 + kstep;
            if (last && has_next) S.a_ready(nxt);
            unsigned vS[2][2];
            if constexpr (GATHER) {
                if (last && has_next) {
                    asm volatile("s_waitcnt vmcnt(8)" ::: "memory");
#pragma unroll
                    for (int h = 0; h < 2; ++h)
#pragma unroll
                        for (int i = 0; i < 2; ++i) { int r = *(const volatile PG8_LAS int*)(lds + GIDX_OFF + ((h * 2 + i) * 8 + wid) * 256 + lane * 4); r = r < 0 ? 0 : r; vN[h][i] = (unsigned)r * (unsigned)(K * 2) + gcol[i]; }
                }
#pragma unroll
                for (int h = 0; h < 2; ++h)
#pragma unroll
                    for (int i = 0; i < 2; ++i) vS[h][i] = (last && has_next) ? vN[h][i] : vC[h][i];
            }
            if constexpr (SP2) {
            PG8_LDB(B0, 0, 0); PG8_LDB(B1, 0, 1); PG8_SCHED; PG8_LDA(At, 0, 0); PG8_STAGEA(PG8_SA(1, 1), a1, 1, vC);
            PG8_WAIT_V(8); PG8_WAIT_L(0); PG8_BAR; PG8_MMA(0, 0, At, B0); PG8_MMA(0, 1, At, B1); PG8_BAR; PG8_SCHED;
            PG8_LDA(At, 0, 1); PG8_STAGE(PG8_SB(0, 0), b2, voffB); PG8_STAGE(PG8_SB(0, 1), b2 + hstep, voffB); PG8_STAGEA(PG8_SA(0, 0), a2, 0, vS);
            PG8_WAIT_V(8); PG8_WAIT_L(0); PG8_BAR; PG8_MMA(1, 0, At, B0); PG8_MMA(1, 1, At, B1); PG8_BAR; PG8_SCHED;
            PG8_LDB(B0, 1, 0); PG8_LDB(B1, 1, 1); PG8_SCHED; PG8_LDA(At, 1, 0); PG8_STAGEA(PG8_SA(0, 1), a2, 1, vS);
            PG8_WAIT_V(8); PG8_WAIT_L(0); PG8_BAR; PG8_MMA(0, 0, At, B0); PG8_MMA(0, 1, At, B1); PG8_BAR; PG8_SCHED;
            PG8_LDA(At, 1, 1); PG8_STAGE(PG8_SB(1, 0), b3, voffB); PG8_STAGE(PG8_SB(1, 1), b3 + hstep, voffB); PG8_STAGEA(PG8_SA(1, 0), a3, 0, vS);
            PG8_WAIT_V(8); PG8_WAIT_L(0); PG8_BAR; PG8_MMA(1, 0, At, B0); PG8_MMA(1, 1, At, B1); PG8_BAR; PG8_SCHED;
            } else {
            PG8_LDB(B0, 0, 0); PG8_SCHED; PG8_LDA(At, 0, 0); PG8_STAGE(PG8_SA(1, 1), a1 + hstep, voffA);
            PG8_WAIT_L(8); PG8_BAR; PG8_WAIT_L(0); PG8_MMA(0, 0, At, B0); PG8_BAR; PG8_SCHED;
            PG8_LDB(B1, 0, 1); PG8_STAGE(PG8_SB(0, 0), b2, voffB);
            PG8_BAR; PG8_WAIT_L(0); PG8_MMA(0, 1, At, B1); PG8_BAR;
            PG8_LDA(At, 0, 1); PG8_STAGE(PG8_SA(0, 0), a2, voffA);
            PG8_BAR; PG8_WAIT_L(0); PG8_MMA(1, 0, At, B0); PG8_BAR; PG8_SCHED;
            PG8_STAGE(PG8_SB(0, 1), b2 + hstep, voffB);
            PG8_WAIT_V(6); PG8_BAR; PG8_MMA(1, 1, At, B1); PG8_BAR;
            PG8_LDB(B0, 1, 0); PG8_SCHED; PG8_LDA(At, 1, 0); PG8_STAGE(PG8_SA(0, 1), a2 + hstep, voffA);
            PG8_WAIT_L(8); PG8_BAR; PG8_WAIT_L(0); PG8_MMA(0, 0, At, B0); PG8_BAR; PG8_SCHED;
            PG8_LDB(B1, 1, 1); PG8_STAGE(PG8_SB(1, 0), b3, voffB);
            PG8_BAR; PG8_WAIT_L(0); PG8_MMA(0, 1, At, B1); PG8_BAR;
            PG8_LDA(At, 1, 1); PG8_STAGE(PG8_SA(1, 0), a3, voffA);
            PG8_BAR; PG8_WAIT_L(0); PG8_MMA(1, 0, At, B0); PG8_BAR; PG8_SCHED;
            PG8_STAGE(PG8_SB(1, 1), b3 + hstep, voffB);
            PG8_WAIT_V(6); PG8_BAR; PG8_MMA(1, 1, At, B1); PG8_BAR;
            }
        }
        if constexpr (ALIGN_EPI) { if (wr == 0) PG8_BAR; }
        if constexpr (!Epi::AFTER_DRAIN) { E(acc, cur, wr, wc, fr, fq); S.done(cur); }
        if (!has_next) break;
        if constexpr (!Epi::CHAIN) {
#pragma unroll
        for (int a = 0; a < 2; ++a)
#pragma unroll
            for (int b = 0; b < 2; ++b)
#pragma unroll
                for (int m = 0; m < 4; ++m)
#pragma unroll
                    for (int n = 0; n < 2; ++n) acc[a][b][m][n] = (f32x4){0.f, 0.f, 0.f, 0.f};
        }
        cur = nxt; cA = nA; cB = nB; ++ui;
        if constexpr (GATHER) {
#pragma unroll
            for (int h = 0; h < 2; ++h)
#pragma unroll
                for (int i = 0; i < 2; ++i) vC[h][i] = vN[h][i]; }
        if constexpr (ALIGN_EPI) { if (wr == 1) PG8_BAR; }
    }
    PG8_WAIT_V(0);
    if constexpr (!ALIGN_EPI) { if (wr == 0) PG8_BAR; }
    PG8_BAR;
    if constexpr (Epi::AFTER_DRAIN) { E.fused(acc, cur, wr, wc, fr, fq, lds, wid, lane); S.done(cur); }
#undef PG8_SA
#undef PG8_SB
#undef PG8_STAGE
#undef PG8_STAGEA
#undef PG8_LDA
#undef PG8_LDB
#undef PG8_MMA
#undef PG8_WAIT_V
#undef PG8_WAIT_L
#undef PG8_BAR
#undef PG8_SCHED
}
}

namespace pg8 {
__device__ __forceinline__ void map_tile(int L, int nM, int nN, int& pm, int& pn) {
    const int nwg = nM * nN; int wgid = L;
    { const int q = nwg / NXCD, r = nwg % NXCD, xcd = wgid % NXCD, off = wgid / NXCD; wgid = (xcd < r ? xcd * (q + 1) : r * (q + 1) + (xcd - r) * q) + off; }
    const int nig = WGM * nN, gid = wgid / nig, fm = gid * WGM, gsz = (nM - fm) < WGM ? (nM - fm) : WGM;
    pm = fm + ((wgid % nig) % gsz); pn = (wgid % nig) / gsz;
}
struct PlainOrder {
    int nM, nN, G, c;
    __device__ __forceinline__ bool next(int i, Unit& u) const { const long L = (long)i * G + c; if (L >= (long)nM * nN) return false; map_tile((int)L, nM, nN, u.pm, u.pn); u.aux = u.pn; return true; }
    __device__ __forceinline__ void a_ready(const Unit&) const {}
    __device__ __forceinline__ void done(const Unit&) const {}
};
struct MergeOrder {
    int nM, G, c;
    __device__ __forceinline__ bool next(int i, Unit& u) const { const int tr = i / 3, n = i - 3 * tr; const long L = (long)tr * G + c; if (L >= (long)nM * 4) return false;
        int pm, pn; map_tile((int)L, nM, 4, pm, pn); u.pm = n * (R / 256) + pm; u.pn = n * 4 + pn; u.aux = n; return true; }
    __device__ __forceinline__ void a_ready(const Unit&) const {}
    __device__ __forceinline__ void done(const Unit&) const {}
};
struct MoeOrder {
    int PM, nN, G, c;
    __device__ __forceinline__ bool next(int i, Unit& u) const { const long L = (long)i * G + c; if (L >= (long)NE * PM * nN) return false;
        int pm, pn; map_tile((int)L, NE * PM, nN, pm, pn); const int e = pm / PM, p = pm - e * PM; u.pm = e * 17 + p; u.pn = e * nN + pn; u.aux = pn; return true; }
    __device__ __forceinline__ void a_ready(const Unit&) const {}
    __device__ __forceinline__ void done(const Unit&) const {}
};

__device__ __forceinline__ unsigned gate_q8x4(float a, float b, float c, float d) { const float sc = 255.9999f;
    return (unsigned)(a * sc) | ((unsigned)(b * sc) << 8) | ((unsigned)(c * sc) << 16) | ((unsigned)(d * sc) << 24); }
__device__ __forceinline__ float gate_c(unsigned w, int j) { return (float)((w >> (8 * j)) & 0xffu) + 0.5f; }
__device__ __forceinline__ float gate_dq(unsigned w, int j) { return (float)((w >> (8 * j)) & 0xffu) * 0.00390625f + 0.001953125f; }
struct EpiInProj {
    static constexpr bool PERM = false, AFTER_DRAIN = false, CHAIN = false;
    unsigned char* ws; const float *qn, *kn; unsigned* nrm;
    __device__ __forceinline__ void operator()(const f32x4 (&acc)[2][2][4][2], const Unit& u, int wr, int wc, int fr_, int fq_) const {
        int fr = fr_, fq = fq_; asm volatile("" : "+v"(fr), "+v"(fq));
        const int pn = u.pn;
        bf16_t* dst; int ld, colbase; bool kv = false, rope = false, gm = false; const float* gain = nullptr; float scale = 1.f; int act = 0, trk = -1; float nmx = 0.f;
        if (pn < 2)       { dst = (bf16_t*)(ws + WS_QA); ld = 512; colbase = pn * 256 + wc * 64; gain = qn; rope = true; scale = C2; }
        else if (pn == 2) { if (wc < 2) { dst = (bf16_t*)(ws + WS_KA); ld = 128; colbase = wc * 64; kv = true; gain = kn; rope = true; } else { dst = (bf16_t*)(ws + WS_VA); ld = 128; colbase = (wc - 2) * 64; kv = true; } }
        else if (pn < 5)  { dst = (bf16_t*)(ws + WS_XB); ld = 512; colbase = (pn - 3) * 256 + wc * 64; }
        else if (pn < 7)  { dst = (bf16_t*)(ws + WS_GB); ld = 512; colbase = (pn - 5) * 256 + wc * 64; act = 1; }
        else if (pn < 9)  { dst = (bf16_t*)(ws + WS_QC); ld = 512; colbase = (pn - 7) * 256 + wc * 64; rope = true; scale = C2; trk = 0; }
        else if (pn < 11) { dst = (bf16_t*)(ws + WS_KC); ld = 512; colbase = (pn - 9) * 256 + wc * 64; kv = true; rope = true; trk = 1; }
        else if (pn < 13) { dst = (bf16_t*)(ws + WS_VC); ld = 512; colbase = (pn - 11) * 256 + wc * 64; kv = true; }
        else              { dst = (bf16_t*)(ws + WS_GM); ld = 3072; colbase = (pn - 13) * 256 + wc * 32; act = 2; gm = true; }
#pragma unroll
        for (int ai = 0; ai < 2; ++ai)
#pragma unroll
            for (int m = 0; m < 4; ++m) {
                const int r = u.pm * BM + ai * HALF + wr * 64 + m * 16 + fr;
                f32x4 v[2][2];
#pragma unroll
                for (int bj = 0; bj < 2; ++bj)
#pragma unroll
                    for (int n = 0; n < 2; ++n) v[bj][n] = acc[ai][bj][m][n];
                if (gain) {
                    float ss = 0.f;
#pragma unroll
                    for (int bj = 0; bj < 2; ++bj)
#pragma unroll
                        for (int n = 0; n < 2; ++n) ss += (v[bj][n][0] * v[bj][n][0] + v[bj][n][1] * v[bj][n][1]) + (v[bj][n][2] * v[bj][n][2] + v[bj][n][3] * v[bj][n][3]);
                    ss += __shfl_xor(ss, 16); ss += __shfl_xor(ss, 32);
                    const float rinv = __builtin_amdgcn_rsqf(ss * (1.0f / 64.0f) + RMS_EPS);
#pragma unroll
                    for (int bj = 0; bj < 2; ++bj)
#pragma unroll
                        for (int n = 0; n < 2; ++n) v[bj][n] = v[bj][n] * rinv * *(const f32x4*)(gain + 32 * bj + 16 * n + 4 * fq);
                }
                if (rope && r < T) {
                    const int s = r & (SEQ - 1); const float pos[2] = {(float)(s >> 6), (float)(s & 63)};
#pragma unroll
                    for (int bj = 0; bj < 2; ++bj)
#pragma unroll
                        for (int j = 0; j < 4; ++j) {
                            const float invf = __builtin_amdgcn_exp2f(-(float)(4 * fq + j) * (13.287712379549449f / 16.0f)) * 0.15915494309189535f;
                            float rev = pos[bj] * invf; rev = rev - floorf(rev);
                            const float sn = __builtin_amdgcn_sinf(rev), cs = __builtin_amdgcn_cosf(rev);
                            const float x1 = v[bj][0][j], x2 = v[bj][1][j];
                            v[bj][0][j] = x1 * cs - x2 * sn; v[bj][1][j] = x2 * cs + x1 * sn;
                        }
                }
                if (trk >= 0) { float ss = 0.f;
#pragma unroll
                    for (int bj = 0; bj < 2; ++bj)
#pragma unroll
                        for (int n = 0; n < 2; ++n) ss += (v[bj][n][0] * v[bj][n][0] + v[bj][n][1] * v[bj][n][1]) + (v[bj][n][2] * v[bj][n][2] + v[bj][n][3] * v[bj][n][3]);
                    ss += __shfl_xor(ss, 16); ss += __shfl_xor(ss, 32); nmx = __builtin_fmaxf(nmx, ss); }
                size_t drow = (size_t)r;
                if (kv) { if (r < T) drow = (size_t)(r >> 13) * KVL + CTX + (r & (SEQ - 1)); else { const int jj = r - T; drow = (size_t)(jj >> 8) * KVL + (jj & 255); } }
                bf16_t* rowp = dst + drow * ld + colbase + 4 * fq;
                if (gm) {
                    unsigned char* gp = (unsigned char*)dst + drow * 3072 + colbase + 8 * fq;
#pragma unroll
                    for (int bj = 0; bj < 2; ++bj) { const f32x4 a0 = v[bj][0], a1 = v[bj][1];
                        v2u w; w.x = gate_q8x4(sigmoid_f(a0[0]), sigmoid_f(a0[1]), sigmoid_f(a0[2]), sigmoid_f(a0[3])); w.y = gate_q8x4(sigmoid_f(a1[0]), sigmoid_f(a1[1]), sigmoid_f(a1[2]), sigmoid_f(a1[3]));
                        *(v2u*)(gp + bj * HALF) = w; }
                } else
#pragma unroll
                for (int bj = 0; bj < 2; ++bj)
#pragma unroll
                    for (int n = 0; n < 2; ++n) {
                        f32x4 o = v[bj][n] * scale;
                        if (act == 1) { o[0] = gelu_tanh_f(o[0]); o[1] = gelu_tanh_f(o[1]); o[2] = gelu_tanh_f(o[2]); o[3] = gelu_tanh_f(o[3]); }
                        if (act == 2) { o[0] = sigmoid_f(o[0]); o[1] = sigmoid_f(o[1]); o[2] = sigmoid_f(o[2]); o[3] = sigmoid_f(o[3]); }
                        v2u w; w.x = cvt_pk_bf16(o[0], o[1]); w.y = cvt_pk_bf16(o[2], o[3]);
                        *(v2u*)(rowp + 32 * bj + 16 * n) = w;
                    }
                __builtin_amdgcn_sched_barrier(0);
            }
        if (trk >= 0) { nmx = __builtin_fmaxf(nmx, __shfl_xor(nmx, 1)); nmx = __builtin_fmaxf(nmx, __shfl_xor(nmx, 2)); nmx = __builtin_fmaxf(nmx, __shfl_xor(nmx, 4)); nmx = __builtin_fmaxf(nmx, __shfl_xor(nmx, 8));
            if (fr == 0 && fq == 0) (void)__hip_atomic_fetch_max(nrm + trk, __float_as_uint(nmx), __ATOMIC_RELAXED, __HIP_MEMORY_SCOPE_AGENT); }
    }
};

struct EpiMerge {
    static constexpr bool PERM = true, AFTER_DRAIN = false, CHAIN = true;
    const unsigned char* GMF; bf16_t* MM;
    __device__ __forceinline__ void operator()(f32x4 (&acc)[2][2][4][2], const Unit& u, int wr, int wc, int fr, int fq) const {
        const int nb = u.aux, pm = u.pm - nb * (R / 256), pn = u.pn - nb * 4;
        const unsigned char* gt = GMF + (size_t)(pm * BM + wr * 64 + fr) * 3072 + nb * 1024 + pn * BM + wc * 32 + 8 * fq;
        const int row0 = pm * BM + wr * 64 + fr, col0 = pn * BM + wc * 32 + 8 * fq;
        constexpr int PD = 6;
        v2u ga[PD], gb[PD];
#define MG_LOAD(k_, s_) do { const int ai_ = (k_) >> 3, m_ = ((k_) >> 1) & 3, bj_ = (k_) & 1; const unsigned char* q_ = gt + (size_t)(ai_ * HALF + m_ * 16) * 3072 + bj_ * HALF; \
            ga[s_] = *(const v2u*)q_; gb[s_] = nb < 2 ? *(const v2u*)(q_ + 1024) : (v2u){0u, 0u}; } while (0)
#pragma unroll
        for (int k = 0; k < PD; ++k) MG_LOAD(k, k);
#pragma unroll
        for (int k = 0; k < 16; ++k) { const int ai = k >> 3, m = (k >> 1) & 3, bj = k & 1, s = k % PD;
            const v2u gw = ga[s], hw = gb[s];
            asm volatile("" :: "v"(gw), "v"(hw));
            if (k + PD < 16) MG_LOAD(k + PD, s);
            f32x4 o0 = acc[ai][bj][m][0], o1 = acc[ai][bj][m][1];
            if (nb < 2) {
#pragma unroll
                for (int j = 0; j < 4; ++j) { o0[j] *= gate_c(gw.x, j) * __builtin_amdgcn_rcpf(gate_c(hw.x, j)); o1[j] *= gate_c(gw.y, j) * __builtin_amdgcn_rcpf(gate_c(hw.y, j)); }
                acc[ai][bj][m][0] = o0; acc[ai][bj][m][1] = o1;
            } else {
#pragma unroll
                for (int j = 0; j < 4; ++j) { o0[j] *= gate_dq(gw.x, j); o1[j] *= gate_dq(gw.y, j); }
                u32x4 w; w.x = cvt_pk_bf16(o0[0], o0[1]); w.y = cvt_pk_bf16(o0[2], o0[3]); w.z = cvt_pk_bf16(o1[0], o1[1]); w.w = cvt_pk_bf16(o1[2], o1[3]);
                *(u32x4*)(MM + (size_t)(row0 + ai * HALF + m * 16) * 1024 + col0 + bj * HALF) = w;
                acc[ai][bj][m][0] = (f32x4){0.f, 0.f, 0.f, 0.f}; acc[ai][bj][m][1] = (f32x4){0.f, 0.f, 0.f, 0.f}; }
        }
#undef MG_LOAD
    }
};

struct EpiF32 {
    static constexpr bool PERM = false, AFTER_DRAIN = false, CHAIN = false;
    float* C; int ldc;
    __device__ __forceinline__ void operator()(const f32x4 (&acc)[2][2][4][2], const Unit& u, int wr, int wc, int fr, int fq) const {
        const int row0 = u.pm * BM + wr * 64 + fr, col0 = u.pn * BM + wc * 32 + 4 * fq;
#pragma unroll
        for (int ai = 0; ai < 2; ++ai)
#pragma unroll
            for (int m = 0; m < 4; ++m) { float* rowp = C + (size_t)(row0 + ai * HALF + m * 16) * ldc + col0;
#pragma unroll
                for (int bj = 0; bj < 2; ++bj)
#pragma unroll
                    for (int n = 0; n < 2; ++n) *(f32x4*)(rowp + bj * HALF + n * 16) = acc[ai][bj][m][n]; }
    }
};

struct EpiGateUp {
    static constexpr bool PERM = true, AFTER_DRAIN = false, CHAIN = false;
    bf16_t* ACT;
    __device__ __forceinline__ void operator()(const f32x4 (&acc)[2][2][4][2], const Unit& u, int wr, int wc, int fr, int fq) const {
        const int row0 = u.pm * BM + wr * 64 + fr, col0 = u.aux * 128 + wc * 32 + 8 * fq;
#pragma unroll
        for (int ai = 0; ai < 2; ++ai)
#pragma unroll
            for (int m = 0; m < 4; ++m) { bf16_t* rowp = ACT + (size_t)(row0 + ai * HALF + m * 16) * FFP + col0;
                const f32x4 g0 = acc[ai][0][m][0], g1 = acc[ai][0][m][1], u0 = acc[ai][1][m][0], u1 = acc[ai][1][m][1];
                u32x4 w; w.x = cvt_pk_bf16(silu_f(g0[0]) * u0[0], silu_f(g0[1]) * u0[1]); w.y = cvt_pk_bf16(silu_f(g0[2]) * u0[2], silu_f(g0[3]) * u0[3]);
                w.z = cvt_pk_bf16(silu_f(g1[0]) * u1[0], silu_f(g1[1]) * u1[1]); w.w = cvt_pk_bf16(silu_f(g1[2]) * u1[2], silu_f(g1[3]) * u1[3]);
                *(u32x4*)rowp = w; }
    }
};

__device__ __forceinline__ float clamp448(float x) { return __builtin_fminf(__builtin_fmaxf(x, -448.0f), 448.0f); }
__device__ __forceinline__ unsigned pk_fp8x4(float a, float b, float c, float d) { int w = 0; w = __builtin_amdgcn_cvt_pk_fp8_f32(clamp448(a), clamp448(b), w, false); w = __builtin_amdgcn_cvt_pk_fp8_f32(clamp448(c), clamp448(d), w, true); return (unsigned)w; }
struct EpiGateUp8 {
    static constexpr bool PERM = true, AFTER_DRAIN = false, CHAIN = false;
    unsigned char* ACT; float descale;
    __device__ __forceinline__ void operator()(const f32x4 (&acc)[2][2][4][2], const Unit& u, int wr, int wc, int fr, int fq) const {
        const int row0 = u.pm * BM + wr * 64 + fr, col0 = u.aux * 128 + wc * 32 + 8 * fq;
#pragma unroll
        for (int ai = 0; ai < 2; ++ai)
#pragma unroll
            for (int m = 0; m < 4; ++m) { unsigned char* rowp = ACT + (size_t)(row0 + ai * HALF + m * 16) * FFP + col0;
                const f32x4 g0 = acc[ai][0][m][0] * descale, g1 = acc[ai][0][m][1] * descale, u0 = acc[ai][1][m][0] * descale, u1 = acc[ai][1][m][1] * descale;
                v2u w; w.x = pk_fp8x4(silu_f(g0[0]) * u0[0], silu_f(g0[1]) * u0[1], silu_f(g0[2]) * u0[2], silu_f(g0[3]) * u0[3]);
                w.y = pk_fp8x4(silu_f(g1[0]) * u1[0], silu_f(g1[1]) * u1[1], silu_f(g1[2]) * u1[2], silu_f(g1[3]) * u1[3]);
                *(v2u*)rowp = w; }
    }
};

struct EpiGate8 {
    static constexpr bool PERM = false, AFTER_DRAIN = false, CHAIN = false;
    unsigned char* GM; float descale;
    __device__ __forceinline__ void operator()(const f32x4 (&acc)[2][2][4][2], const Unit& u, int wr, int wc, int fr, int fq) const {
        const int row0 = u.pm * BM + wr * 64 + fr, col0 = u.pn * BM + wc * 32 + 8 * fq;
#pragma unroll
        for (int ai = 0; ai < 2; ++ai)
#pragma unroll
            for (int m = 0; m < 4; ++m) { unsigned char* rowp = GM + (size_t)(row0 + ai * HALF + m * 16) * 3072 + col0;
#pragma unroll
                for (int bj = 0; bj < 2; ++bj) { const f32x4 a0 = acc[ai][bj][m][0], a1 = acc[ai][bj][m][1];
                    const float ce = -1.4426950408889634f * descale, cq = 1.0f / 255.999f;
                    unsigned q0[4], q1[4];
#pragma unroll
                    for (int j = 0; j < 4; ++j) { q0[j] = (unsigned)__builtin_amdgcn_rcpf(__builtin_fmaf(__builtin_amdgcn_exp2f(a0[j] * ce), cq, cq)); q1[j] = (unsigned)__builtin_amdgcn_rcpf(__builtin_fmaf(__builtin_amdgcn_exp2f(a1[j] * ce), cq, cq)); }
                    v2u w; w.x = q0[0] | (q0[1] << 8) | (q0[2] << 16) | (q0[3] << 24); w.y = q1[0] | (q1[1] << 8) | (q1[2] << 16) | (q1[3] << 24);
                    *(v2u*)(rowp + bj * HALF) = w; }
                __builtin_amdgcn_sched_barrier(0); }
    }
};

struct EpiBf16Out {
    static constexpr bool PERM = true, AFTER_DRAIN = false, CHAIN = false;
    bf16_t* O; int ldc; float scale;
    __device__ __forceinline__ void operator()(const f32x4 (&acc)[2][2][4][2], const Unit& u, int wr, int wc, int fr, int fq) const {
        const int row0 = u.pm * BM + wr * 64 + fr, col0 = u.aux * BM + wc * 32 + 8 * fq;
#pragma unroll
        for (int ai = 0; ai < 2; ++ai)
#pragma unroll
            for (int m = 0; m < 4; ++m) { bf16_t* rowp = O + (size_t)(row0 + ai * HALF + m * 16) * ldc + col0;
#pragma unroll
                for (int bj = 0; bj < 2; ++bj) { const f32x4 v0 = acc[ai][bj][m][0] * scale, v1 = acc[ai][bj][m][1] * scale;
                    u32x4 w; w.x = cvt_pk_bf16(v0[0], v0[1]); w.y = cvt_pk_bf16(v0[2], v0[3]); w.z = cvt_pk_bf16(v1[0], v1[1]); w.w = cvt_pk_bf16(v1[2], v1[3]);
                    *(u32x4*)(rowp + bj * HALF) = w; } }
    }
};
}
namespace attn_body {
using bf16=__hip_bfloat16;
using bf16x8=__attribute__((ext_vector_type(8)))short;
using s16x4=__attribute__((ext_vector_type(4)))short;
using f32x16=__attribute__((ext_vector_type(16)))float;
using u32x4=__attribute__((ext_vector_type(4)))unsigned;
constexpr int D=64;
constexpr int NW=8,QBLK=32,QB=QBLK*NW,KVBLK=64;
constexpr int ATTN_UNIT_ROWS=QB;
__device__ __forceinline__ int crow(int r,int hi){return (r&3)+8*(r>>2)+4*hi;}
#define SBAR() __builtin_amdgcn_sched_barrier(0)
constexpr int NSLOT=3, SLOTB=8192;
constexpr int LDS_K=0, LDS_V=NSLOT*SLOTB, LDS_WS=2*NSLOT*SLOTB, LDS_OST=LDS_WS+NW*64*4, LDS_BYTES=LDS_OST+NW*4096;
__device__ __forceinline__ void glds16(const void*gsrc,unsigned lds_dst){unsigned keep;
  asm volatile("s_mov_b32 %0, m0\n\ts_mov_b32 m0, %2\n\ts_nop 0\n\tglobal_load_lds_dwordx4 %1, off\n\ts_mov_b32 m0, %0":"=&s"(keep):"v"(gsrc),"s"(lds_dst):"memory");}
__device__ __forceinline__ float max3f(float a,float b,float c){float r;asm("v_max3_f32 %0, %1, %2, %3":"=v"(r):"v"(a),"v"(b),"v"(c));return r;}
__device__ __forceinline__ float max2f(float a,float b){float r;asm("v_max_f32_e32 %0, %1, %2":"=v"(r):"v"(a),"v"(b));return r;}
__device__ __forceinline__ float fadd_s(float a,float b){float r;asm("v_add_f32_e32 %0, %1, %2":"=v"(r):"v"(a),"v"(b));return r;}
__device__ __forceinline__ float fsub_s(float a,float b){float r;asm("v_sub_f32_e32 %0, %1, %2":"=v"(r):"v"(a),"v"(b));return r;}
typedef float f32x2_t __attribute__((ext_vector_type(2))); typedef __bf16 bf16x2_t __attribute__((ext_vector_type(2)));
__device__ __forceinline__ unsigned cvtpk_s(float lo,float hi){f32x2_t v={lo,hi};bf16x2_t b=__builtin_convertvector(v,bf16x2_t);return __builtin_bit_cast(unsigned,b);}
#define WAIT_BAR(N) asm volatile("s_waitcnt vmcnt(" #N ") lgkmcnt(0)\n\ts_barrier":::"memory")

__device__ __forceinline__ void qkt(f32x16&p0,f32x16&p1,const char*Kslot,const bf16x8*qr,const f32x16&negm,int r32,int hi){
  const char*kb=Kslot+hi*1024+r32*16;
  #pragma unroll
  for(int d0=0;d0<4;++d0){
    const bf16x8 b0=*reinterpret_cast<const bf16x8*>(kb+d0*2048);
    const bf16x8 b1=*reinterpret_cast<const bf16x8*>(kb+d0*2048+512);
    if(d0==0){p0=__builtin_amdgcn_mfma_f32_32x32x16_bf16(b0,qr[0],negm,0,0,0);p1=__builtin_amdgcn_mfma_f32_32x32x16_bf16(b1,qr[0],negm,0,0,0);}
    else{p0=__builtin_amdgcn_mfma_f32_32x32x16_bf16(b0,qr[d0],p0,0,0,0);p1=__builtin_amdgcn_mfma_f32_32x32x16_bf16(b1,qr[d0],p1,0,0,0);}}
}
typedef __attribute__((address_space(3))) const char* lds_cptr;
typedef short v4i16_t __attribute__((ext_vector_type(4)));
__device__ __forceinline__ void kload8(bf16x8*kf,lds_cptr kp){
  kf[0]=*(const __attribute__((address_space(3))) bf16x8*)(kp);      kf[1]=*(const __attribute__((address_space(3))) bf16x8*)(kp+512);
  kf[2]=*(const __attribute__((address_space(3))) bf16x8*)(kp+2048); kf[3]=*(const __attribute__((address_space(3))) bf16x8*)(kp+2560);
  kf[4]=*(const __attribute__((address_space(3))) bf16x8*)(kp+4096); kf[5]=*(const __attribute__((address_space(3))) bf16x8*)(kp+4608);
  kf[6]=*(const __attribute__((address_space(3))) bf16x8*)(kp+6144); kf[7]=*(const __attribute__((address_space(3))) bf16x8*)(kp+6656);
}
__device__ __forceinline__ void kload2(bf16x8*kf,lds_cptr kp,int j){ kf[2*j]=*(const __attribute__((address_space(3))) bf16x8*)(kp+j*2048); kf[2*j+1]=*(const __attribute__((address_space(3))) bf16x8*)(kp+j*2048+512); }
__device__ __forceinline__ s16x4 vtr(lds_cptr p){ return __builtin_bit_cast(s16x4,__builtin_amdgcn_ds_read_tr16_b64_v4i16((__attribute__((address_space(3))) v4i16_t*)p)); }
__device__ __forceinline__ float rowmax(const f32x16&p0,const f32x16&p1){
  float a=max3f(p0[0],p0[1],p1[0]),b=max3f(p0[2],p0[3],p1[1]);a=max3f(a,p1[2],p1[3]);
  #pragma unroll
  for(int r=4;r<16;r+=4){a=max3f(a,p0[r],p0[r+1]);b=max3f(b,p0[r+2],p0[r+3]);a=max3f(a,p1[r],p1[r+1]);b=max3f(b,p1[r+2],p1[r+3]);}
  const float m=max2f(a,b);
  auto rr=__builtin_amdgcn_permlane32_swap(__float_as_uint(m),__float_as_uint(m),false,false);
  return max2f(__uint_as_float(rr[0]),__uint_as_float(rr[1]));
}
__device__ __forceinline__ void pv(f32x16*o,int vb,bf16x8 pa0,bf16x8 pa1,bf16x8 pa2,bf16x8 pa3){
  #pragma unroll
  for(int d0=0;d0<2;++d0){s16x4 lo[4],hi[4];
    #pragma unroll
    for(int ks=0;ks<4;++ks){
      asm volatile("ds_read_b64_tr_b16 %0,%1 offset:%c2":"=&v"(lo[ks]):"v"(vb),"i"(d0*4096+ks*1024):"memory");
      asm volatile("ds_read_b64_tr_b16 %0,%1 offset:%c2":"=&v"(hi[ks]):"v"(vb),"i"(d0*4096+ks*1024+512):"memory");}
    asm volatile("s_waitcnt lgkmcnt(0)":::"memory");SBAR();
    #define PK(k) (bf16x8){lo[k][0],lo[k][1],lo[k][2],lo[k][3],hi[k][0],hi[k][1],hi[k][2],hi[k][3]}
    o[d0]=__builtin_amdgcn_mfma_f32_32x32x16_bf16(pa0,PK(0),o[d0],0,0,0);
    o[d0]=__builtin_amdgcn_mfma_f32_32x32x16_bf16(pa1,PK(1),o[d0],0,0,0);
    o[d0]=__builtin_amdgcn_mfma_f32_32x32x16_bf16(pa2,PK(2),o[d0],0,0,0);
    o[d0]=__builtin_amdgcn_mfma_f32_32x32x16_bf16(pa3,PK(3),o[d0],0,0,0);
    #undef PK
  }
}

#ifndef ATTN_STORE16
#define ATTN_STORE16(p,v) (*(u32x4*)(p)=(v))
#endif
template<int THRL,bool NOMAX=false> __device__ __forceinline__ void attn_unit(const bf16*Qu,int qp,const bf16*__restrict__ Kh,int kp,const bf16*__restrict__ Vh,int vp,bf16*Ou,int op,int NT,char*shm,int tid_in){
  int tid_=tid_in; asm volatile("":"+v"(tid_));
  const int tid=tid_,lane=tid&63,r32=lane&31,hi=lane>>5; const int wid=__builtin_amdgcn_readfirstlane(tid>>6);
  const bf16*Qw=Qu+(long)(wid*QBLK)*qp;
  const unsigned lds0=(unsigned)(uintptr_t)shm;
  float*wsf=(float*)(shm+LDS_WS)+wid*64;
  const bf16*ksrc=Kh+(long)lane*kp+wid*8;
  const bf16*vsrc=Vh+(long)(16*(wid&3)+(lane>>2))*vp+(wid>>2)*32+(lane&3)*8;
  const unsigned kdst=lds0+LDS_K+wid*1024, vdst=lds0+LDS_V+wid*1024;
  #define DMA_K(t,slot) glds16(ksrc+(long)(t)*KVBLK*kp,(unsigned)__builtin_amdgcn_readfirstlane(kdst+(slot)))
  #define DMA_V(t,slot) glds16(vsrc+(long)(t)*KVBLK*vp,(unsigned)__builtin_amdgcn_readfirstlane(vdst+(slot)))
  const int vb0=(int)(lds0+LDS_V)+((lane>>4)&1)*32+(lane&3)*8+(4*hi+((lane&15)>>2))*64;
  const char*Kbase=shm+LDS_K; bf16x8 kf[8];
  const lds_cptr shm3=(lds_cptr)shm; const lds_cptr kp0=shm3+LDS_K+hi*1024+r32*16; const lds_cptr vp0=shm3+LDS_V+((lane>>4)&1)*32+(lane&3)*8+(4*hi+((lane&15)>>2))*64;
  DMA_K(0,0);DMA_V(0,0);DMA_K(1,SLOTB);
  bf16x8 qr[4];
  #pragma unroll
  for(int d0=0;d0<4;++d0)qr[d0]=*reinterpret_cast<const bf16x8*>(&Qw[(long)r32*qp+d0*16+hi*8]);
  float mhat=0.f,l_reg=0.f;f32x16 o[2];o[0]=f32x16{};o[1]=f32x16{};f32x16 negm=f32x16{};asm volatile("":"+v"(negm));
  #define CMASK(P0,P1,t) do{}while(0)
  bool resc=false;
  #define START(P0,P1) do{ resc=false; if constexpr(!NOMAX){ const float rm=rowmax(P0,P1); \
    { const float dl=rm; mhat=fadd_s(mhat,dl); \
      _Pragma("unroll") for(int r=0;r<16;++r){P0[r]=fsub_s(P0[r],dl);P1[r]=fsub_s(P1[r],dl);} \
      _Pragma("unroll") for(int r=0;r<16;++r)negm[r]=-mhat; asm volatile("":"+v"(negm)); } } \
    _Pragma("unroll") for(int r=0;r<16;++r)P0[r]=__builtin_amdgcn_exp2f(P0[r]); }while(0)
  #define RESC() do{ if(resc){ asm volatile("s_waitcnt lgkmcnt(0)":::"memory"); \
      _Pragma("unroll") for(int d_=0;d_<2;++d_) _Pragma("unroll") for(int r=0;r<16;++r)o[d_][r]*=wsf[crow(r,hi)]; } }while(0)
  f32x16 pA0,pA1,pB0,pB1;
  int sl_prev=0,sl_cur=0,sl_next=SLOTB;
  #define ROT() do{sl_prev=sl_cur;sl_cur=sl_next;sl_next=(sl_next==(NSLOT-1)*SLOTB)?0:sl_next+SLOTB;}while(0)
  DMA_K(2,2*SLOTB);
  WAIT_BAR(3);
  qkt(pA0,pA1,Kbase,qr,negm,r32,hi);asm volatile("s_nop 15\n\ts_nop 7":"+v"(pA0),"+v"(pA1));CMASK(pA0,pA1,0);
  START(pA0,pA1);
  _Pragma("unroll") for(int r=0;r<16;++r)pA1[r]=__builtin_amdgcn_exp2f(pA1[r]);
  WAIT_BAR(0);
  DMA_K(3,0);DMA_V(1,SLOTB);
  ROT();
  kload8(kf,kp0+sl_cur);
  WAIT_BAR(2);
  s16x4 vlo[8],vhi[8]; u32x4 pw0,pw1,pw2,pw3;
  #define PKW(P,B) cvtpk_s(P[B],P[B+1])
  #define PAF(k) __builtin_bit_cast(bf16x8,pw##k)
  #define VFR(i) (bf16x8){vlo[i][0],vlo[i][1],vlo[i][2],vlo[i][3],vhi[i][0],vhi[i][1],vhi[i][2],vhi[i][3]}
  #define PIN(x) asm volatile("":"+v"(x))
  #define MX3(a,b,c) __builtin_fmaxf(__builtin_fmaxf((a),(b)),(c))
  #define GAPA(MF,A0,A1,A2,A3,W0,W1,PW) do{ MF; sacc+=A0; sacc+=A1; sacc+=A2; sacc+=A3; PIN(sacc); W0; W1; PIN(PW); SBAR(); }while(0)
  #define EX(v) __builtin_amdgcn_exp2f(v)
  #define GAPB(MF,X,B) do{ MF; X[B]=EX(X[B]); X[B+1]=EX(X[B+1]); X[B+2]=EX(X[B+2]); X[B+3]=EX(X[B+3]); PIN(X); SBAR(); }while(0)
  #define VRD(i) do{ vlo[i]=vtr(vp_+(((i)>>2)*4096+((i)&3)*1024)); vhi[i]=vtr(vp_+(((i)>>2)*4096+((i)&3)*1024+512)); }while(0)
  #define KRD(G,j) do{ if(G){ kload2(kf,kp0+sl_next,j); SBAR(); } }while(0)
  #define STEP(C0,C1,P0,P1,t,GK,GV,GL) do{ SBAR(); \
    const lds_cptr vp_=vp0+sl_prev; \
    VRD(0); SBAR(); float sacc=(P0[0]+P0[1]); \
    GAPA(C0=__builtin_amdgcn_mfma_f32_32x32x16_bf16(kf[0],qr[0],negm,0,0,0), P0[2],P0[3],P0[4],P0[5],     pw0[0]=PKW(P0,0), pw0[1]=PKW(P0,2), pw0); \
    VRD(4); SBAR(); GAPA(C1=__builtin_amdgcn_mfma_f32_32x32x16_bf16(kf[1],qr[0],negm,0,0,0), P0[6],P0[7],P0[8],P0[9],     pw0[2]=PKW(P0,4), pw0[3]=PKW(P0,6), pw0); \
    VRD(1); SBAR(); GAPA(C0=__builtin_amdgcn_mfma_f32_32x32x16_bf16(kf[2],qr[1],C0,0,0,0),   P0[10],P0[11],P0[12],P0[13], pw1[0]=PKW(P0,8), pw1[1]=PKW(P0,10), pw1); \
    VRD(5); SBAR(); GAPA(C1=__builtin_amdgcn_mfma_f32_32x32x16_bf16(kf[3],qr[1],C1,0,0,0),   P0[14],P0[15],P1[0],P1[1],   pw1[2]=PKW(P0,12),pw1[3]=PKW(P0,14), pw1); \
    VRD(2); SBAR(); GAPA(C0=__builtin_amdgcn_mfma_f32_32x32x16_bf16(kf[4],qr[2],C0,0,0,0),   P1[2],P1[3],P1[4],P1[5],     pw2[0]=PKW(P1,0), pw2[1]=PKW(P1,2), pw2); \
    VRD(6); SBAR(); GAPA(C1=__builtin_amdgcn_mfma_f32_32x32x16_bf16(kf[5],qr[2],C1,0,0,0),   P1[6],P1[7],P1[8],P1[9],     pw2[2]=PKW(P1,4), pw2[3]=PKW(P1,6), pw2); \
    VRD(3); SBAR(); GAPA(C0=__builtin_amdgcn_mfma_f32_32x32x16_bf16(kf[6],qr[3],C0,0,0,0),   P1[10],P1[11],P1[12],P1[13], pw3[0]=PKW(P1,8), pw3[1]=PKW(P1,10), pw3); \
    VRD(7); SBAR(); GAPA(C1=__builtin_amdgcn_mfma_f32_32x32x16_bf16(kf[7],qr[3],C1,0,0,0),   P1[14],P1[15],0.f,0.f,       pw3[2]=PKW(P1,12),pw3[3]=PKW(P1,14), pw3); \
    l_reg+=sacc; \
    if(GK){DMA_K((t)+3,sl_cur);} if(GV){DMA_V((t)+1,sl_next);} \
    CMASK(C0,C1,t); \
    if constexpr(!NOMAX){ float a=MX3(C0[0],C0[1],C1[0]),b=MX3(C0[2],C0[3],C1[1]); a=MX3(a,C1[2],C1[3]); \
      _Pragma("unroll") for(int r=4;r<16;r+=4){a=MX3(a,C0[r],C0[r+1]);b=MX3(b,C0[r+2],C0[r+3]);a=MX3(a,C1[r],C1[r+1]);b=MX3(b,C1[r+2],C1[r+3]);} \
      float rm=__builtin_fmaxf(a,b); { auto rr=__builtin_amdgcn_permlane32_swap(__float_as_uint(rm),__float_as_uint(rm),false,false); rm=__builtin_fmaxf(__uint_as_float(rr[0]),__uint_as_float(rr[1])); } \
      resc=false; \
      if(__builtin_expect(__any(rm>(float)THRL),0)){ const float dl=__builtin_fmaxf(rm,0.f); mhat+=dl; \
        _Pragma("unroll") for(int r=0;r<16;++r){C0[r]-=dl;C1[r]-=dl;} \
        _Pragma("unroll") for(int r=0;r<16;++r)negm[r]=-mhat; asm volatile("":"+v"(negm)); \
        const float f=__builtin_amdgcn_exp2f(-dl); l_reg*=f; if(hi==0)wsf[r32]=f; resc=true; } } \
    SBAR(); \
    GAPB(o[0]=__builtin_amdgcn_mfma_f32_32x32x16_bf16(PAF(0),VFR(0),o[0],0,0,0), C0,0); \
    GAPB(o[1]=__builtin_amdgcn_mfma_f32_32x32x16_bf16(PAF(0),VFR(4),o[1],0,0,0), C0,4); \
    KRD(GL,0); GAPB(o[0]=__builtin_amdgcn_mfma_f32_32x32x16_bf16(PAF(1),VFR(1),o[0],0,0,0), C0,8); \
    KRD(GL,1); GAPB(o[1]=__builtin_amdgcn_mfma_f32_32x32x16_bf16(PAF(1),VFR(5),o[1],0,0,0), C0,12); \
    KRD(GL,2); GAPB(o[0]=__builtin_amdgcn_mfma_f32_32x32x16_bf16(PAF(2),VFR(2),o[0],0,0,0), C1,0); \
    KRD(GL,3); GAPB(o[1]=__builtin_amdgcn_mfma_f32_32x32x16_bf16(PAF(2),VFR(6),o[1],0,0,0), C1,4); \
    GAPB(o[0]=__builtin_amdgcn_mfma_f32_32x32x16_bf16(PAF(3),VFR(3),o[0],0,0,0), C1,8); \
    GAPB(o[1]=__builtin_amdgcn_mfma_f32_32x32x16_bf16(PAF(3),VFR(7),o[1],0,0,0), C1,12); \
    }while(0)
  int t=1;
  #undef CMASK
  #define CMASK(P0,P1,t) do{}while(0)
  for(;t+5<NT;t+=2){
    STEP(pB0,pB1,pA0,pA1,t,true,true,true);     WAIT_BAR(2); RESC(); ROT();
    STEP(pA0,pA1,pB0,pB1,t+1,true,true,true);   WAIT_BAR(2); RESC(); ROT();
  }
  #undef CMASK
  #define CMASK(P0,P1,t) do{}while(0)
  #define ENDW(tt) do{ if((tt)+3<NT){WAIT_BAR(2);} else if((tt)+2<NT){WAIT_BAR(1);} else {WAIT_BAR(0);} }while(0)
  for(;t+1<NT;t+=2){
    STEP(pB0,pB1,pA0,pA1,t,(t+3<NT),(t+1<NT),(t+1<NT));       ENDW(t);   RESC(); ROT();
    STEP(pA0,pA1,pB0,pB1,t+1,(t+4<NT),(t+2<NT),(t+2<NT));     ENDW(t+1); RESC(); ROT();
  }
  STEP(pB0,pB1,pA0,pA1,NT-1,false,false,false); RESC();
  { float sacc=pB0[0]+pB0[1]; _Pragma("unroll") for(int r=2;r<16;++r)sacc+=pB0[r]; _Pragma("unroll") for(int r=0;r<16;++r)sacc+=pB1[r]; l_reg+=sacc;
    pw0=(u32x4){PKW(pB0,0),PKW(pB0,2),PKW(pB0,4),PKW(pB0,6)};pw1=(u32x4){PKW(pB0,8),PKW(pB0,10),PKW(pB0,12),PKW(pB0,14)};pw2=(u32x4){PKW(pB1,0),PKW(pB1,2),PKW(pB1,4),PKW(pB1,6)};pw3=(u32x4){PKW(pB1,8),PKW(pB1,10),PKW(pB1,12),PKW(pB1,14)};
    SBAR(); pv(o,vb0+sl_cur,PAF(0),PAF(1),PAF(2),PAF(3)); }
  #undef PKW
  #undef PAF
  #undef VFR
  #undef PIN
  #undef MX3
  #undef GAPA
  #undef GAPB
  #undef EX
  #undef VRD
  #undef KRD
  #undef STEP
  #undef ENDW
  {auto rr=__builtin_amdgcn_permlane32_swap(__float_as_uint(l_reg),__float_as_uint(l_reg),false,false);l_reg=__uint_as_float(rr[0])+__uint_as_float(rr[1]);}
  if(hi==0)wsf[32+r32]=l_reg;asm volatile("s_waitcnt lgkmcnt(0)":::"memory");
  float rli[16];
  #pragma unroll
  for(int r=0;r<16;++r)rli[r]=__builtin_amdgcn_rcpf(wsf[32+crow(r,hi)]);
  bf16*Ow=Ou+(long)(wid*QBLK)*op;
  { bf16*stg=(bf16*)(shm+LDS_OST)+wid*2048;
    #pragma unroll
    for(int r=0;r<16;++r){const int orow=crow(r,hi);
      #pragma unroll
      for(int d0=0;d0<2;++d0)stg[orow*64+d0*32+r32]=__float2bfloat16(o[d0][r]*rli[r]);}
    asm volatile("s_waitcnt lgkmcnt(0)":::"memory");
    #pragma unroll
    for(int i=0;i<4;++i){const int row=i*8+(lane>>3),ch=lane&7; const u32x4 v=*(const u32x4*)(stg+row*64+ch*8); ATTN_STORE16(Ow+(long)row*op+ch*8,v);} }
  asm volatile("s_waitcnt lgkmcnt(0)\n\ts_barrier":::"memory");
  #undef DMA_K
  #undef DMA_V
  #undef CMASK
  #undef START
  #undef RESC
  #undef ROT
}

constexpr int U2_K=0, U2_V=4*SLOTB, U2_WS=8*SLOTB, U2_OST=U2_WS+NW*64*4;
__device__ __forceinline__ void attn_unit2(const bf16*Qu,int qp,const bf16*__restrict__ Kh,int kp,const bf16*__restrict__ Vh,int vp,bf16*Ou,int op,int NT,char*shm,int tid_in){
  int tid_=tid_in; asm volatile("":"+v"(tid_));
  const int tid=tid_,lane=tid&63,r32=lane&31,hi=lane>>5; const int wid=__builtin_amdgcn_readfirstlane(tid>>6);
  const bf16*Qw=Qu+(long)(wid*64)*qp;
  const unsigned lds0=(unsigned)(uintptr_t)shm;
  float*wsf=(float*)(shm+U2_WS)+wid*64;
  const bf16*ksrc=Kh+(long)lane*kp+wid*8;
  const bf16*vsrc=Vh+(long)(16*(wid&3)+(lane>>2))*vp+(wid>>2)*32+(lane&3)*8;
  const unsigned kdst=lds0+U2_K+wid*1024, vdst=lds0+U2_V+wid*1024;
  #define DMA_K(t,slot) glds16(ksrc+(long)(t)*KVBLK*kp,(unsigned)__builtin_amdgcn_readfirstlane(kdst+(slot)))
  #define DMA_V(t,slot) glds16(vsrc+(long)(t)*KVBLK*vp,(unsigned)__builtin_amdgcn_readfirstlane(vdst+(slot)))
  const lds_cptr shm3=(lds_cptr)shm; const lds_cptr kp0=shm3+U2_K+hi*1024+r32*16; const lds_cptr vp0=shm3+U2_V+((lane>>4)&1)*32+(lane&3)*8+(4*hi+((lane&15)>>2))*64;
  DMA_K(0,0);DMA_V(0,0);DMA_K(1,SLOTB);DMA_V(1,SLOTB);DMA_K(2,2*SLOTB);DMA_V(2,2*SLOTB);
  bf16x8 qa[4],qb[4];
  #pragma unroll
  for(int d0=0;d0<4;++d0){qa[d0]=*reinterpret_cast<const bf16x8*>(&Qw[(long)r32*qp+d0*16+hi*8]);qb[d0]=*reinterpret_cast<const bf16x8*>(&Qw[(long)(32+r32)*qp+d0*16+hi*8]);}
  float la=0.f,lb=0.f; f32x16 oa[2],ob[2]; oa[0]=f32x16{};oa[1]=f32x16{};ob[0]=f32x16{};ob[1]=f32x16{};
  asm volatile("s_waitcnt vmcnt(0) lgkmcnt(0)\n\ts_barrier":::"memory");
  int sl_cur=0,sl_n1=SLOTB,sl_n3=3*SLOTB;
  bf16x8 kf[8]; kload8(kf,kp0);
  f32x16 a0,a1,b0,b1; const f32x16 z16=f32x16{}; u32x4 pa[4],pb[4];
  #define MF(k,q,c) __builtin_amdgcn_mfma_f32_32x32x16_bf16(k,q,c,0,0,0)
  #define X4(P,B) do{ P[B]=__builtin_amdgcn_exp2f(P[B]); P[B+1]=__builtin_amdgcn_exp2f(P[B+1]); P[B+2]=__builtin_amdgcn_exp2f(P[B+2]); P[B+3]=__builtin_amdgcn_exp2f(P[B+3]); asm volatile("":"+v"(P)); SBAR(); }while(0)
  #define SP4(SUM,P,B,PW,H) do{ SUM+=P[B]; SUM+=P[B+1]; SUM+=P[B+2]; SUM+=P[B+3]; asm volatile("":"+v"(SUM)); PW[(H)*2]=cvtpk_s(P[B],P[B+1]); PW[(H)*2+1]=cvtpk_s(P[B+2],P[B+3]); asm volatile("":"+v"(PW)); SBAR(); }while(0)
  #pragma unroll
  for(int d0=0;d0<4;++d0){ a0=MF(kf[2*d0],qa[d0],d0==0?z16:a0); a1=MF(kf[2*d0+1],qa[d0],d0==0?z16:a1); }
  #pragma unroll
  for(int r=0;r<16;++r){a0[r]=__builtin_amdgcn_exp2f(a0[r]);a1[r]=__builtin_amdgcn_exp2f(a1[r]);}
  for(int t=0;t<NT;++t){
    if(t>0){ if(t+2<NT) asm volatile("s_waitcnt vmcnt(2) lgkmcnt(0)\n\ts_barrier":::"memory"); else asm volatile("s_waitcnt vmcnt(0) lgkmcnt(0)\n\ts_barrier":::"memory"); }
    if(t+3<NT){DMA_K(t+3,sl_n3);DMA_V(t+3,sl_n3);}
    const bool nx=t+1<NT; const lds_cptr vq=vp0+sl_cur; s16x4 vlo[8],vhi[8]; float sa=0.f,sb=0.f;
    #define VLD() do{ _Pragma("unroll") for(int i=0;i<8;++i){ vlo[i]=vtr(vq+((i>>2)*4096+(i&3)*1024)); vhi[i]=vtr(vq+((i>>2)*4096+(i&3)*1024+512)); } }while(0)
    #define VF(i) (bf16x8){vlo[i][0],vlo[i][1],vlo[i][2],vlo[i][3],vhi[i][0],vhi[i][1],vhi[i][2],vhi[i][3]}
    b0=MF(kf[0],qb[0],z16); SP4(sa,a0,0,pa[0],0);  b1=MF(kf[1],qb[0],z16); SP4(sa,a0,4,pa[0],1);
    b0=MF(kf[2],qb[1],b0);  SP4(sa,a0,8,pa[1],0);  b1=MF(kf[3],qb[1],b1);  SP4(sa,a0,12,pa[1],1);
    b0=MF(kf[4],qb[2],b0);  SP4(sa,a1,0,pa[2],0);  b1=MF(kf[5],qb[2],b1);  SP4(sa,a1,4,pa[2],1);
    b0=MF(kf[6],qb[3],b0);  SP4(sa,a1,8,pa[3],0);  b1=MF(kf[7],qb[3],b1);  SP4(sa,a1,12,pa[3],1);
    la+=sa;
    VLD(); if(nx) kload8(kf,kp0+sl_n1);
    #define PVA(ks,d0) oa[d0]=MF(__builtin_bit_cast(bf16x8,pa[ks]),VF((ks)+4*(d0)),oa[d0])
    #define PVB(ks,d0) ob[d0]=MF(__builtin_bit_cast(bf16x8,pb[ks]),VF((ks)+4*(d0)),ob[d0])
    PVA(0,0); X4(b0,0); PVA(0,1); X4(b0,4); PVA(1,0); X4(b0,8); PVA(1,1); X4(b0,12);
    PVA(2,0); X4(b1,0); PVA(2,1); X4(b1,4); PVA(3,0); X4(b1,8); PVA(3,1); X4(b1,12);
    if(nx){ a0=MF(kf[0],qa[0],z16); } SP4(sb,b0,0,pb[0],0);  if(nx){ a1=MF(kf[1],qa[0],z16); } SP4(sb,b0,4,pb[0],1);
    if(nx){ a0=MF(kf[2],qa[1],a0); }  SP4(sb,b0,8,pb[1],0);  if(nx){ a1=MF(kf[3],qa[1],a1); }  SP4(sb,b0,12,pb[1],1);
    if(nx){ a0=MF(kf[4],qa[2],a0); }  SP4(sb,b1,0,pb[2],0);  if(nx){ a1=MF(kf[5],qa[2],a1); }  SP4(sb,b1,4,pb[2],1);
    if(nx){ a0=MF(kf[6],qa[3],a0); }  SP4(sb,b1,8,pb[3],0);  if(nx){ a1=MF(kf[7],qa[3],a1); }  SP4(sb,b1,12,pb[3],1);
    lb+=sb;
    VLD(); SBAR();
    PVB(0,0); if(nx) X4(a0,0); PVB(0,1); if(nx) X4(a0,4); PVB(1,0); if(nx) X4(a0,8); PVB(1,1); if(nx) X4(a0,12);
    PVB(2,0); if(nx) X4(a1,0); PVB(2,1); if(nx) X4(a1,4); PVB(3,0); if(nx) X4(a1,8); PVB(3,1); if(nx) X4(a1,12);
    SBAR();
    #undef VLD
    #undef VF
    #undef PVA
    #undef PVB
    sl_cur=(sl_cur==3*SLOTB)?0:sl_cur+SLOTB; sl_n1=(sl_n1==3*SLOTB)?0:sl_n1+SLOTB; sl_n3=(sl_n3==3*SLOTB)?0:sl_n3+SLOTB;
  }
  #undef MF
  #undef X4
  #undef SP4
  bf16*stg=(bf16*)(shm+U2_OST)+wid*2048;
  #pragma unroll
  for(int blk=0;blk<2;++blk){ float l_reg=blk?lb:la; const f32x16 o0=blk?ob[0]:oa[0], o1=blk?ob[1]:oa[1];
    {auto rr=__builtin_amdgcn_permlane32_swap(__float_as_uint(l_reg),__float_as_uint(l_reg),false,false);l_reg=__uint_as_float(rr[0])+__uint_as_float(rr[1]);}
    if(hi==0)wsf[32+r32]=l_reg;asm volatile("s_waitcnt lgkmcnt(0)":::"memory");
    float rli[16];
    #pragma unroll
    for(int r=0;r<16;++r)rli[r]=__builtin_amdgcn_rcpf(wsf[32+crow(r,hi)]);
    #pragma unroll
    for(int r=0;r<16;++r){const int orow=crow(r,hi); stg[orow*64+r32]=__float2bfloat16(o0[r]*rli[r]); stg[orow*64+32+r32]=__float2bfloat16(o1[r]*rli[r]);}
    asm volatile("s_waitcnt lgkmcnt(0)":::"memory");
    bf16*Ow=Ou+(long)(wid*64+blk*32)*op;
    #pragma unroll
    for(int i=0;i<4;++i){const int row=i*8+(lane>>3),ch=lane&7; const u32x4 v=*(const u32x4*)(stg+row*64+ch*8); ATTN_STORE16(Ow+(long)row*op+ch*8,v);}
    asm volatile("s_waitcnt lgkmcnt(0)":::"memory"); }
  asm volatile("s_waitcnt lgkmcnt(0)\n\ts_barrier":::"memory");
  #undef DMA_K
  #undef DMA_V
}
constexpr int V2_LDS_K=0, V2_LDS_V=3*8192, V2_LDS_WS=V2_LDS_V+3*16384, V2_LDS_OST=V2_LDS_WS+NW*64*4, V2_LDS_BYTES=V2_LDS_OST+NW*4096;
__device__ __forceinline__ void qkt0(f32x16&p0,f32x16&p1,const char*Kslot,const bf16x8*qr,int r32,int hi){
  const char*kb=Kslot+hi*1024+r32*16; const f32x16 z=f32x16{};
  #pragma unroll
  for(int d0=0;d0<4;++d0){
    const bf16x8 b0=*reinterpret_cast<const bf16x8*>(kb+d0*2048);
    const bf16x8 b1=*reinterpret_cast<const bf16x8*>(kb+d0*2048+512);
    if(d0==0){p0=__builtin_amdgcn_mfma_f32_32x32x16_bf16(b0,qr[0],z,0,0,0);p1=__builtin_amdgcn_mfma_f32_32x32x16_bf16(b1,qr[0],z,0,0,0);}
    else{p0=__builtin_amdgcn_mfma_f32_32x32x16_bf16(b0,qr[d0],p0,0,0,0);p1=__builtin_amdgcn_mfma_f32_32x32x16_bf16(b1,qr[d0],p1,0,0,0);}}
}
__device__ __forceinline__ void pv4(f32x16*o,int vb,bf16x8 pa0,bf16x8 pa1,bf16x8 pa2,bf16x8 pa3){
  #pragma unroll
  for(int d0=0;d0<4;++d0){s16x4 lo[4],hi[4];
    #pragma unroll
    for(int ks=0;ks<4;++ks){
      asm volatile("ds_read_b64_tr_b16 %0,%1 offset:%c2":"=&v"(lo[ks]):"v"(vb),"i"(d0*4096+ks*1024):"memory");
      asm volatile("ds_read_b64_tr_b16 %0,%1 offset:%c2":"=&v"(hi[ks]):"v"(vb),"i"(d0*4096+ks*1024+512):"memory");}
    asm volatile("s_waitcnt lgkmcnt(0)":::"memory");SBAR();
    #define PK(k) (bf16x8){lo[k][0],lo[k][1],lo[k][2],lo[k][3],hi[k][0],hi[k][1],hi[k][2],hi[k][3]}
    o[d0]=__builtin_amdgcn_mfma_f32_32x32x16_bf16(pa0,PK(0),o[d0],0,0,0);
    o[d0]=__builtin_amdgcn_mfma_f32_32x32x16_bf16(pa1,PK(1),o[d0],0,0,0);
    o[d0]=__builtin_amdgcn_mfma_f32_32x32x16_bf16(pa2,PK(2),o[d0],0,0,0);
    o[d0]=__builtin_amdgcn_mfma_f32_32x32x16_bf16(pa3,PK(3),o[d0],0,0,0);
    #undef PK
  }
}
template<int THRL,bool NOMAX=false> __device__ __forceinline__ void attn_unit_v128(const bf16*Qu,int qp,const bf16*__restrict__ Kh,int kp,const bf16*__restrict__ Vh,int vp,bf16*Ou,int op,int NT,char*shm,int tid_in){
  int tid_=tid_in; asm volatile("":"+v"(tid_));
  const int tid=tid_,lane=tid&63,r32=lane&31,hi=lane>>5; const int wid=__builtin_amdgcn_readfirstlane(tid>>6);
  const bf16*Qw=Qu+(long)(wid*QBLK)*qp;
  const unsigned lds0=(unsigned)(uintptr_t)shm;
  float*wsf=(float*)(shm+V2_LDS_WS)+wid*64;
  const bf16*ksrc=Kh+(long)lane*kp+wid*8;
  const bf16*vsrc=Vh+(long)(16*(wid&3)+(lane>>2))*vp+(wid>>2)*32+(lane&3)*8;
  const unsigned kdst=lds0+V2_LDS_K+wid*1024, vdst=lds0+V2_LDS_V+wid*1024;
  #define DMA_K(t,slot) glds16(ksrc+(long)(t)*KVBLK*kp,(unsigned)__builtin_amdgcn_readfirstlane(kdst+(slot)))
  #define DMA_V(t,slot) do{ glds16(vsrc+(long)(t)*KVBLK*vp,(unsigned)__builtin_amdgcn_readfirstlane(vdst+2*(slot))); glds16(vsrc+64+(long)(t)*KVBLK*vp,(unsigned)__builtin_amdgcn_readfirstlane(vdst+2*(slot)+8192)); }while(0)
  const int vb0=(int)(lds0+V2_LDS_V)+((lane>>4)&1)*32+(lane&3)*8+(4*hi+((lane&15)>>2))*64;
  const char*Kbase=shm+V2_LDS_K; bf16x8 kf[8];
  const lds_cptr shm3=(lds_cptr)shm; const lds_cptr kp0=shm3+V2_LDS_K+hi*1024+r32*16; const lds_cptr vp0=shm3+V2_LDS_V+((lane>>4)&1)*32+(lane&3)*8+(4*hi+((lane&15)>>2))*64;
  DMA_K(0,0);DMA_V(0,0);DMA_K(1,SLOTB);
  bf16x8 qr[4];
  #pragma unroll
  for(int d0=0;d0<4;++d0)qr[d0]=*reinterpret_cast<const bf16x8*>(&Qw[(long)r32*qp+d0*16+hi*8]);
  float mhat=0.f,l_reg=0.f;f32x16 o[4];o[0]=f32x16{};o[1]=f32x16{};o[2]=f32x16{};o[3]=f32x16{};
  const f32x16 zero16=f32x16{};
  bool resc=false;
  #define START(P0,P1) do{ resc=false; if constexpr(NOMAX){ _Pragma("unroll") for(int r=0;r<16;++r){P0[r]=__builtin_amdgcn_exp2f(P0[r]);} } \
    else { const float rm=rowmax(P0,P1); mhat=rm; _Pragma("unroll") for(int r=0;r<16;++r){P0[r]=__builtin_amdgcn_exp2f(fsub_s(P0[r],mhat));} } }while(0)
  #define RESC() do{ if(resc){ asm volatile("s_waitcnt lgkmcnt(0)":::"memory"); \
      _Pragma("unroll") for(int d_=0;d_<4;++d_) _Pragma("unroll") for(int r=0;r<16;++r)o[d_][r]*=wsf[crow(r,hi)]; } }while(0)
  f32x16 pA0,pA1,pB0,pB1;
  int sl_prev=0,sl_cur=0,sl_next=SLOTB;
  #define ROT() do{sl_prev=sl_cur;sl_cur=sl_next;sl_next=(sl_next==(NSLOT-1)*SLOTB)?0:sl_next+SLOTB;}while(0)
  DMA_K(2,2*SLOTB);
  WAIT_BAR(3);
  qkt0(pA0,pA1,Kbase,qr,r32,hi);asm volatile("s_nop 15\n\ts_nop 7":"+v"(pA0),"+v"(pA1));
  START(pA0,pA1);
  if constexpr(NOMAX){ _Pragma("unroll") for(int r=0;r<16;++r)pA1[r]=__builtin_amdgcn_exp2f(pA1[r]); } else { _Pragma("unroll") for(int r=0;r<16;++r)pA1[r]=__builtin_amdgcn_exp2f(fsub_s(pA1[r],mhat)); }
  WAIT_BAR(0);
  DMA_K(3,0);DMA_V(1,SLOTB);
  ROT();
  kload8(kf,kp0+sl_cur);
  WAIT_BAR(3);
  s16x4 vwl[5],vwh[5]; u32x4 pw0,pw1,pw2,pw3;
  #define PKW(P,B) cvtpk_s(P[B],P[B+1])
  #define PAF(k) __builtin_bit_cast(bf16x8,pw##k)
  #define VWF(s) (bf16x8){vwl[s][0],vwl[s][1],vwl[s][2],vwl[s][3],vwh[s][0],vwh[s][1],vwh[s][2],vwh[s][3]}
  #define PIN(x) asm volatile("":"+v"(x))
  #define MX3(a,b,c) __builtin_fmaxf(__builtin_fmaxf((a),(b)),(c))
  #define GAPA(MF,A0,A1,A2,A3,W0,W1,PW) do{ MF; sacc+=A0; sacc+=A1; sacc+=A2; sacc+=A3; PIN(sacc); W0; W1; PIN(PW); SBAR(); }while(0)
  #define EXS(v) (NOMAX?__builtin_amdgcn_exp2f(v):__builtin_amdgcn_exp2f((v)-mhat))
  #define GAPB(MF,X,B) do{ MF; X[B]=EXS(X[B]); X[B+1]=EXS(X[B+1]); PIN(X); SBAR(); }while(0)
  #define VRD(f,s) do{ vwl[s]=vtr(vp_+(((f)>>2)*4096+((f)&3)*1024)); vwh[s]=vtr(vp_+(((f)>>2)*4096+((f)&3)*1024+512)); }while(0)
  #define KRD(G,j) do{ if(G){ kload2(kf,kp0+sl_next,j); SBAR(); } }while(0)
  #define PVM(i) o[(i)&3]=__builtin_amdgcn_mfma_f32_32x32x16_bf16(PAF_SEL((i)>>2),VWF((i)%5),o[(i)&3],0,0,0)
  #define PAF_SEL(k) ((k)==0?PAF(0):(k)==1?PAF(1):(k)==2?PAF(2):PAF(3))
  #define VNEXT(i) do{ if((i)+5<16){ VRD((((i)+5)>>2)+4*(((i)+5)&3),(i)%5); SBAR(); } }while(0)
  #define STEP(C0,C1,P0,P1,t,GK,GV,GL) do{ SBAR(); \
    const lds_cptr vp_=vp0+2*sl_prev; \
    float sacc=(P0[0]+P0[1]); \
    GAPA(C0=__builtin_amdgcn_mfma_f32_32x32x16_bf16(kf[0],qr[0],zero16,0,0,0), P0[2],P0[3],P0[4],P0[5],     pw0[0]=PKW(P0,0), pw0[1]=PKW(P0,2), pw0); \
    GAPA(C1=__builtin_amdgcn_mfma_f32_32x32x16_bf16(kf[1],qr[0],zero16,0,0,0), P0[6],P0[7],P0[8],P0[9],     pw0[2]=PKW(P0,4), pw0[3]=PKW(P0,6), pw0); \
    GAPA(C0=__builtin_amdgcn_mfma_f32_32x32x16_bf16(kf[2],qr[1],C0,0,0,0),   P0[10],P0[11],P0[12],P0[13], pw1[0]=PKW(P0,8), pw1[1]=PKW(P0,10), pw1); \
    VRD(0,0); SBAR(); GAPA(C1=__builtin_amdgcn_mfma_f32_32x32x16_bf16(kf[3],qr[1],C1,0,0,0),   P0[14],P0[15],P1[0],P1[1],   pw1[2]=PKW(P0,12),pw1[3]=PKW(P0,14), pw1); \
    VRD(4,1); SBAR(); GAPA(C0=__builtin_amdgcn_mfma_f32_32x32x16_bf16(kf[4],qr[2],C0,0,0,0),   P1[2],P1[3],P1[4],P1[5],     pw2[0]=PKW(P1,0), pw2[1]=PKW(P1,2), pw2); \
    VRD(8,2); SBAR(); GAPA(C1=__builtin_amdgcn_mfma_f32_32x32x16_bf16(kf[5],qr[2],C1,0,0,0),   P1[6],P1[7],P1[8],P1[9],     pw2[2]=PKW(P1,4), pw2[3]=PKW(P1,6), pw2); \
    VRD(12,3); SBAR(); GAPA(C0=__builtin_amdgcn_mfma_f32_32x32x16_bf16(kf[6],qr[3],C0,0,0,0),   P1[10],P1[11],P1[12],P1[13], pw3[0]=PKW(P1,8), pw3[1]=PKW(P1,10), pw3); \
    VRD(1,4); SBAR(); GAPA(C1=__builtin_amdgcn_mfma_f32_32x32x16_bf16(kf[7],qr[3],C1,0,0,0),   P1[14],P1[15],0.f,0.f,       pw3[2]=PKW(P1,12),pw3[3]=PKW(P1,14), pw3); \
    l_reg+=sacc; \
    if(GK){DMA_K((t)+3,sl_cur);} if(GV){DMA_V((t)+1,sl_next);} \
    if constexpr(!NOMAX){ float a=MX3(C0[0],C0[1],C1[0]),b=MX3(C0[2],C0[3],C1[1]); a=MX3(a,C1[2],C1[3]); \
      _Pragma("unroll") for(int r=4;r<16;r+=4){a=MX3(a,C0[r],C0[r+1]);b=MX3(b,C0[r+2],C0[r+3]);a=MX3(a,C1[r],C1[r+1]);b=MX3(b,C1[r+2],C1[r+3]);} \
      float rm=__builtin_fmaxf(a,b); { auto rr=__builtin_amdgcn_permlane32_swap(__float_as_uint(rm),__float_as_uint(rm),false,false); rm=__builtin_fmaxf(__uint_as_float(rr[0]),__uint_as_float(rr[1])); } \
      resc=false; const float rel=rm-mhat; \
      if(__builtin_expect(__any(rel>(float)THRL),0)){ const float dl=__builtin_fmaxf(rel,0.f); mhat+=dl; \
        const float f=__builtin_amdgcn_exp2f(-dl); l_reg*=f; if(hi==0)wsf[r32]=f; resc=true; } } \
    SBAR(); \
    GAPB(PVM(0),C0,0);  VNEXT(0); \
    GAPB(PVM(1),C0,2);  VNEXT(1); \
    GAPB(PVM(2),C0,4);  VNEXT(2); \
    GAPB(PVM(3),C0,6);  VNEXT(3); \
    KRD(GL,0); GAPB(PVM(4),C0,8);  VNEXT(4); \
    GAPB(PVM(5),C0,10); VNEXT(5); \
    GAPB(PVM(6),C0,12); VNEXT(6); \
    KRD(GL,1); GAPB(PVM(7),C0,14); VNEXT(7); \
    GAPB(PVM(8),C1,0);  VNEXT(8); \
    GAPB(PVM(9),C1,2);  VNEXT(9); \
    KRD(GL,2); GAPB(PVM(10),C1,4); VNEXT(10); \
    GAPB(PVM(11),C1,6); \
    GAPB(PVM(12),C1,8); \
    KRD(GL,3); GAPB(PVM(13),C1,10); \
    GAPB(PVM(14),C1,12); \
    GAPB(PVM(15),C1,14); \
    }while(0)
  int t=1;
  for(;t+5<NT;t+=2){
    STEP(pB0,pB1,pA0,pA1,t,true,true,true);     WAIT_BAR(3); RESC(); ROT();
    STEP(pA0,pA1,pB0,pB1,t+1,true,true,true);   WAIT_BAR(3); RESC(); ROT();
  }
  #define ENDW(tt) do{ if((tt)+3<NT){WAIT_BAR(3);} else if((tt)+2<NT){WAIT_BAR(2);} else {WAIT_BAR(0);} }while(0)
  for(;t+1<NT;t+=2){
    STEP(pB0,pB1,pA0,pA1,t,(t+3<NT),(t+1<NT),(t+1<NT));       ENDW(t);   RESC(); ROT();
    STEP(pA0,pA1,pB0,pB1,t+1,(t+4<NT),(t+2<NT),(t+2<NT));     ENDW(t+1); RESC(); ROT();
  }
  STEP(pB0,pB1,pA0,pA1,NT-1,false,false,false); RESC();
  { float sacc=pB0[0]+pB0[1]; _Pragma("unroll") for(int r=2;r<16;++r)sacc+=pB0[r]; _Pragma("unroll") for(int r=0;r<16;++r)sacc+=pB1[r]; l_reg+=sacc;
    pw0=(u32x4){PKW(pB0,0),PKW(pB0,2),PKW(pB0,4),PKW(pB0,6)};pw1=(u32x4){PKW(pB0,8),PKW(pB0,10),PKW(pB0,12),PKW(pB0,14)};pw2=(u32x4){PKW(pB1,0),PKW(pB1,2),PKW(pB1,4),PKW(pB1,6)};pw3=(u32x4){PKW(pB1,8),PKW(pB1,10),PKW(pB1,12),PKW(pB1,14)};
    SBAR(); pv4(o,vb0+2*sl_cur,PAF(0),PAF(1),PAF(2),PAF(3)); }
  #undef PKW
  #undef PAF
  #undef VWF
  #undef PIN
  #undef MX3
  #undef GAPA
  #undef GAPB
  #undef EXS
  #undef VRD
  #undef KRD
  #undef PVM
  #undef PAF_SEL
  #undef VNEXT
  #undef STEP
  #undef ENDW
  {auto rr=__builtin_amdgcn_permlane32_swap(__float_as_uint(l_reg),__float_as_uint(l_reg),false,false);l_reg=__uint_as_float(rr[0])+__uint_as_float(rr[1]);}
  if(hi==0)wsf[32+r32]=l_reg;asm volatile("s_waitcnt lgkmcnt(0)":::"memory");
  float rli[16];
  #pragma unroll
  for(int r=0;r<16;++r)rli[r]=__builtin_amdgcn_rcpf(wsf[32+crow(r,hi)]);
  bf16*Ow=Ou+(long)(wid*QBLK)*op;
  { bf16*stg=(bf16*)(shm+V2_LDS_OST)+wid*2048;
    #pragma unroll
    for(int rd=0;rd<2;++rd){
      #pragma unroll
      for(int r=0;r<16;++r){const int orow=crow(r,hi);
        #pragma unroll
        for(int d0=0;d0<2;++d0)stg[orow*64+d0*32+r32]=__float2bfloat16(o[2*rd+d0][r]*rli[r]);}
      asm volatile("s_waitcnt lgkmcnt(0)":::"memory");
      #pragma unroll
      for(int i=0;i<4;++i){const int row=i*8+(lane>>3),ch=lane&7; const u32x4 v=*(const u32x4*)(stg+row*64+ch*8); ATTN_STORE16(Ow+(long)row*op+rd*64+ch*8,v);}
      asm volatile("s_waitcnt lgkmcnt(0)":::"memory"); } }
  asm volatile("s_waitcnt lgkmcnt(0)\n\ts_barrier":::"memory");
  #undef DMA_K
  #undef DMA_V
  #undef START
  #undef RESC
  #undef ROT
}
#undef SBAR
#undef WAIT_BAR
}
#define XB_TMO      128
#define XB_XCNT(j)  (256  + 64 * (j))
#define XB_XSUB(j)  (1280 + 64 * (j))
#define XB_XGEN(j)  (2304 + 64 * (j))
#define XB_TOP      3328
#define XB_TOPGEN   3392
#define XCD_BAR_WORDS 3456
#define XB_SPIN_CAP (1u << 18)

__device__ __forceinline__ unsigned xb_ld(unsigned* p)              { return __hip_atomic_load(p, __ATOMIC_RELAXED, __HIP_MEMORY_SCOPE_AGENT); }
__device__ __forceinline__ unsigned xb_add(unsigned* p, unsigned v) { return __hip_atomic_fetch_add(p, v, __ATOMIC_RELAXED, __HIP_MEMORY_SCOPE_AGENT); }
__device__ __forceinline__ unsigned xb_xcc_id() { return (unsigned)__builtin_amdgcn_s_getreg((3 << 11) | 20) & 0xFu; }
#define XB_SPIN(cond, bar) do { unsigned _sp = 0; while (cond) { __builtin_amdgcn_s_sleep(1); \
    if ((++_sp & 255u) == 0u) { if (xb_ld(&(bar)[XB_TMO])) break; if (_sp > XB_SPIN_CAP) { atomicAdd(&(bar)[XB_TMO], 1u); break; } } } } while (0)

struct XcdBarrier {
    unsigned* bar; unsigned x;
    volatile LAS unsigned* st;
};

__device__ __forceinline__ XcdBarrier xcd_barrier_post(unsigned* bar, volatile LAS unsigned* st, int tid) {
    XcdBarrier b; b.bar = bar; b.x = xb_xcc_id(); b.st = st;
    if (tid == 0) (void)xb_add(&bar[XB_XCNT(b.x)], 1u);
    return b;
}
__device__ __forceinline__ void xcd_barrier_complete(unsigned* bar, unsigned x, unsigned& nloc, unsigned& nx) {
    const unsigned G = gridDim.x * gridDim.y * gridDim.z;
    unsigned sum, cnt, mine, sp = 0u;
    for (;;) {
        sum = 0u; cnt = 0u; mine = 0u;
#pragma unroll
        for (unsigned j = 0; j < 16; ++j) { const unsigned c = xb_ld(&bar[XB_XCNT(j)]); sum += c; cnt += (c > 0u) ? 1u : 0u; mine = (j == x) ? c : mine; }
        if (sum == G) break;
        __builtin_amdgcn_s_sleep(1);
        if ((++sp & 255u) == 0u) { if (xb_ld(&bar[XB_TMO])) break; if (sp > XB_SPIN_CAP) { atomicAdd(&bar[XB_TMO], 1u); break; } }
    }
    nloc = mine > 0u ? mine : 1u; nx = cnt > 0u ? cnt : 1u;
}

__device__ __forceinline__ void xcd_barrier(const XcdBarrier& b, int tid) {
    asm volatile("s_waitcnt vmcnt(0)" ::: "memory");
    __syncthreads();
    if (tid == 0) {
        unsigned* bar = b.bar;
        __builtin_amdgcn_s_waitcnt(0);
        unsigned nloc = b.st[0], nx = b.st[1];
        if (nloc == 0u) { xcd_barrier_complete(bar, b.x, nloc, nx); b.st[0] = nloc; b.st[1] = nx; }
        const unsigned old = xb_add(&bar[XB_XSUB(b.x)], 1u);
        const unsigned gen = old / nloc;
        if (old + 1u == (gen + 1u) * nloc) {
            __builtin_amdgcn_fence(__ATOMIC_RELEASE, "agent");
            asm volatile("s_waitcnt vmcnt(0)" ::: "memory");
            const unsigned og = xb_add(&bar[XB_TOP], 1u);
            const unsigned tg = og / nx;
            if (og + 1u == (tg + 1u) * nx) xb_add(&bar[XB_TOPGEN], 1u);
            else XB_SPIN(xb_ld(&bar[XB_TOPGEN]) == tg, bar);
            __builtin_amdgcn_fence(__ATOMIC_ACQUIRE, "agent");
            xb_add(&bar[XB_XGEN(b.x)], 1u);
            asm volatile("s_waitcnt vmcnt(0)" ::: "memory");
        } else {
            XB_SPIN(xb_ld(&bar[XB_XGEN(b.x)]) == gen, bar);
            __builtin_amdgcn_fence(__ATOMIC_ACQUIRE, "agent");
            asm volatile("s_waitcnt vmcnt(0)" ::: "memory");
        }
    }
    __syncthreads();
}

struct Ctx { LAS unsigned char* lds; int tid, lane, wave, G, vcu; unsigned char* ws; };
struct Args { const float* in[28]; float* out; unsigned char* ws; int ph_lo, ph_hi, rep_mask, pad; };
typedef const __attribute__((address_space(4))) Args* CArgs;
__device__ __forceinline__ const float* inp(CArgs a, int i) { return (const float*)(GAS const float*)a->in[i]; }
enum { I_X = 0, I_C, I_CTX, I_CCTX, I_WADA, I_BADA, I_WIN, I_AQN, I_AKN, I_CONVW, I_CONVB, I_LWA, I_LBA, I_LWX, I_LBX, I_LLAM, I_DLAM, I_DSUB, I_WBR, I_WOUT, I_LN1G, I_LN1B, I_WR, I_WG, I_WU, I_WDN, I_LN2G, I_LN2B };

__device__ __forceinline__ void tr_item64(const float* W, int ldw, int k0, int n0, bf16* dst0, bf16* dst1, int pitch, LAS bf16* scr, int lane, bool permd = false) {
    f32x4 v[16];
    const float* src = W + (size_t)(k0 + (lane >> 4)) * ldw + n0 + 4 * (lane & 15);
#pragma unroll
    for (int i = 0; i < 16; ++i) v[i] = *(const f32x4*)(src + (size_t)(4 * i) * ldw);
#pragma unroll
    for (int i = 0; i < 16; ++i) { const unsigned p0 = cvt_pk_bf16(v[i][0], v[i][1]), p1 = cvt_pk_bf16(v[i][2], v[i][3]);
        LAS unsigned* q = (LAS unsigned*)(scr + (4 * i + (lane >> 4)) * 66 + 4 * (lane & 15)); q[0] = p0; q[1] = p1; }
    LDS_WAIT(); asm volatile("" ::: "memory");
    const int c = lane & 7;
#pragma unroll
    for (int j = 0; j < 8; ++j) { const int n = (lane >> 3) + 8 * j; const LAS bf16* t = scr + (8 * c) * 66 + n;
        v4u o; o.x = (unsigned)t[0] | ((unsigned)t[66] << 16); o.y = (unsigned)t[2 * 66] | ((unsigned)t[3 * 66] << 16);
        o.z = (unsigned)t[4 * 66] | ((unsigned)t[5 * 66] << 16); o.w = (unsigned)t[6 * 66] | ((unsigned)t[7 * 66] << 16);
        const int nl = n & 31, nr = permd ? (16 * ((nl >> 2) & 1) + 4 * (nl >> 3) + (nl & 3)) : nl;
        bf16* d = ((j < 4) ? dst0 : dst1) + (size_t)nr * pitch;
        *(GAS v4u*)(d + 8 * c) = o; }
    LDS_WAIT(); asm volatile("" ::: "memory");
}

__device__ __forceinline__ void tr_item64_f8(const float* W, int ldw, int k0, int n0, unsigned char* dst0, unsigned char* dst1, int pitch, float scale, LAS bf16* scr, int lane, bool permd = false) {
    f32x4 v[16];
    const float* src = W + (size_t)(k0 + (lane >> 4)) * ldw + n0 + 4 * (lane & 15);
#pragma unroll
    for (int i = 0; i < 16; ++i) v[i] = *(const f32x4*)(src + (size_t)(4 * i) * ldw);
#pragma unroll
    for (int i = 0; i < 16; ++i) { const unsigned p0 = cvt_pk_bf16(v[i][0], v[i][1]), p1 = cvt_pk_bf16(v[i][2], v[i][3]);
        LAS unsigned* q = (LAS unsigned*)(scr + (4 * i + (lane >> 4)) * 66 + 4 * (lane & 15)); q[0] = p0; q[1] = p1; }
    LDS_WAIT(); asm volatile("" ::: "memory");
    const int c = lane & 3;
#pragma unroll
    for (int j = 0; j < 4; ++j) { const int n = (lane >> 2) + 16 * j; const LAS bf16* t = scr + (16 * c) * 66 + n;
        float f[16];
#pragma unroll
        for (int q = 0; q < 16; ++q) f[q] = __uint_as_float((unsigned)t[q * 66] << 16) * scale;
        v4u o; o.x = pg8::pk_fp8x4(f[0], f[1], f[2], f[3]); o.y = pg8::pk_fp8x4(f[4], f[5], f[6], f[7]); o.z = pg8::pk_fp8x4(f[8], f[9], f[10], f[11]); o.w = pg8::pk_fp8x4(f[12], f[13], f[14], f[15]);
        const int nl8 = n & 31, nr8 = permd ? (16 * ((nl8 >> 2) & 1) + 4 * (nl8 >> 3) + (nl8 & 3)) : nl8;
        unsigned char* d = ((j < 2) ? dst0 : dst1) + (size_t)nr8 * pitch;
        *(GAS v4u*)(d + 16 * c) = o; }
    LDS_WAIT(); asm volatile("" ::: "memory");
}

struct CvItem { const float* src; unsigned voff; int ldw; unsigned char* d0; unsigned char* d1; int pitch; float scale; };
__device__ __forceinline__ void cv_load(f32x4 (&v)[16], const CvItem& c) {
#pragma unroll
    for (int i = 0; i < 16; ++i) v[i] = *(const f32x4*)((const char*)uni(c.src + (size_t)(4 * i) * c.ldw) + c.voff);
}
__device__ __forceinline__ void cv_finish(const f32x4 (&v)[16], const CvItem& ci, LAS bf16* scr, int lane) {
#pragma unroll
    for (int i = 0; i < 16; ++i) { const unsigned p0 = cvt_pk_bf16(v[i][0], v[i][1]), p1 = cvt_pk_bf16(v[i][2], v[i][3]);
        LAS unsigned* q = (LAS unsigned*)(scr + (4 * i + (lane >> 4)) * 66 + 4 * (lane & 15)); q[0] = p0; q[1] = p1; }
    LDS_WAIT(); asm volatile("" ::: "memory");
    const int c = lane & 3;
#pragma unroll
    for (int j = 0; j < 4; ++j) { const int n = (lane >> 2) + 16 * j; const LAS bf16* t = scr + (16 * c) * 66 + n;
        float f[16];
#pragma unroll
        for (int q = 0; q < 16; ++q) f[q] = __uint_as_float((unsigned)t[q * 66] << 16) * ci.scale;
        v4u o; o.x = pg8::pk_fp8x4(f[0], f[1], f[2], f[3]); o.y = pg8::pk_fp8x4(f[4], f[5], f[6], f[7]); o.z = pg8::pk_fp8x4(f[8], f[9], f[10], f[11]); o.w = pg8::pk_fp8x4(f[12], f[13], f[14], f[15]);
        unsigned char* d = (j < 2) ? ci.d0 + (size_t)n * ci.pitch : ci.d1 + (size_t)(n - 32) * ci.pitch;
        *(GAS v4u*)(d + 16 * c) = o; }
    LDS_WAIT(); asm volatile("" ::: "memory");
}
__device__ __forceinline__ void cv_pack(const f32x4 (&v)[16], unsigned (&pk)[32]) {
#pragma unroll
    for (int i = 0; i < 16; ++i) { pk[2 * i] = cvt_pk_bf16(v[i][0], v[i][1]); pk[2 * i + 1] = cvt_pk_bf16(v[i][2], v[i][3]); }
}
__device__ __forceinline__ void cv_finish_p(const unsigned (&pk)[32], const CvItem& ci, LAS bf16* scr, int lane) {
#pragma unroll
    for (int i = 0; i < 16; ++i) { LAS unsigned* q = (LAS unsigned*)(scr + (4 * i + (lane >> 4)) * 66 + 4 * (lane & 15)); q[0] = pk[2 * i]; q[1] = pk[2 * i + 1]; }
    LDS_WAIT(); asm volatile("" ::: "memory");
    const int c = lane & 3;
#pragma unroll
    for (int j = 0; j < 4; ++j) { const int n = (lane >> 2) + 16 * j; const LAS bf16* t = scr + (16 * c) * 66 + n;
        float f[16];
#pragma unroll
        for (int q = 0; q < 16; ++q) f[q] = __uint_as_float((unsigned)t[q * 66] << 16) * ci.scale;
        v4u o; o.x = pg8::pk_fp8x4(f[0], f[1], f[2], f[3]); o.y = pg8::pk_fp8x4(f[4], f[5], f[6], f[7]); o.z = pg8::pk_fp8x4(f[8], f[9], f[10], f[11]); o.w = pg8::pk_fp8x4(f[12], f[13], f[14], f[15]);
        unsigned char* d = (j < 2) ? ci.d0 + (size_t)n * ci.pitch : ci.d1 + (size_t)(n - 32) * ci.pitch;
        *(GAS v4u*)(d + 16 * c) = o; }
    LDS_WAIT(); asm volatile("" ::: "memory");
}
__device__ __forceinline__ void cv_pack8(const f32x4 (&v)[16], float scale, unsigned (&P)[4][4]) {
#pragma unroll
    for (int j = 0; j < 4; ++j)
#pragma unroll
        for (int g = 0; g < 4; ++g) P[j][g] = pg8::pk_fp8x4(v[4 * g][j] * scale, v[4 * g + 1][j] * scale, v[4 * g + 2][j] * scale, v[4 * g + 3][j] * scale);
}
__device__ __forceinline__ void cv_store8(const unsigned (&P)[4][4], const CvItem& ci, int lane) {
    const int n = 4 * (lane & 15) + (lane >> 4);
    unsigned char* d = (n < 32) ? ci.d0 + (size_t)n * ci.pitch : ci.d1 + (size_t)(n - 32) * ci.pitch;
#pragma unroll
    for (int g = 0; g < 4; ++g) {
        const auto a = __builtin_amdgcn_permlane16_swap(P[0][g], P[1][g], false, false); const auto b = __builtin_amdgcn_permlane16_swap(P[2][g], P[3][g], false, false);
        const auto c = __builtin_amdgcn_permlane32_swap(a[0], b[0], false, false); const auto e = __builtin_amdgcn_permlane32_swap(a[1], b[1], false, false);
        const unsigned q0 = c[0], q2 = c[1], q1 = e[0], q3 = e[1];
        const unsigned t0 = __builtin_amdgcn_perm(q1, q0, 0x05010400u), t1 = __builtin_amdgcn_perm(q1, q0, 0x07030602u), t2 = __builtin_amdgcn_perm(q3, q2, 0x05010400u), t3 = __builtin_amdgcn_perm(q3, q2, 0x07030602u);
        v4u o; o.x = __builtin_amdgcn_perm(t2, t0, 0x05040100u); o.y = __builtin_amdgcn_perm(t2, t0, 0x07060302u); o.z = __builtin_amdgcn_perm(t3, t1, 0x05040100u); o.w = __builtin_amdgcn_perm(t3, t1, 0x07060302u);
        *(GAS v4u*)(d + 16 * g) = o; }
}
constexpr int CV_ITEMS = 3 * 11008, CV_IN_LRU = 0, CV_IN_ATT = 16;
__device__ __forceinline__ CvItem cv_make(CArgs a, unsigned char* ws, int l, int it, int lane) {
    CvItem c; const int which = it / 11008, r = it % 11008, e = r / 688, q = r % 688;
    if (which < 2) { const int kb = q / 43, nb = q % 43, n0 = nb * 64, k0 = kb * 64;
        const float* W = inp(a, which == 0 ? I_WG : I_WU) + ((size_t)(l * NE + e) * D) * FF;
        const int drow = e * 5632 + (n0 >> 7) * 256 + (n0 & 127) + which * 128; unsigned char* d0 = ws + WS_WGU + (size_t)drow * D + k0;
        c.src = W + (size_t)k0 * FF + n0; c.voff = (unsigned)((lane >> 4) * FF + 4 * (lane & 15)) * 4u; c.ldw = FF; c.d0 = d0; c.d1 = d0 + (size_t)32 * D; c.pitch = D; c.scale = WSC_GU; }
    else { const int kb = q / 16, nb = q % 16, n0 = nb * 64, k0 = kb * 64;
        const float* W = inp(a, I_WDN) + ((size_t)(l * NE + e) * FF) * D; unsigned char* d0 = ws + WS_WD + ((size_t)e * D + n0) * FFP + k0;
        c.src = W + (size_t)k0 * D + n0; c.voff = (unsigned)((lane >> 4) * D + 4 * (lane & 15)) * 4u; c.ldw = D; c.d0 = d0; c.d1 = d0 + (size_t)32 * FFP; c.pitch = FFP; c.scale = WSC_D; }
    return c;
}

__device__ __forceinline__ void ph_prologue(const Ctx& X, CArgs a) {
    float* MOD = (float*)(X.ws + WS_MOD);
    if ((int)blockIdx.x < 384) {
        LAS float* SV = (LAS float*)X.lds;
        LAS float* RED = (LAS float*)(X.lds + 5 * 1024 * 4);
        for (int i = X.tid; i < 5 * 1024; i += 512) { const int v = i >> 10, k = i & 1023; const float cv = v < 4 ? inp(a, I_C)[v * 1024 + k] : inp(a, I_CCTX)[k]; SV[i] = silu_f(cv); }
        __syncthreads();
        for (int it = blockIdx.x; it < 384; it += X.G) {
            const int l = it / 192, n0 = (it % 192) * 32, kg = X.tid >> 5, cn = X.tid & 31;
            const float* W = inp(a, I_WADA) + (size_t)l * 1024 * 6144 + n0 + cn;
            float acc[5] = {0.f, 0.f, 0.f, 0.f, 0.f};
#pragma unroll 16
            for (int k = kg; k < 1024; k += 16) { const float w = W[(size_t)k * 6144];
#pragma unroll
                for (int v = 0; v < 5; ++v) acc[v] += SV[v * 1024 + k] * w; }
#pragma unroll
            for (int v = 0; v < 5; ++v) RED[(kg * 5 + v) * 32 + cn] = acc[v];
            __syncthreads();
            if (X.tid < 160) { const int v = X.tid >> 5; float s = 0.f;
                for (int q = 0; q < 16; ++q) s += RED[(q * 5 + v) * 32 + cn];
                MOD[(l * 5 + v) * 6144 + n0 + cn] = s + inp(a, I_BADA)[l * 6144 + n0 + cn]; }
            __syncthreads();
        }
    }
    LAS bf16* scr = (LAS bf16*)(X.lds + 32768 + X.wave * 8448);
    const int gw = X.vcu * NWAVES + X.wave, NGW = X.G * NWAVES;
    bf16* WIN = (bf16*)(X.ws + WS_WIN); bf16* WBR = (bf16*)(X.ws + WS_WBR); bf16* WOUT = (bf16*)(X.ws + WS_WOUT);
    for (int it = gw; it < 3200 + 768 + 512; it += NGW) {
        if (it < 3200) { const int l = it / 1600, r = it % 1600, kb = r / 100, nb = r % 100, n0 = nb * 64, k0 = kb * 64;
            const int tile = n0 >> 8, wc = (n0 & 255) >> 6, drow = tile * 256 + 32 * wc;
            bf16* d0 = WIN + (size_t)l * DIN * D + (size_t)drow * D + k0;
            if (n0 < 3328) tr_item64(inp(a, I_WIN) + (size_t)l * D * DIN, DIN, k0, n0, d0, d0 + (size_t)128 * D, D, scr, X.lane);
            else { unsigned char* e0 = (unsigned char*)(WIN + (size_t)l * DIN * D + (size_t)3328 * D) + (size_t)(n0 - 3328) * D + k0;
                tr_item64_f8(inp(a, I_WIN) + (size_t)l * D * DIN, DIN, k0, n0, e0, e0 + (size_t)32 * D, D, WSC_GU, scr, X.lane, true); } }
        else if (it < 3200 + 768) { const int q = it - 3200, ln = q / 128, r = q % 128, kb = r / 16, nb = r % 16, n0 = nb * 64, k0 = kb * 64;
            bf16* d0 = WBR + (size_t)ln * 1024 * 512 + (size_t)n0 * 512 + k0;
            tr_item64(inp(a, I_WBR) + (size_t)ln * 512 * 1024, 1024, k0, n0, d0, d0 + (size_t)32 * 512, 512, scr, X.lane); }
        else { const int q = it - 3968, l = q / 256, r = q % 256, kb = r / 16, nb = r % 16, n0 = nb * 64, k0 = kb * 64;
            bf16* d0 = WOUT + (size_t)l * D * D + (size_t)n0 * D + k0;
            tr_item64(inp(a, I_WOUT) + (size_t)l * D * D, D, k0, n0, d0, d0 + (size_t)32 * D, D, scr, X.lane); }
    }
    bf16* LW = (bf16*)(X.ws + WS_LRUW);
    for (int i = gw * 64 + X.lane; i < 2 * 2 * 2 * 8 * 4096; i += NGW * 64) {
        const int k = i & 63, n = (i >> 6) & 63, g = (i >> 12) & 7, gate = (i >> 15) & 1, d = (i >> 16) & 1, l = i >> 17;
        const float* src = gate ? inp(a, I_LWX) : inp(a, I_LWA);
        const float w = src[((((size_t)l * 2 + d) * 8 + g) * 64 + k) * 64 + n];
        LW[i] = (bf16)(cvt_pk_bf16(w, 0.f) & 0xffffu);
    }
}

__device__ __forceinline__ const float* xrow_ptr(CArgs a, unsigned char* ws, int l, int r) {
    if (l == 0) return r < T ? inp(a, I_X) + (size_t)r * D : inp(a, I_CTX) + (size_t)(r - T) * D;
    return (const float*)(ws + WS_X2) + (size_t)r * D;
}
__device__ __forceinline__ const float* mod_ptr(unsigned char* ws, int l, int r) { const int v = r < T ? (r >> 13) : 4; return (const float*)(ws + WS_MOD) + (size_t)(l * 5 + v) * 6144; }

__device__ __forceinline__ void ph_make_xh0(const Ctx& X, CArgs a) {
    const int gw = X.vcu * NWAVES + X.wave, NGW = X.G * NWAVES;
    bf16* XH = (bf16*)(X.ws + WS_SA);
    for (int r0 = gw * 4; r0 < R; r0 += NGW * 4) {
        const float* md = mod_ptr(X.ws, 0, r0);
        f32x4 x[4][4];
#pragma unroll
        for (int q = 0; q < 4; ++q) { const float* xr = xrow_ptr(a, X.ws, 0, r0 + q);
#pragma unroll
            for (int j = 0; j < 4; ++j) x[q][j] = *(const f32x4*)(xr + 4 * X.lane + 256 * j); }
#pragma unroll
        for (int j = 0; j < 4; ++j) { const int c = 4 * X.lane + 256 * j; const f32x4 sh = *(const f32x4*)(md + c), sc = *(const f32x4*)(md + 1024 + c) + 1.0f;
#pragma unroll
            for (int q = 0; q < 4; ++q) { const f32x4 h = x[q][j] * sc + sh; v2u w; w.x = cvt_pk_bf16(h[0], h[1]); w.y = cvt_pk_bf16(h[2], h[3]);
                *(v2u*)(XH + (size_t)(r0 + q) * D + c) = w; *(unsigned*)(X.ws + WS_XH8 + (size_t)(r0 + q) * D + c) = pg8::pk_fp8x4(h[0], h[1], h[2], h[3]); } }
    }
}

__device__ __forceinline__ f32x2 lru_comp(f32x2 first, f32x2 second) { return (f32x2){first.x * second.x, second.x * first.y + second.y}; }
template <int PASS> __device__ __forceinline__ void ph_lru(const Ctx& X, CArgs a, int l, bool need_ctx) {
    LAS float* U = (LAS float*)X.lds;
    LAS f32x2* WAG = (LAS f32x2*)(X.lds + 34816);
    LAS float* PRE = (LAS float*)(X.lds + 34816 + 8192);
    LAS f32x2* CAR = (LAS f32x2*)(X.lds + 34816 + 8192 + 4096);
    LAS v4u* BW = (LAS v4u*)(X.lds + 51200);
    LAS float* CW = (LAS float*)(X.lds + 51200 + 32768);
    unsigned char* wsl = X.ws;
#define LRU_WS(off) (wsl + (off))
#define XB ((const bf16*)LRU_WS(WS_XB))
#define GB ((const bf16*)LRU_WS(WS_GB))
#define YB ((bf16*)LRU_WS(WS_BR) + (size_t)R * 512)
#define LW ((const bf16*)LRU_WS(WS_LRUW) + (size_t)l * 2 * 2 * 8 * 4096)
#define AGG ((f32x2*)LRU_WS(WS_AGG))
#define LBQ ((v4u*)LRU_WS(WS_MM32))
    const int w = X.wave;
    int tid_o = X.tid; asm volatile("" : "+v"(tid_o));
    int quad = (tid_o & 63) >> 4, l16 = tid_o & 15, tt = tid_o >> 2, c16 = (tid_o & 3) * 16;
    int gcur = -1; float cba[2][4], cbx[2][4], csp[2][4];
#define LRU_ITEM(it_, b_, sc_, g_) const int b_ = (it_) / 528, sc_ = ((it_) % 528) >> 3, g_ = (it_) & 7
#define LRU_LOADX(dst, it_) do { LRU_ITEM(it_, b__, sc__, g__); const int slo = sc__ < 2 ? T + b__ * CTX : b__ * SEQ, sln = sc__ < 2 ? CTX : SEQ, tq = (sc__ < 2 ? sc__ * 128 : (sc__ - 2) * 128) + tt - 2; \
        _Pragma("unroll") for (int j = 0; j < 4; ++j) { const int t = tq + j; const bool ok = t >= 0 && t < sln; const bf16* p = XB + (size_t)(slo + (ok ? t : 0)) * 512 + g__ * 64 + c16; \
            dst[j][0] = ok ? *(const v4u*)p : (v4u){0u, 0u, 0u, 0u}; dst[j][1] = ok ? *(const v4u*)(p + 8) : (v4u){0u, 0u, 0u, 0u}; } } while (0)
    v4u xc[4][2];
    int item = blockIdx.x;
    while (item < NB * 66 * 8 && PASS == 2 && !need_ctx && ((item % 528) >> 3) < 2) item += X.G;
    if (PASS == 1 && item < NB * 66 * 8) LRU_LOADX(xc, item);
    int cvk = 0;
    while (item < NB * 66 * 8) {
        LRU_ITEM(item, b, sc, g);
        { unsigned long long w_ = (unsigned long long)X.ws; asm volatile("" : "+s"(w_)); wsl = (unsigned char*)(GAS unsigned char*)w_; }
        asm volatile("" : "+v"(tid_o)); quad = (tid_o & 63) >> 4; l16 = tid_o & 15; tt = tid_o >> 2; c16 = (tid_o & 3) * 16;
        int nitem = item + X.G;
        f32x4 cvv[16]; CvItem cvi; const bool cvh = PASS == 2 && cvk < CV_IN_LRU;
        while (nitem < NB * 66 * 8 && PASS == 2 && !need_ctx && ((nitem % 528) >> 3) < 2) nitem += X.G;
        const int seqlo = sc < 2 ? T + b * CTX : b * SEQ, t0 = sc < 2 ? sc * 128 : (sc - 2) * 128;
        if (PASS == 1 && g != gcur) {
            __syncthreads();
            CArgs a2 = a; asm volatile("" : "+s"(a2));
            const bf16* lw_ = LW;
            for (int i = X.tid; i < 2048; i += 512) { const int slot = i >> 6, ln = i & 63, ks = slot & 1, nt = (slot >> 1) & 3, dg = slot >> 3;
                BW[i] = *(const v4u*)(lw_ + ((size_t)(dg * 8 + g) * 64 + nt * 16 + (ln & 15)) * 64 + ks * 32 + 8 * (ln >> 4)); }
            if (X.tid < 320) { const int j = X.tid >> 6, ch = X.tid & 63; CW[X.tid] = j < 4 ? inp(a2, I_CONVW)[(l * 4 + j) * 512 + g * 64 + ch] : inp(a2, I_CONVB)[l * 512 + g * 64 + ch]; }
#pragma unroll
            for (int d = 0; d < 2; ++d)
#pragma unroll
                for (int nt = 0; nt < 4; ++nt) { const int ch = g * 64 + nt * 16 + l16;
                    cba[d][nt] = inp(a2, I_LBA)[(l * 2 + d) * 512 + ch]; cbx[d][nt] = inp(a2, I_LBX)[(l * 2 + d) * 512 + ch];
                    const float el = fast_exp(-inp(a2, I_LLAM)[(l * 2 + d) * 512 + ch]);
                    csp[d][nt] = el < 0.03f ? el * (1.0f - el * (0.5f - el * (0.33333334f - el * 0.25f))) : __builtin_amdgcn_logf(1.0f + el) * 0.6931471805599453f; }
            gcur = g;
            __syncthreads();
        }
        if (PASS == 2) {
        { const int dc = tid_o & 127, d = dc >> 6, ch = dc & 63, sg = tid_o >> 7;
          const f32x2* ag = AGG + (size_t)(b * 2 + d) * 66 * 512 + g * 64 + ch;
          const int npos = d == 0 ? sc : (sc == 1 ? 0 : (sc == 0 ? 1 : 67 - sc));
          f32x2 qv[17];
#pragma unroll
          for (int k = 0; k < 17; ++k) { const int p = sg * 17 + k; const int c = d == 0 ? p : (p == 0 ? 1 : (p == 1 ? 0 : 67 - p));
              qv[k] = p < npos ? ag[(size_t)c * 512] : (f32x2){1.f, 0.f}; }
          f32x2 part = {1.f, 0.f};
#pragma unroll
          for (int k = 0; k < 17; ++k) part = lru_comp(part, qv[k]);
          CAR[sg * 128 + dc] = part; }
        }
        if (PASS == 1) { float u[16];
#pragma unroll
          for (int k = 0; k < 16; k += 4) { const f32x4 bvv = *(const LAS f32x4*)(CW + 256 + c16 + k); u[k] = bvv[0]; u[k + 1] = bvv[1]; u[k + 2] = bvv[2]; u[k + 3] = bvv[3]; }
#pragma unroll
          for (int j = 0; j < 4; ++j) { const unsigned xw[8] = {xc[j][0].x, xc[j][0].y, xc[j][0].z, xc[j][0].w, xc[j][1].x, xc[j][1].y, xc[j][1].z, xc[j][1].w};
#pragma unroll
              for (int k = 0; k < 16; k += 4) { const f32x4 wv = *(const LAS f32x4*)(CW + j * 64 + c16 + k);
                  u[k] += wv[0] * bf_lo(xw[k >> 1]); u[k + 1] += wv[1] * bf_hi(xw[k >> 1]); u[k + 2] += wv[2] * bf_lo(xw[(k >> 1) + 1]); u[k + 3] += wv[3] * bf_hi(xw[(k >> 1) + 1]); } }
#pragma unroll
          for (int k = 0; k < 16; k += 4) *(LAS f32x4*)(U + tt * 68 + c16 + k) = (f32x4){u[k], u[k + 1], u[k + 2], u[k + 3]}; }
        if (PASS == 1 && nitem < NB * 66 * 8) LRU_LOADX(xc, nitem);
        const int rowb = seqlo + t0 + 16 * w + 4 * quad;
        unsigned short gbq[4][4];
        if (PASS == 2) {
#pragma unroll
            for (int nt = 0; nt < 4; ++nt)
#pragma unroll
                for (int i = 0; i < 4; ++i) gbq[nt][i] = GB[(size_t)(rowb + i) * 512 + g * 64 + nt * 16 + l16]; }
        v4u lbq[8];
        if (PASS == 2) {
#pragma unroll
            for (int k = 0; k < 8; ++k) lbq[k] = LBQ[((size_t)item * 8 + k) * 512 + tid_o]; }
        if (cvh) { cvi = cv_make(a, X.ws, l, (X.vcu * NWAVES + w) + cvk * (X.G * NWAVES), tid_o & 63); cv_load(cvv, cvi); }
        if (PASS == 1) __syncthreads();
        float av[2][4][4], bv[2][4][4];
        if (PASS == 1) {
        bf16x8 af[2];
#pragma unroll
        for (int ks = 0; ks < 2; ++ks) { const LAS float* up = U + (16 * w + l16) * 68 + ks * 32 + 8 * quad; const f32x4 p0 = *(const LAS f32x4*)up, p1 = *(const LAS f32x4*)(up + 4);
            v4u pk; pk.x = cvt_pk_bf16(p0[0], p0[1]); pk.y = cvt_pk_bf16(p0[2], p0[3]); pk.z = cvt_pk_bf16(p1[0], p1[1]); pk.w = cvt_pk_bf16(p1[2], p1[3]); af[ks] = __builtin_bit_cast(bf16x8, pk); }
#pragma unroll
        for (int d = 0; d < 2; ++d)
#pragma unroll
            for (int nt = 0; nt < 4; ++nt) {
                f32x4 cr = {0.f, 0.f, 0.f, 0.f}, ci = {0.f, 0.f, 0.f, 0.f};
#pragma unroll
                for (int ks = 0; ks < 2; ++ks) {
                    const bf16x8 br = __builtin_bit_cast(bf16x8, BW[((((d * 2 + 0) * 4 + nt) * 2 + ks) << 6) + (tid_o & 63)]);
                    const bf16x8 bi = __builtin_bit_cast(bf16x8, BW[((((d * 2 + 1) * 4 + nt) * 2 + ks) << 6) + (tid_o & 63)]);
                    cr = __builtin_amdgcn_mfma_f32_16x16x32_bf16(af[ks], br, cr, 0, 0, 0);
                    ci = __builtin_amdgcn_mfma_f32_16x16x32_bf16(af[ks], bi, ci, 0, 0, 0);
                }
                const float ba = cba[d][nt], bx = cbx[d][nt], sp = csp[d][nt];
                unsigned pkw[4];
#pragma unroll
                for (int i = 0; i < 4; ++i) {
                    const float uu = U[(16 * w + 4 * quad + i) * 68 + nt * 16 + l16];
                    const float rr = sigmoid_f(cr[i] + ba), ii = sigmoid_f(ci[i] + bx);
                    const float la = -8.0f * rr * sp, x2 = 2.0f * la;
                    const float om = x2 > -0.25f ? -x2 * (1.0f + x2 * (0.5f + x2 * (0.16666667f + x2 * (0.041666668f + x2 * (0.008333334f + x2 * 0.0013888889f))))) : 1.0f - fast_exp(x2);
                    av[d][nt][i] = fast_exp(la); bv[d][nt][i] = __builtin_amdgcn_sqrtf(om) * (ii * uu);
                    pkw[i] = (unsigned)__builtin_bit_cast(unsigned short, (_Float16)la) | cvt_pk_bf16(0.f, bv[d][nt][i]);
                }
                LBQ[((size_t)item * 8 + d * 4 + nt) * 512 + tid_o] = (v4u){pkw[0], pkw[1], pkw[2], pkw[3]};
            }
        } else {
#pragma unroll
        for (int d = 0; d < 2; ++d)
#pragma unroll
            for (int nt = 0; nt < 4; ++nt) { const v4u q4 = lbq[d * 4 + nt]; const unsigned qq[4] = {q4.x, q4.y, q4.z, q4.w};
#pragma unroll
                for (int i = 0; i < 4; ++i) { av[d][nt][i] = fast_exp((float)__builtin_bit_cast(_Float16, (unsigned short)(qq[i] & 0xffffu))); bv[d][nt][i] = __uint_as_float(qq[i] & 0xffff0000u); } }
        }
        f32x2 seg[2][4];
#pragma unroll
        for (int nt = 0; nt < 4; ++nt) {
            { float A = 1.f, H = 0.f;
#pragma unroll
              for (int i = 0; i < 4; ++i) { H = av[0][nt][i] * H + bv[0][nt][i]; A *= av[0][nt][i]; } seg[0][nt] = (f32x2){A, H}; }
            { float A = 1.f, H = 0.f;
#pragma unroll
              for (int i = 3; i >= 0; --i) { H = av[1][nt][i] * H + bv[1][nt][i]; A *= av[1][nt][i]; } seg[1][nt] = (f32x2){A, H}; }
        }
#pragma unroll
        for (int d = 0; d < 2; ++d)
#pragma unroll
            for (int nt = 0; nt < 4; ++nt) {
                f32x2 tot = seg[d][nt];
#pragma unroll
                for (int off = 16; off <= 32; off <<= 1) {
                    const f32x2 o = (f32x2){__shfl_xor(tot.x, off), __shfl_xor(tot.y, off)};
                    const bool me_low = (X.lane & off) == 0;
                    const bool me_first = (d == 0) ? me_low : !me_low;
                    tot = me_first ? lru_comp(tot, o) : lru_comp(o, tot);
                }
                if (quad == 0) WAG[(d * 8 + w) * 64 + nt * 16 + l16] = tot;
            }
        __syncthreads();
        if (PASS == 1) {
            if (X.tid < 128) { const int d = X.tid >> 6, ch = X.tid & 63; f32x2 tot = (f32x2){1.f, 0.f};
                for (int q = 0; q < 8; ++q) { const int ww = d == 0 ? q : 7 - q; tot = lru_comp(tot, WAG[(d * 8 + ww) * 64 + ch]); }
                AGG[((size_t)(b * 2 + d) * 66 + sc) * 512 + g * 64 + ch] = tot; }
            __syncthreads();
        } else {
            if (X.tid < 128) { const int d = X.tid >> 6, ch = X.tid & 63; float st = 0.f;
#pragma unroll
                for (int sg = 0; sg < 4; ++sg) { const f32x2 q = CAR[sg * 128 + X.tid]; st = q.x * st + q.y; }
                for (int q = 0; q < 8; ++q) { const int ww = d == 0 ? q : 7 - q; PRE[(d * 8 + ww) * 64 + ch] = st; const f32x2 t2 = WAG[(d * 8 + ww) * 64 + ch]; st = t2.x * st + t2.y; } }
            __syncthreads();
#pragma unroll
            for (int nt = 0; nt < 4; ++nt) {
                float y[4];
                { float s = PRE[(0 * 8 + w) * 64 + nt * 16 + l16];
#pragma unroll
                  for (int q = 0; q < 4; ++q) { const float A = __shfl(seg[0][nt].x, q * 16 + l16), H = __shfl(seg[0][nt].y, q * 16 + l16); if (q < quad) s = A * s + H; }
#pragma unroll
                  for (int i = 0; i < 4; ++i) { s = av[0][nt][i] * s + bv[0][nt][i]; y[i] = s; } }
                { float s = PRE[(1 * 8 + w) * 64 + nt * 16 + l16];
#pragma unroll
                  for (int q = 3; q >= 0; --q) { const float A = __shfl(seg[1][nt].x, q * 16 + l16), H = __shfl(seg[1][nt].y, q * 16 + l16); if (q > quad) s = A * s + H; }
#pragma unroll
                  for (int i = 3; i >= 0; --i) { s = av[1][nt][i] * s + bv[1][nt][i]; y[i] += s; } }
                const int ch = g * 64 + nt * 16 + l16;
#pragma unroll
                for (int i = 0; i < 4; ++i) { const size_t o = (size_t)(rowb + i) * 512 + ch; const float gbv = __uint_as_float((unsigned)gbq[nt][i] << 16);
                    YB[o] = (bf16)(cvt_pk_bf16(y[i] * gbv, 0.f) & 0xffffu); }
            }
            __syncthreads();
        }
        if (cvh) { cv_finish(cvv, cvi, (LAS bf16*)(X.lds + 51200 + w * 8448), tid_o & 63); ++cvk; }
        item = nitem;
    }
    for (; PASS == 2 && cvk < CV_IN_LRU; ++cvk) {
        const CvItem ci = cv_make(a, X.ws, l, (X.vcu * NWAVES + w) + cvk * (X.G * NWAVES), tid_o & 63); f32x4 v[16]; cv_load(v, ci); cv_finish(v, ci, (LAS bf16*)(X.lds + 51200 + w * 8448), tid_o & 63); }
#undef LRU_ITEM
#undef LRU_LOADX
#undef LRU_WS
#undef XB
#undef GB
#undef YB
#undef LW
#undef AGG
#undef LBQ
}

__device__ __forceinline__ void ph_diff_combine(const Ctx& X, CArgs a, int l, int nrows) {
    const int gw = X.vcu * NWAVES + X.wave, NGW = X.G * NWAVES;
    const float lam_init = l == 0 ? 0.2f : 0.35550906759096926f;
    const float* dl = inp(a, I_DLAM) + l * 256;
    const float s1 = wave_sum(dl[X.lane] * dl[64 + X.lane]), s2 = wave_sum(dl[128 + X.lane] * dl[192 + X.lane]);
    const float lam = expf(s1) - expf(s2) + lam_init;
    const bf16* DO0 = (const bf16*)(X.ws + WS_DO); const bf16* DO1 = DO0 + (size_t)R * 512; bf16* YC = (bf16*)(X.ws + WS_BR) + (size_t)2 * R * 512;
    const float* sub = inp(a, I_DSUB) + l * 128 + (8 * X.lane & 127);
    const f32x4 g0 = *(const f32x4*)sub, g1 = *(const f32x4*)(sub + 4);
    const float post = 1.0f - lam_init;
    for (int r = gw; r < nrows; r += NGW) {
        const v4u p = *(const v4u*)(DO0 + (size_t)r * 512 + 8 * X.lane), q = *(const v4u*)(DO1 + (size_t)r * 512 + 8 * X.lane);
        float v[8] = {bf_lo(p.x) - lam * bf_lo(q.x), bf_hi(p.x) - lam * bf_hi(q.x), bf_lo(p.y) - lam * bf_lo(q.y), bf_hi(p.y) - lam * bf_hi(q.y),
                      bf_lo(p.z) - lam * bf_lo(q.z), bf_hi(p.z) - lam * bf_hi(q.z), bf_lo(p.w) - lam * bf_lo(q.w), bf_hi(p.w) - lam * bf_hi(q.w)};
        float ss = 0.f;
#pragma unroll
        for (int k = 0; k < 8; ++k) ss += v[k] * v[k];
        ss += __shfl_xor(ss, 1); ss += __shfl_xor(ss, 2); ss += __shfl_xor(ss, 4); ss += __shfl_xor(ss, 8);
        const float rinv = __builtin_amdgcn_rsqf(ss * (1.0f / 128.0f) + RMS_EPS) * post;
        v4u o; o.x = cvt_pk_bf16(v[0] * rinv * g0[0], v[1] * rinv * g0[1]); o.y = cvt_pk_bf16(v[2] * rinv * g0[2], v[3] * rinv * g0[3]);
        o.z = cvt_pk_bf16(v[4] * rinv * g1[0], v[5] * rinv * g1[1]); o.w = cvt_pk_bf16(v[6] * rinv * g1[2], v[7] * rinv * g1[3]);
        *(v4u*)(YC + (size_t)r * 512 + 8 * X.lane) = o;
    }
}

__device__ __forceinline__ void ph_ln1_router(const Ctx& X, CArgs a, int l, int nrows) {
    const int gw = X.vcu * NWAVES + X.wave, NGW = X.G * NWAVES;
    LAS float* WR = (LAS float*)X.lds;
    for (int i = X.tid; i < 16 * 1024; i += 512) { const int c = i >> 4, e = i & 15; WR[e * 1024 + c] = inp(a, I_WR)[(size_t)l * 1024 * 16 + i]; }
    __syncthreads();
    const bf16* O16 = (const bf16*)(X.ws + WS_GM); float* X1 = (float*)(X.ws + WS_X1); unsigned char* H2 = X.ws + WS_SA; float* AFF = (float*)(X.ws + WS_AFF);
    const float* lg = uni(inp(a, I_LN1G) + l * D); const float* lb = uni(inp(a, I_LN1B) + l * D);
    f32x4 xn[2][4]; v2u on[2][4];
#define LN1_FETCH(rr_) do { unsigned lp_ = 4u * (unsigned)X.lane; asm volatile("" : "+v"(lp_)); \
        const float* p0_ = uni(xrow_ptr(a, X.ws, l, (rr_))); const float* p1_ = uni(xrow_ptr(a, X.ws, l, (rr_) + 1)); const bf16* po_ = uni(O16 + (size_t)(rr_) * D); \
        _Pragma("unroll") for (int j = 0; j < 4; ++j) { xn[0][j] = *(const f32x4*)(p0_ + (lp_ + 256u * j)); xn[1][j] = *(const f32x4*)(p1_ + (lp_ + 256u * j)); } \
        _Pragma("unroll") for (int j = 0; j < 4; ++j) { on[0][j] = *(const v2u*)(po_ + (lp_ + 256u * j)); on[1][j] = *(const v2u*)(po_ + (lp_ + 1024u + 256u * j)); } } while (0)
    if (gw * 2 < nrows) LN1_FETCH(gw * 2);
    for (int r0 = gw * 2; r0 < nrows; r0 += NGW * 2) {
        const float* md = uni(mod_ptr(X.ws, l, r0));
        unsigned l4 = 4u * (unsigned)X.lane; asm volatile("" : "+v"(l4));
        float* x1p = uni(X1 + (size_t)r0 * D); unsigned char* h2p = uni(H2 + (size_t)r0 * D);
        f32x4 v[2][4]; float s[2] = {0.f, 0.f};
#pragma unroll
        for (int j = 0; j < 4; ++j) { v[0][j] = xn[0][j]; v[1][j] = xn[1][j]; }
#pragma unroll
        for (int j = 0; j < 4; ++j) { const f32x4 g1 = *(const f32x4*)(md + (l4 + 2048u + 256u * j));
#pragma unroll
            for (int q = 0; q < 2; ++q) { const v2u ow = on[q][j]; const f32x4 of = {bf_lo(ow.x), bf_hi(ow.x), bf_lo(ow.y), bf_hi(ow.y)};
                v[q][j] = v[q][j] * DN_ALPHA + g1 * of;
                s[q] += (v[q][j][0] + v[q][j][1]) + (v[q][j][2] + v[q][j][3]); } }
        float mean[2], rstd[2];
#pragma unroll
        for (int q = 0; q < 2; ++q) mean[q] = wave_sum(s[q]) * (1.0f / D);
#pragma unroll
        for (int q = 0; q < 2; ++q) { float qq = 0.f;
#pragma unroll
            for (int j = 0; j < 4; ++j) { v[q][j] = v[q][j] - mean[q]; qq += (v[q][j][0] * v[q][j][0] + v[q][j][1] * v[q][j][1]) + (v[q][j][2] * v[q][j][2] + v[q][j][3] * v[q][j][3]); }
            s[q] = qq; }
#pragma unroll
        for (int q = 0; q < 2; ++q) rstd[q] = 1.0f / sqrtf(wave_sum(s[q]) * (1.0f / D) + LN_EPS);
#pragma unroll
        for (int j = 0; j < 4; ++j) { const unsigned c = l4 + 256u * j;
            const f32x4 g4 = *(const f32x4*)(lg + c), b4 = *(const f32x4*)(lb + c), sc4 = *(const f32x4*)(md + (c + 4096u)) + 1.0f, sh4 = *(const f32x4*)(md + (c + 3072u));
#pragma unroll
            for (int q = 0; q < 2; ++q) { const f32x4 y = v[q][j] * rstd[q] * g4 + b4;
                *(f32x4*)(x1p + (c + 1024u * q)) = y;
                const f32x4 h = y * sc4 + sh4; v[q][j] = h;
                *(unsigned*)(h2p + (c + 1024u * q)) = pg8::pk_fp8x4(h[0], h[1], h[2], h[3]); } }
        __builtin_amdgcn_sched_barrier(0);
        if (r0 + NGW * 2 < nrows) LN1_FETCH(r0 + NGW * 2);
        __builtin_amdgcn_sched_barrier(0);
        float lgt[2][16];
#pragma unroll
        for (int q = 0; q < 2; ++q) {
            unsigned cq = l4; asm volatile("" : "+v"(cq));
#pragma unroll
            for (int e = 0; e < 16; ++e) lgt[q][e] = 0.f;
#pragma unroll
            for (int j = 0; j < 4; ++j)
#pragma unroll
                for (int e = 0; e < 16; ++e) { const f32x4 wr = *(const LAS f32x4*)(WR + e * 1024 + cq + 256u * j);
                    lgt[q][e] += (v[q][j][0] * wr[0] + v[q][j][1] * wr[1]) + (v[q][j][2] * wr[2] + v[q][j][3] * wr[3]);
                    asm volatile("" : "+v"(lgt[q][e]));
                    if ((e & 7) == 7) __builtin_amdgcn_sched_barrier(0); }
        }
#pragma unroll
        for (int q = 0; q < 2; ++q) {
            float k8[8], k4[4], k2[2], k1;
            { const bool hi = (X.lane & 32) != 0;
#pragma unroll
              for (int e = 0; e < 8; ++e) { const float send = hi ? lgt[q][e] : lgt[q][e + 8], keep = hi ? lgt[q][e + 8] : lgt[q][e]; k8[e] = keep + __shfl_xor(send, 32); } }
            { const bool hi = (X.lane & 16) != 0;
#pragma unroll
              for (int e = 0; e < 4; ++e) { const float send = hi ? k8[e] : k8[e + 4], keep = hi ? k8[e + 4] : k8[e]; k4[e] = keep + __shfl_xor(send, 16); } }
            { const bool hi = (X.lane & 8) != 0;
#pragma unroll
              for (int e = 0; e < 2; ++e) { const float send = hi ? k4[e] : k4[e + 2], keep = hi ? k4[e + 2] : k4[e]; k2[e] = keep + __shfl_xor(send, 8); } }
            { const bool hi = (X.lane & 4) != 0; const float send = hi ? k2[0] : k2[1], keep = hi ? k2[1] : k2[0]; k1 = keep + __shfl_xor(send, 4); }
            k1 += __shfl_xor(k1, 2); k1 += __shfl_xor(k1, 1);
            float mx = k1;
            mx = fmaxf(mx, __shfl_xor(mx, 32)); mx = fmaxf(mx, __shfl_xor(mx, 16)); mx = fmaxf(mx, __shfl_xor(mx, 8)); mx = fmaxf(mx, __shfl_xor(mx, 4));
            const float ex = expf(k1 - mx); float den = ex;
            den += __shfl_xor(den, 32); den += __shfl_xor(den, 16); den += __shfl_xor(den, 8); den += __shfl_xor(den, 4);
            const int eidx = ((X.lane >> 5) & 1) * 8 + ((X.lane >> 4) & 1) * 4 + ((X.lane >> 3) & 1) * 2 + ((X.lane >> 2) & 1);
            if ((X.lane & 3) == 0) AFF[(size_t)(r0 + q) * 16 + eidx] = ex / den;
        }
    }
#undef LN1_FETCH
    __syncthreads();
}

__device__ __forceinline__ void ph_topk_convert(const Ctx& X, CArgs a, int l, bool need_ctx) {
    LAS unsigned* HIST = (LAS unsigned*)X.lds;
    LAS unsigned* SH = HIST + 256;
    const float* AFF = (const float*)(X.ws + WS_AFF); int* SLOT = (int*)(X.ws + WS_SLOT); int* SRC = (int*)(X.ws + WS_SRC);
    const int nitems = need_ctx ? 128 : 64;
    for (int it = blockIdx.x; it < nitems; it += X.G) {
        const bool isc = it >= 64; const int q = it & 63, b = q >> 4, e = q & 15;
        const int n = isc ? CTX : SEQ, cap = isc ? CAPC : CAP, rbase = isc ? T + b * CTX : b * SEQ;
        unsigned key[16];
#pragma unroll
        for (int i = 0; i < 16; ++i) { const int t = i * 512 + X.tid; key[i] = t < n ? __float_as_uint(AFF[(size_t)(rbase + t) * 16 + e]) : 0u; }
        unsigned prefix = 0u, need = (unsigned)cap;
        for (int pass = 0; pass < 4; ++pass) {
            const int shift = 24 - 8 * pass;
            if (X.tid < 256) HIST[X.tid] = 0u;
            __syncthreads();
            if (pass == 0) {
#pragma unroll
                for (int i = 0; i < 16; ++i) { bool act = (i * 512 + X.tid) < n; const unsigned bin = key[i] >> 24;
#pragma unroll
                    for (int rep = 0; rep < 4; ++rep) { const unsigned long long am = __ballot(act);
                        if (am != 0ull) { const int leader = __builtin_ctzll(am); const unsigned vv = (unsigned)__builtin_amdgcn_readlane((int)bin, leader); const unsigned long long mm = __ballot(act && bin == vv);
                            if (X.lane == leader) __hip_atomic_fetch_add(&HIST[vv], (unsigned)__popcll(mm), __ATOMIC_RELAXED, __HIP_MEMORY_SCOPE_WORKGROUP);
                            act = act && bin != vv; } }
                    if (act) __hip_atomic_fetch_add(&HIST[bin], 1u, __ATOMIC_RELAXED, __HIP_MEMORY_SCOPE_WORKGROUP); }
            } else {
#pragma unroll
            for (int i = 0; i < 16; ++i) { const bool ok = ((key[i] >> (shift + 8)) == (prefix >> (shift + 8)));
                if (ok && (i * 512 + X.tid) < n) __hip_atomic_fetch_add(&HIST[(key[i] >> shift) & 255u], 1u, __ATOMIC_RELAXED, __HIP_MEMORY_SCOPE_WORKGROUP); }
            }
            __syncthreads();
            if (X.wave == 0) {
                const unsigned c0 = HIST[4 * X.lane], c1 = HIST[4 * X.lane + 1], c2 = HIST[4 * X.lane + 2], c3 = HIST[4 * X.lane + 3];
                const unsigned s = c0 + c1 + c2 + c3; unsigned suf = s;
#pragma unroll
                for (int off = 1; off < 64; off <<= 1) { const unsigned o = __shfl_down(suf, off); if (X.lane + off < 64) suf += o; }
                const unsigned above = suf - s;
                if (above < need && need <= above + s) {
                    unsigned cum = above; int bin;
                    if (need <= cum + c3) bin = 3; else { cum += c3; if (need <= cum + c2) bin = 2; else { cum += c2; if (need <= cum + c1) bin = 1; else { cum += c1; bin = 0; } } }
                    SH[0] = prefix | ((unsigned)(4 * X.lane + bin) << shift); SH[1] = need - cum;
                }
            }
            __syncthreads();
            prefix = SH[0]; need = SH[1];
            __syncthreads();
        }
        const unsigned K = prefix;
        const int niter = isc ? 1 : 16;
        LAS unsigned* CNT = SH + 32;
#pragma unroll
        for (int i = 0; i < 16; ++i) { if (i < niter) { const int t = i * 512 + X.tid; const bool valid = t < n;
            const unsigned long long mg = __ballot(valid && key[i] > K), me = __ballot(valid && key[i] == K);
            if (X.lane == 0) CNT[i * 8 + X.wave] = (unsigned)__popcll(mg) | ((unsigned)__popcll(me) << 16); } }
        __syncthreads();
        if (X.wave == 0) { const int ne = niter * 8;
            const unsigned c0 = 2 * X.lane < ne ? CNT[2 * X.lane] : 0u, c1 = 2 * X.lane + 1 < ne ? CNT[2 * X.lane + 1] : 0u;
            const unsigned sm = c0 + c1; unsigned inc = sm;
#pragma unroll
            for (int off = 1; off < 64; off <<= 1) { const unsigned o = __shfl_up(inc, off); if (X.lane >= off) inc += o; }
            const unsigned exc = inc - sm;
            if (2 * X.lane < ne) CNT[2 * X.lane] = exc;
            if (2 * X.lane + 1 < ne) CNT[2 * X.lane + 1] = exc + c0; }
        __syncthreads();
#pragma unroll
        for (int i = 0; i < 16; ++i) { if (i < niter) { const int t = i * 512 + X.tid; const bool valid = t < n;
            const bool gt = valid && key[i] > K, eq = valid && key[i] == K;
            const unsigned long long mg = __ballot(gt), me = __ballot(eq);
            const unsigned long long lower = (1ull << X.lane) - 1ull;
            const unsigned bs = CNT[i * 8 + X.wave];
            const unsigned ngt = (bs & 0xffffu) + (unsigned)__popcll(mg & lower), neq = (bs >> 16) + (unsigned)__popcll(me & lower);
            const bool sel = gt || (eq && neq < need);
            const unsigned pos = ngt + (neq < need ? neq : need);
            if (valid) { SLOT[(size_t)(rbase + t) * 16 + e] = sel ? (int)pos : -1;
                if (sel) SRC[e * EROWS + (isc ? 4096 + b * CAPC : b * CAP) + (int)pos] = rbase + t; } } }
        __syncthreads();
    }
    if (need_ctx) { const int gt = blockIdx.x * 512 + X.tid; if (gt < NE * 128) SRC[(gt >> 7) * EROWS + 4224 + (gt & 127)] = -1; }
    LAS bf16* scr = (LAS bf16*)(X.lds + 32768 + X.wave * 8448);
    const int gw = X.vcu * NWAVES + X.wave, NGW = X.G * NWAVES;
    unsigned char* WGU = X.ws + WS_WGU; unsigned char* WD = X.ws + WS_WD;
    __syncthreads();
    for (int it = gw + CV_IN_ATT * NGW; it < CV_ITEMS; it += NGW) {
        const CvItem ci = cv_make(a, X.ws, l, it, X.lane); f32x4 v[16]; unsigned P[4][4]; cv_load(v, ci); cv_pack8(v, ci.scale, P); cv_store8(P, ci, X.lane); }
    unsigned zz = 0u; asm volatile("" : "+v"(zz)); const v4u zero4 = {zz, zz, zz, zz};
    for (int i = gw * 64 + X.lane; i < NE * 128 * 64; i += NGW * 64) {
        const int e = i >> 13, rr = (i >> 6) & 127, pc = i & 63; const int row = e * 5632 + 21 * 256 + (rr >> 6) * 128 + 64 + (rr & 63);
        *(v4u*)(WGU + (size_t)row * D + pc * 16) = zero4; }
    for (int i = gw * 64 + X.lane; i < NE * 1024 * 4; i += NGW * 64) {
        const int rowi = i >> 2, pc = i & 3; *(v4u*)(WD + (size_t)rowi * FFP + FF + pc * 16) = zero4; }
}

__device__ __forceinline__ void ph_gather(const Ctx& X, bool need_ctx) {
    const int gw = X.vcu * NWAVES + X.wave, NGW = X.G * NWAVES;
    const int* SRC = (const int*)(X.ws + WS_SRC); const unsigned char* H2 = X.ws + WS_SA; unsigned char* XG = X.ws + WS_XG;
    const int per_e = need_ctx ? EROWS : 4096;
    for (int i0 = gw * 8; i0 < NE * per_e; i0 += NGW * 8) {
        const int e = i0 / per_e, q0 = i0 - e * per_e, mr0 = e * EROWS + q0;
        int src[8]; v4u v0[8];
#pragma unroll
        for (int q = 0; q < 8; ++q) src[q] = SRC[mr0 + q];
#pragma unroll
        for (int q = 0; q < 8; ++q) { v0[q] = (v4u){0u, 0u, 0u, 0u}; if (src[q] >= 0) v0[q] = *(const v4u*)(H2 + (size_t)src[q] * D + 16 * X.lane); }
#pragma unroll
        for (int q = 0; q < 8; ++q) *(v4u*)(XG + (size_t)(mr0 + q) * D + 16 * X.lane) = v0[q];
    }
}

__device__ __forceinline__ void ph_ln2(const Ctx& X, CArgs a, int l, int nrows) {
    const int gw = X.vcu * NWAVES + X.wave, NGW = X.G * NWAVES;
    const float* X1 = (const float*)(X.ws + WS_X1); const float* AFF = (const float*)(X.ws + WS_AFF); const int* SLOT = (const int*)(X.ws + WS_SLOT);
    const bf16* EO = (const bf16*)(X.ws + WS_EO); float* X2 = (float*)(X.ws + WS_X2); bf16* XH = (bf16*)(X.ws + WS_SA);
    const float* lg = inp(a, I_LN2G) + l * D; const float* lb = inp(a, I_LN2B) + l * D;
    int slv_n = -1; float afv_n = 0.f; f32x4 xn[2][4];
#define LN2_FETCH(rr_) do { unsigned lp_ = 4u * (unsigned)X.lane; asm volatile("" : "+v"(lp_)); \
        slv_n = X.lane < 32 ? SLOT[(size_t)(rr_) * 16 + X.lane] : -1; afv_n = X.lane < 32 ? AFF[(size_t)(rr_) * 16 + X.lane] : 0.f; \
        _Pragma("unroll") for (int q = 0; q < 2; ++q) _Pragma("unroll") for (int j = 0; j < 4; ++j) xn[q][j] = *(const f32x4*)(X1 + (size_t)((rr_) + q) * D + (lp_ + 256u * j)); } while (0)
    if (gw * 2 < nrows) LN2_FETCH(gw * 2);
    for (int r0 = gw * 2; r0 < nrows; r0 += NGW * 2) {
        const float* md = mod_ptr(X.ws, l, r0);
        const bool isc = r0 >= T; const int b = isc ? (r0 - T) >> 8 : r0 >> 13;
        const int slv = slv_n; const float afv = afv_n;
        f32x4 v[2][4], mo[2][4];
#pragma unroll
        for (int q = 0; q < 2; ++q)
#pragma unroll
            for (int j = 0; j < 4; ++j) { v[q][j] = xn[q][j]; mo[q][j] = (f32x4){0.f, 0.f, 0.f, 0.f}; }
        const unsigned long long bal = __ballot(slv >= 0);
        unsigned msk[2] = {(unsigned)(bal & 0xffffull), (unsigned)((bal >> 16) & 0xffffull)};
        const size_t rb = (size_t)(isc ? 4096 + b * CAPC : b * CAP);
        while ((msk[0] | msk[1]) != 0u) {
            v2u wv[2][4][4]; float af[2][4];
#pragma unroll
            for (int q = 0; q < 2; ++q) { unsigned m = msk[q];
#pragma unroll
                for (int k = 0; k < 4; ++k) { const bool has = m != 0u; const int e = has ? __builtin_ctz(m) : 0; m = has ? (m & (m - 1u)) : 0u;
                    int sl = 0; float aq = 0.f;
                    if (has) { sl = __builtin_amdgcn_readlane(slv, q * 16 + e); aq = __builtin_bit_cast(float, __builtin_amdgcn_readlane(__builtin_bit_cast(int, afv), q * 16 + e)); }
                    af[q][k] = aq; const size_t er = (size_t)e * EROWS + rb + sl;
#pragma unroll
                    for (int j = 0; j < 4; ++j) wv[q][k][j] = *(const v2u*)(EO + er * D + 4 * X.lane + 256 * j); }
                msk[q] = m; }
#pragma unroll
            for (int q = 0; q < 2; ++q)
#pragma unroll
                for (int k = 0; k < 4; ++k)
#pragma unroll
                    for (int j = 0; j < 4; ++j) { const v2u w2 = wv[q][k][j]; const float aq = af[q][k];
                        mo[q][j][0] += aq * bf_lo(w2.x); mo[q][j][1] += aq * bf_hi(w2.x); mo[q][j][2] += aq * bf_lo(w2.y); mo[q][j][3] += aq * bf_hi(w2.y); }
        }
        __builtin_amdgcn_sched_barrier(0);
        if (r0 + NGW * 2 < nrows) LN2_FETCH(r0 + NGW * 2);
        __builtin_amdgcn_sched_barrier(0);
        float s[2] = {0.f, 0.f}, mean[2], rstd[2];
#pragma unroll
        for (int q = 0; q < 2; ++q)
#pragma unroll
            for (int j = 0; j < 4; ++j) { const int c = 4 * X.lane + 256 * j;
                v[q][j] = v[q][j] * DN_ALPHA + *(const f32x4*)(md + 5120 + c) * mo[q][j];
                s[q] += (v[q][j][0] + v[q][j][1]) + (v[q][j][2] + v[q][j][3]); }
#pragma unroll
        for (int q = 0; q < 2; ++q) mean[q] = wave_sum(s[q]) * (1.0f / D);
#pragma unroll
        for (int q = 0; q < 2; ++q) { float qq = 0.f;
#pragma unroll
            for (int j = 0; j < 4; ++j) { v[q][j] = v[q][j] - mean[q]; qq += (v[q][j][0] * v[q][j][0] + v[q][j][1] * v[q][j][1]) + (v[q][j][2] * v[q][j][2] + v[q][j][3] * v[q][j][3]); }
            s[q] = qq; }
#pragma unroll
        for (int q = 0; q < 2; ++q) rstd[q] = 1.0f / sqrtf(wave_sum(s[q]) * (1.0f / D) + LN_EPS);
        const float* md1 = (const float*)(X.ws + WS_MOD) + (size_t)(1 * 5 + (isc ? 4 : b)) * 6144;
#pragma unroll
        for (int j = 0; j < 4; ++j) { const int c = 4 * X.lane + 256 * j; const f32x4 g4 = *(const f32x4*)(lg + c), b4 = *(const f32x4*)(lb + c);
#pragma unroll
            for (int q = 0; q < 2; ++q) { const f32x4 y = v[q][j] * rstd[q] * g4 + b4;
                if (l == 0) { *(f32x4*)(X2 + (size_t)(r0 + q) * D + c) = y;
                    const f32x4 h = y * (*(const f32x4*)(md1 + 1024 + c) + 1.0f) + *(const f32x4*)(md1 + c);
                    v2u wv; wv.x = cvt_pk_bf16(h[0], h[1]); wv.y = cvt_pk_bf16(h[2], h[3]); *(v2u*)(XH + (size_t)(r0 + q) * D + c) = wv;
                    *(unsigned*)(X.ws + WS_XH8 + (size_t)(r0 + q) * D + c) = pg8::pk_fp8x4(h[0], h[1], h[2], h[3]); }
                else *(f32x4*)((float*)(GAS float*)a->out + (size_t)(r0 + q) * D + c) = y; } }
    }
#undef LN2_FETCH
}
__device__ __forceinline__ int lane_now() { int l_; asm volatile("v_mbcnt_lo_u32_b32 %0, -1, 0\n\tv_mbcnt_hi_u32_b32 %0, -1, %0" : "=v"(l_)); return l_; }
__device__ __forceinline__ void ph_attention(const Ctx& X, CArgs a, int l, unsigned char* lds_generic, bool need_ctx) {
    using attn_body::attn_unit; using attn_body::attn_unit_v128; typedef attn_body::bf16 abf;
    const abf* QA = (const abf*)(X.ws + WS_QA); const abf* KA = (const abf*)(X.ws + WS_KA); const abf* VA = (const abf*)(X.ws + WS_VA);
    const abf* QC = (const abf*)(X.ws + WS_QC); const abf* KC = (const abf*)(X.ws + WS_KC); const abf* VC = (const abf*)(X.ws + WS_VC);
    abf* YA = (abf*)(X.ws + WS_BR); abf* DO = (abf*)(X.ws + WS_DO);
    int cvk = CV_IN_LRU; const int gwc = X.vcu * NWAVES + X.wave, ngwc = X.G * NWAVES;
    bool nomax; { float gq = fabsf(inp(a, I_AQN)[l * 64 + lane_now()]), gk = fabsf(inp(a, I_AKN)[l * 64 + lane_now()]);
#pragma unroll
        for (int o = 1; o < 64; o <<= 1) { gq = fmaxf(gq, __shfl_xor(gq, o)); gk = fmaxf(gk, __shfl_xor(gk, o)); }
        const float bound = 64.0f * C2 * gq * gk * 1.02f;
        nomax = __builtin_amdgcn_readfirstlane((int)(bound < 40.0f)) != 0; }
    bool nomaxd; { const unsigned* nw = (const unsigned*)(X.ws + WS_CTL) + CW_NRM + 2 * l;
        const float mq = __uint_as_float(__hip_atomic_load(nw, __ATOMIC_RELAXED, __HIP_MEMORY_SCOPE_AGENT)), mk = __uint_as_float(__hip_atomic_load(nw + 1, __ATOMIC_RELAXED, __HIP_MEMORY_SCOPE_AGENT));
        const float boundd = C2 * sqrtf(mq * mk) * 1.02f;
        nomaxd = __builtin_amdgcn_readfirstlane((int)(boundd < 60.0f && mq > 0.0f && mk > 0.0f)) != 0; }
#define ATT_CV() do { if (cvk < CV_IN_ATT) { const bool two_ = cvk + 1 < CV_IN_ATT; \
        CvItem c0_ = cv_make(a, X.ws, l, gwc + cvk * ngwc, lane_now()); f32x4 v_[16]; unsigned pk_[4][4]; cv_load(v_, c0_); cv_pack8(v_, c0_.scale, pk_); \
        asm volatile("" ::: "memory"); __builtin_amdgcn_sched_barrier(0); \
        CvItem c1_ = c0_; if (two_) { c1_ = cv_make(a, X.ws, l, gwc + (cvk + 1) * ngwc, lane_now()); cv_load(v_, c1_); } \
        __builtin_amdgcn_sched_barrier(0); cv_store8(pk_, c0_, lane_now()); \
        if (two_) { cv_pack8(v_, c1_.scale, pk_); cv_store8(pk_, c1_, lane_now()); } cvk += 2; } } while (0)
    const int ng = nomax ? 512 : 1024, nun2 = ng + 1024 + (need_ctx ? 64 : 0);
    for (int U = X.vcu; U < nun2; U += X.G) {
        if (U < ng) {
            if (nomax) { const int qb = U & 15, h = (U >> 4) & 7, b = U >> 7; const size_t qrow = (size_t)b * SEQ + qb * 512;
                attn_body::attn_unit2(QA + qrow * 512 + h * 64, 512, KA + (size_t)b * KVL * 128 + (h >> 2) * 64, 128, VA + (size_t)b * KVL * 128 + (h >> 2) * 64, 128, YA + qrow * 512 + h * 64, 512, KVL / 64, (char*)lds_generic + RING_OFF, (X.wave << 6) | lane_now());
                ATT_CV(); }
            else { const int qb = U & 31, h = (U >> 5) & 7, b = U >> 8; const size_t qrow = (size_t)b * SEQ + qb * 256;
                attn_unit<8, false>(QA + qrow * 512 + h * 64, 512, KA + (size_t)b * KVL * 128 + (h >> 2) * 64, 128, VA + (size_t)b * KVL * 128 + (h >> 2) * 64, 128, YA + qrow * 512 + h * 64, 512, KVL / 64, (char*)lds_generic + RING_OFF, (X.wave << 6) | lane_now()); }
        } else if (U >= ng + 1024 && U < ng + 1024 + 32) { const int V = U - ng - 1024, h = V & 7, b = V >> 3; const size_t qrow = (size_t)T + b * CTX;
            if (nomax) attn_unit<8, true>(QA + qrow * 512 + h * 64, 512, KA + (size_t)b * KVL * 128 + (h >> 2) * 64, 128, VA + (size_t)b * KVL * 128 + (h >> 2) * 64, 128, YA + qrow * 512 + h * 64, 512, CTX / 64, (char*)lds_generic + RING_OFF, (X.wave << 6) | lane_now());
            else attn_unit<8, false>(QA + qrow * 512 + h * 64, 512, KA + (size_t)b * KVL * 128 + (h >> 2) * 64, 128, VA + (size_t)b * KVL * 128 + (h >> 2) * 64, 128, YA + qrow * 512 + h * 64, 512, CTX / 64, (char*)lds_generic + RING_OFF, (X.wave << 6) | lane_now());
        } else { int b, hj, NT; size_t qrow;
            if (U < ng + 1024) { const int V = U - ng, qb = V & 31; hj = (V >> 5) & 7; b = V >> 8; qrow = (size_t)b * SEQ + qb * 256; NT = KVL / 64; }
            else { const int V = U - ng - 1024 - 32; hj = V & 7; b = V >> 3; qrow = (size_t)T + b * CTX; NT = CTX / 64; }
            const int hc = hj >> 1, j = hj & 1;
            if (nomaxd) attn_unit_v128<8, true>(QC + qrow * 512 + hj * 64, 512, KC + (size_t)b * KVL * 512 + hj * 64, 512, VC + (size_t)b * KVL * 512 + hc * 128, 512, DO + (size_t)j * R * 512 + qrow * 512 + hc * 128, 512, NT, (char*)lds_generic + RING_OFF, (X.wave << 6) | lane_now());
            else attn_unit_v128<8, false>(QC + qrow * 512 + hj * 64, 512, KC + (size_t)b * KVL * 512 + hj * 64, 512, VC + (size_t)b * KVL * 512 + hc * 128, 512, DO + (size_t)j * R * 512 + qrow * 512 + hc * 128, 512, NT, (char*)lds_generic + RING_OFF, (X.wave << 6) | lane_now());
        }
        ATT_CV();
    }
    while (cvk < CV_IN_ATT) ATT_CV();
#undef ATT_CV
}

__device__ __forceinline__ bool grid_bar_fn(const XcdBarrier& bar, int tid) { XcdBarrier b2_ = bar; asm volatile("" : "+s"(b2_.x)); xcd_barrier(b2_, tid); return true; }
constexpr int PH_PER_LAYER = 12, N_PHASES = 2 + DEPTH * PH_PER_LAYER;
__global__ void __launch_bounds__(NWAVES * 64, 2) fwd_kernel(Args args) {
    extern __shared__ __attribute__((aligned(16))) unsigned char lds[];
    Ctx X;
    const int wave0 = __builtin_amdgcn_readfirstlane((int)threadIdx.x >> 6);
#define MK_TID() ({ int l_; asm volatile("v_mbcnt_lo_u32_b32 %0, -1, 0\n\tv_mbcnt_hi_u32_b32 %0, -1, %0" : "=v"(l_)); (wave0 << 6) | l_; })
    X.lds = (LAS unsigned char*)lds; X.tid = MK_TID(); X.lane = X.tid & 63; X.wave = wave0;
    X.G = gridDim.x; { const int bx = blockIdx.x; X.vcu = (X.G % 8 == 0) ? (bx % 8) * (X.G / 8) + bx / 8 : bx; }
    X.ws = args.ws;
    gu32* ctl = (gu32*)(args.ws + WS_CTL);
    volatile LAS unsigned* MISC = (volatile LAS unsigned*)(X.lds + MISC_OFF);
    for (int u = X.tid; u < (LDS_BYTES - LDSCTL_OFF) / 4; u += NWAVES * 64) ((LAS unsigned*)(X.lds + LDSCTL_OFF))[u] = 0u;
    __syncthreads();
#if MK_PER_PHASE
#define GRID_BAR() do { } while (0)
#else
    XcdBarrier bar = xcd_barrier_post((unsigned*)(ctl + CW_BAR), MISC + 8, X.tid);
#define GRID_BAR() ((void)grid_bar_fn(bar, MK_TID()))
#endif
#if MK_PER_PHASE
    const int lo = args.ph_lo, hi = args.ph_hi;
#endif
    CArgs A = (CArgs)__builtin_amdgcn_kernarg_segment_ptr(); int bx_ = (int)blockIdx.x;
#define OPQ() do { int t_ = MK_TID(); asm volatile("" : "+v"(t_)); X.tid = t_; X.lane = t_ & 63; X.wave = wave0; unsigned long long w_ = (unsigned long long)args.ws; asm volatile("" : "+s"(w_)); X.ws = (unsigned char*)(GAS unsigned char*)w_; A = (CArgs)__builtin_amdgcn_kernarg_segment_ptr(); asm volatile("" : "+s"(A)); bx_ = (int)blockIdx.x; asm volatile("" : "+s"(bx_)); } while (0)
#if MK_PER_PHASE
#define IN(k) (lo <= (k) && (k) < hi)
#else
#define IN(k) true
#endif
#ifdef MK_REP_MASK
#define REP(k) for (int rep_ = 0; rep_ <= ((MK_REP_MASK >> (k)) & 1); ++rep_) if (rep_ ? grid_bar_fn(bar, MK_TID()) : true)
#else
#define REP(k)
#endif
#define SEAM(k) do { if (IN(k) && IN((k) + 1)) GRID_BAR(); } while (0)
#define SA ((pg8::bf16_t*)(X.ws + WS_SA))

    REP(12) { if (IN(0)) { OPQ(); ph_prologue(X, A); } } SEAM(0);
    REP(13) { if (IN(1)) { OPQ(); ph_make_xh0(X, A); } } SEAM(1);

    for (int l = 0; l < DEPTH; ++l) {
        const int P = 2 + l * PH_PER_LAYER; const bool need_ctx = l < DEPTH - 1; const int nrows = need_ctx ? R : T;
        REP(0) { if (IN(P + 0)) { OPQ();
            { pg8::Gemm g{SA, (const pg8::bf16_t*)(X.ws + WS_WIN) + (size_t)l * DIN * D, R, 3328, D, nullptr};
              pg8::PlainOrder S{R / 256, 13, X.G, bx_};
              pg8::EpiInProj E{X.ws, inp(A, I_AQN) + l * 64, inp(A, I_AKN) + l * 64, (unsigned*)(X.ws + WS_CTL) + CW_NRM + 2 * l};
              pg8::gemm_phase<pg8::EpiInProj, pg8::PlainOrder, true, true>(X.lds + RING_OFF, g, S, E, X.tid); }
            OPQ();
            { pg8::Gemm g{(const pg8::bf16_t*)(X.ws + WS_XH8), (const pg8::bf16_t*)(X.ws + WS_WIN) + (size_t)l * DIN * D + (size_t)3328 * D, R, 3072, D / 2, nullptr};
              pg8::PlainOrder S{R / 256, 12, X.G, X.G - 1 - bx_};
              pg8::EpiGate8 E{X.ws + WS_GM, 1.0f / WSC_GU};
              pg8::gemm_phase<pg8::EpiGate8, pg8::PlainOrder, true, true, true>(X.lds + RING_OFF, g, S, E, X.tid); }
        } }
        SEAM(P + 0);
        REP(1) { if (IN(P + 1)) { OPQ(); ph_lru<1>(X, A, l, need_ctx); } }
#if MK_PER_PHASE
        SEAM(P + 1);
#endif
        REP(2) { if (IN(P + 2)) { OPQ(); ph_attention(X, A, l, lds, need_ctx); } } SEAM(P + 2);
        REP(3) { if (IN(P + 3)) { OPQ(); ph_lru<2>(X, A, l, need_ctx); ph_diff_combine(X, A, l, nrows); } } SEAM(P + 3);
        REP(4) { if (IN(P + 4)) { OPQ();
            pg8::Gemm g{(const pg8::bf16_t*)(X.ws + WS_BR), (const pg8::bf16_t*)(X.ws + WS_WBR) + (size_t)l * 3 * 1024 * 512, 3 * R, 3 * 1024, 512, nullptr};
            pg8::MergeOrder S{nrows / 256, X.G, bx_};
            pg8::EpiMerge E{(const unsigned char*)(X.ws + WS_GM), SA};
            pg8::gemm_phase<pg8::EpiMerge, pg8::MergeOrder, true, true>(X.lds + RING_OFF, g, S, E, X.tid);
        } }
        SEAM(P + 4);
        REP(5) { if (IN(P + 5)) { OPQ();
            pg8::Gemm g{SA, (const pg8::bf16_t*)(X.ws + WS_WOUT) + (size_t)l * D * D, R, D, D, nullptr};
            pg8::PlainOrder S{nrows / 256, 4, X.G, bx_};
            pg8::EpiBf16Out E{(pg8::bf16_t*)(X.ws + WS_GM), D, 1.0f};
            pg8::gemm_phase<pg8::EpiBf16Out, pg8::PlainOrder, true, true>(X.lds + RING_OFF, g, S, E, X.tid);
        } }
        SEAM(P + 5);
        REP(6) { if (IN(P + 6)) { OPQ(); ph_ln1_router(X, A, l, nrows); } } SEAM(P + 6);
        REP(7) { if (IN(P + 7)) { OPQ(); ph_topk_convert(X, A, l, need_ctx); } } do { if (IN(P + 7) && IN(P + 9)) GRID_BAR(); } while (0);
        REP(9) { if (IN(P + 9)) { OPQ();
            pg8::Gemm g{(const pg8::bf16_t*)(X.ws + WS_SA), (const pg8::bf16_t*)(X.ws + WS_WGU), MROWS, NE * 5632, D / 2, (const int*)(X.ws + WS_SRC)};
            pg8::MoeOrder S{need_ctx ? 17 : 16, 22, X.G, bx_};
            pg8::EpiGateUp8 E{X.ws + WS_ACT, 1.0f / WSC_GU};
            pg8::gemm_phase<pg8::EpiGateUp8, pg8::MoeOrder, true, true, true, true>(X.lds + RING_OFF, g, S, E, X.tid);
        } }
        SEAM(P + 9);
        REP(10) { if (IN(P + 10)) { OPQ();
            pg8::Gemm g{(const pg8::bf16_t*)(X.ws + WS_ACT), (const pg8::bf16_t*)(X.ws + WS_WD), MROWS, NE * 1024, FFP / 2, nullptr};
            pg8::MoeOrder S{need_ctx ? 17 : 16, 4, X.G, bx_};
            pg8::EpiBf16Out E{(pg8::bf16_t*)(X.ws + WS_EO), D, 1.0f / WSC_D};
            pg8::gemm_phase<pg8::EpiBf16Out, pg8::MoeOrder, true, true, true>(X.lds + RING_OFF, g, S, E, X.tid);
        } }
        SEAM(P + 10);
        REP(11) { if (IN(P + 11)) { OPQ(); ph_ln2(X, A, l, nrows); } }
        if (l + 1 < DEPTH) SEAM(P + 11);
    }
#undef IN
#undef MK_TID
#undef REP
#undef SA
#undef OPQ
#undef SEAM
#undef GRID_BAR
}

extern "C" void kernel_launch(void* const* d_in, const int* in_sizes, int n_in, void* d_out, int out_size, void* d_ws, size_t ws_size, hipStream_t stream) {
    static int grid = 0;
    if (grid == 0) {
        if (n_in != 28 || out_size != T * D || ws_size < WS_END) { fprintf(stderr, "kernel_launch: unexpected shapes: n_in %d out %d ws %zu (need %zu)\n", n_in, out_size, ws_size, (size_t)WS_END); grid = -1; return; }
        int dev = 0, cus = 0, per_cu = 0;
        if (hipGetDevice(&dev) != hipSuccess || hipDeviceGetAttribute(&cus, hipDeviceAttributeMultiprocessorCount, dev) != hipSuccess) { grid = -1; return; }
        if (hipFuncSetAttribute((const void*)fwd_kernel, hipFuncAttributeMaxDynamicSharedMemorySize, LDS_BYTES) != hipSuccess) { fprintf(stderr, "kernel_launch: hipFuncSetAttribute failed\n"); grid = -1; return; }
        if (hipOccupancyMaxActiveBlocksPerMultiprocessor(&per_cu, (const void*)fwd_kernel, NWAVES * 64, LDS_BYTES) != hipSuccess || per_cu < 1)
            fprintf(stderr, "kernel_launch: occupancy query reports %d workgroups per CU\n", per_cu);
        (void)hipGetLastError();
        grid = cus;
    }
    if (grid < 0) return;
    if (hipMemsetAsync((char*)d_ws + WS_CTL, 0, CTL_BYTES, stream) != hipSuccess) return;
    Args a{};
    for (int i = 0; i < 28; ++i) a.in[i] = (const float*)d_in[i];
    a.out = (float*)d_out; a.ws = (unsigned char*)d_ws;
#if MK_PER_PHASE
    for (int p = 0; p < N_PHASES; ++p) { a.ph_lo = p; a.ph_hi = p + 1; hipLaunchKernelGGL(fwd_kernel, dim3(grid), dim3(NWAVES * 64), LDS_BYTES, stream, a); }
#else
    a.ph_lo = 0; a.ph_hi = N_PHASES;
    hipLaunchKernelGGL(fwd_kernel, dim3(grid), dim3(NWAVES * 64), LDS_BYTES, stream, a);
#endif
    const hipError_t le = hipPeekAtLastError();
    if (le != hipSuccess) fprintf(stderr, "kernel_launch: launch failed: %s\n", hipGetErrorName(le));
}
```

```cpp
#include <hip/hip_runtime.h>
#include <hip/hip_bf16.h>
#include <cstdio>
#include <cstdint>
#include <cmath>

#ifndef MK_PER_PHASE
#define MK_PER_PHASE 0
#endif

constexpr int D = 1024, NB = 4, SEQ = 8192, CTX = 256, DEPTH = 2;
constexpr int T = NB * SEQ;
constexpr int TC = NB * CTX;
constexpr int R = T + TC;
constexpr int KVL = CTX + SEQ;
constexpr int DIN = 6400;
constexpr int NE = 16, FF = 2752, FFP = 2816, CAP = 1024, CAPC = 32;
constexpr int EROWS = 4352;
constexpr int MROWS = NE * EROWS;
constexpr float LN_EPS = 1e-5f, RMS_EPS = 1e-6f;
constexpr float DN_ALPHA = 1.41421356237309515f;
constexpr float WSC_GU = 32.0f, WSC_D = 128.0f;
constexpr float C2 = 0.125f * 1.4426950408889634f;

constexpr size_t al256(size_t x) { return (x + 255) & ~(size_t)255; }
constexpr size_t WS_CTL = 0, CTL_BYTES = 65536;
constexpr size_t WS_MOD  = WS_CTL + CTL_BYTES;
constexpr size_t WS_LRUW = al256(WS_MOD + (size_t)2 * 5 * 6144 * 4);
constexpr size_t WS_AGG  = al256(WS_LRUW + (size_t)2 * 2 * 2 * 8 * 4096 * 2);
constexpr size_t WS_AFF  = al256(WS_AGG + (size_t)4 * 2 * 66 * 512 * 8);
constexpr size_t WS_SLOT = al256(WS_AFF + (size_t)R * 16 * 4);
constexpr size_t WS_SRC  = al256(WS_SLOT + (size_t)R * 16 * 4);
constexpr size_t WS_WIN  = al256(WS_SRC + (size_t)MROWS * 4);
constexpr size_t WS_WBR  = al256(WS_WIN + (size_t)2 * DIN * D * 2);
constexpr size_t WS_WOUT = al256(WS_WBR + (size_t)2 * 3 * 1024 * 512 * 2);
constexpr size_t WS_WGU  = al256(WS_WOUT + (size_t)2 * D * D * 2);
constexpr size_t WS_WD   = al256(WS_WGU + (size_t)NE * 5632 * D * 2);
constexpr size_t WS_X1   = al256(WS_WD + (size_t)NE * D * FFP * 2);
constexpr size_t WS_X2   = al256(WS_X1 + (size_t)R * D * 4);
constexpr size_t WS_SA   = al256(WS_X2 + (size_t)R * D * 4);
constexpr size_t WS_OV   = al256(WS_SA + (size_t)R * D * 2);
constexpr size_t WS_QA = WS_OV;
constexpr size_t WS_KA = al256(WS_QA + (size_t)R * 512 * 2);
constexpr size_t WS_VA = al256(WS_KA + (size_t)R * 128 * 2);
constexpr size_t WS_XB = al256(WS_VA + (size_t)R * 128 * 2);
constexpr size_t WS_GB = al256(WS_XB + (size_t)R * 512 * 2);
constexpr size_t WS_QC = al256(WS_GB + (size_t)R * 512 * 2);
constexpr size_t WS_KC = al256(WS_QC + (size_t)R * 512 * 2);
constexpr size_t WS_VC = al256(WS_KC + (size_t)R * 512 * 2);
constexpr size_t WS_GM = al256(WS_VC + (size_t)R * 512 * 2);
constexpr size_t WS_BR = al256(WS_GM + (size_t)R * 3072 * 2);
constexpr size_t WS_DO = al256(WS_BR + (size_t)3 * R * 512 * 2);
constexpr size_t WS_MM32 = al256(WS_DO + (size_t)2 * R * 512 * 2);
constexpr size_t WS_MIX_END = al256(WS_MM32 + (size_t)R * D * 4);
constexpr size_t WS_XH8 = WS_MIX_END - al256((size_t)R * D);
constexpr size_t WS_XG  = WS_OV;
constexpr size_t WS_ACT = al256(WS_XG + (size_t)MROWS * D * 2);
constexpr size_t WS_EO  = al256(WS_ACT + (size_t)MROWS * FFP * 2);
constexpr size_t WS_MOE_END = al256(WS_EO + (size_t)MROWS * D * 2);
constexpr size_t WS_END = WS_MIX_END > WS_MOE_END ? WS_MIX_END : WS_MOE_END;
static_assert(WS_END <= (size_t)1442840576, "d_ws map exceeds 4 x largest tensor");
static_assert(WS_XH8 >= WS_MOE_END, "XH8 is written while the MoE outputs are read");
static_assert((size_t)R * D * 4 <= (size_t)R * 3072 * 2, "O32 fits in GM's place");

constexpr int CW_TMO = 0, CW_BAR = 1024, CW_NRM = 8192;

constexpr int RING_OFF = 0, RING_BYTES = 131072;
constexpr int LDSCTL_OFF = RING_BYTES, MISC_OFF = LDSCTL_OFF + 320;
constexpr int LDS_BYTES = 147456;
constexpr int NWAVES = 8;

#define GAS __attribute__((address_space(1)))
#define LAS __attribute__((address_space(3)))
typedef unsigned short bf16;
typedef unsigned v4u __attribute__((ext_vector_type(4)));
typedef unsigned v2u __attribute__((ext_vector_type(2)));
typedef float f32x4 __attribute__((ext_vector_type(4)));
typedef float f32x2 __attribute__((ext_vector_type(2)));
typedef short bf16x8 __attribute__((ext_vector_type(8)));
typedef GAS unsigned gu32;
#define RLX_AGENT __ATOMIC_RELAXED, __HIP_MEMORY_SCOPE_AGENT
#define LDS_WAIT() asm volatile("s_waitcnt lgkmcnt(0)" ::: "memory")
#define VM_WAIT() asm volatile("s_waitcnt vmcnt(0)" ::: "memory")
typedef float f32x2_cv __attribute__((ext_vector_type(2))); typedef __bf16 bf16x2_cv __attribute__((ext_vector_type(2)));
__device__ __forceinline__ unsigned cvt_pk_bf16(float lo, float hi) { const f32x2_cv v = {lo, hi}; const bf16x2_cv b = __builtin_convertvector(v, bf16x2_cv); return __builtin_bit_cast(unsigned, b); }
__device__ __forceinline__ float bf_lo(unsigned w) { return __uint_as_float(w << 16); }
__device__ __forceinline__ float bf_hi(unsigned w) { return __uint_as_float(w & 0xffff0000u); }
__device__ __forceinline__ float fast_exp(float x) { return __builtin_amdgcn_exp2f(x * 1.4426950408889634f); }
__device__ __forceinline__ float sigmoid_f(float x) { return __builtin_amdgcn_rcpf(1.0f + fast_exp(-x)); }
__device__ __forceinline__ float silu_f(float x) { return x * sigmoid_f(x); }
__device__ __forceinline__ float gelu_tanh_f(float x) { const float z = 0.7978845608028654f * (x + 0.044715f * x * x * x); return x * sigmoid_f(2.0f * z); }
__device__ __forceinline__ float wave_sum(float v) {
#pragma unroll
    for (int o = 1; o < 64; o <<= 1) v += __shfl_xor(v, o);
    return v;
}
template <class Tp> __device__ __forceinline__ Tp* uni(Tp* p) { const unsigned long long v = (unsigned long long)p;
    const unsigned lo = __builtin_amdgcn_readfirstlane((unsigned)v), hi = __builtin_amdgcn_readfirstlane((unsigned)(v >> 32));
    return (Tp*)(GAS Tp*)(((unsigned long long)hi << 32) | lo); }
namespace pg8 {
#define PG8_LAS __attribute__((address_space(3)))
typedef unsigned short bf16_t;
typedef short bf16x8 __attribute__((ext_vector_type(8)));
typedef float f32x4 __attribute__((ext_vector_type(4)));
typedef unsigned u32x4 __attribute__((ext_vector_type(4)));
constexpr int BM = 256, BK = 64, HALF = 128, HTB = HALF * BK * 2  , STAGE_BYTES = 8 * HTB, NXCD = 8, WGM = 8;

__host__ __device__ __forceinline__ int lds_byte(int r, int c) { const int st = (r >> 4) * 2 + (c >> 5), rr = r & 15, cc = c & 31, ob = rr * 64 + cc * 2; return st * 1024 + (ob ^ (((ob >> 9) & 1) << 5)); }
__host__ __device__ __forceinline__ void stage_rc(int b, int& R, int& C) { const int st = b / 1024, sb = b % 1024, swz = sb ^ (((sb >> 9) & 1) << 5); R = (st >> 1) * 16 + swz / 64; C = (st & 1) * 32 + (swz % 64) / 2; }
__host__ __device__ __forceinline__ int perm32(int rho) { const int n = rho >> 4, i = rho & 15; return 8 * (i >> 2) + 4 * n + (i & 3); }

struct Unit { int pm, pn, aux; };
struct Gemm { const bf16_t* A; const bf16_t* Bt; int M, N, K; const int* rowsrc; };

struct StaticOrder {
    int nM, nN, nwg, G, c;
    __host__ __device__ void init(int M, int N, int G_, int c_) { nM = M / BM; nN = N / BM; nwg = nM * nN; G = G_; c = c_; }
    __host__ __device__ bool next(int i, Unit& u) const {
        const long L = (long)i * G + c; if (L >= nwg) return false;
        int wgid = (int)L; { const int q = nwg / NXCD, r = nwg % NXCD, xcd = wgid % NXCD, off = wgid / NXCD; wgid = (xcd < r ? xcd * (q + 1) : r * (q + 1) + (xcd - r) * q) + off; }
        const int nig = WGM * nN, gid = wgid / nig, fm = gid * WGM, gsz = (nM - fm) < WGM ? (nM - fm) : WGM;
        u.pm = fm + ((wgid % nig) % gsz); u.pn = (wgid % nig) / gsz; return true;
    }
    __device__ __forceinline__ void a_ready(const Unit&) const {}
    __device__ __forceinline__ void done(const Unit&) const {}
};

typedef float f32x2 __attribute__((ext_vector_type(2)));

template <class Epi, class Sched, bool ALIGN_EPI = false, bool SP2 = false, bool F8 = false, bool GATHER = false>
__device__ __forceinline__ void gemm_phase(PG8_LAS unsigned char* lds, const Gemm g, const Sched& S, const Epi& E, const int tid_in) {
    int tid_ = tid_in; asm volatile("" : "+v"(tid_));
    const int tid = tid_, wid = __builtin_amdgcn_readfirstlane(tid >> 6), lane = tid & 63, wr = wid >> 2, wc = wid & 3, fr = lane & 15, fq = lane >> 4;
    const int K = g.K, nt = K / BK;
    unsigned voffA[2], voffB[2];
#pragma unroll
    for (int i = 0; i < 2; ++i) { int R, C; stage_rc(tid * 16 + i * 8192, R, C); const int Rb = Epi::PERM ? ((R & ~31) + perm32(R & 31)) : R;
        voffA[i] = (unsigned)(R * K + C) * 2u; voffB[i] = (unsigned)(Rb * K + C) * 2u; }
    const size_t kstep = (size_t)(BK * 2);
    static_assert(!GATHER || SP2, "GATHER is written for the SP2 loop");
    int grow[2]; { int R0, C0, R1, C1; stage_rc(tid * 16, R0, C0); stage_rc(tid * 16 + 8192, R1, C1); grow[0] = R0; grow[1] = R1; }
    unsigned gcol[2]; { gcol[0] = voffA[0] - (unsigned)(grow[0] * K) * 2u; gcol[1] = voffA[1] - (unsigned)(grow[1] * K) * 2u; }
    unsigned vC[2][2], vN[2][2];
    constexpr int GIDX_OFF = STAGE_BYTES + 1024;
    const size_t hstep = (size_t)HALF * K * 2;
    const size_t tstep = 2 * hstep;
    const unsigned ldsw = (unsigned)wid * 1024u;
    const int aoff = lds_byte(wr * 64 + fr, fq * 8), boff = lds_byte(wc * 32 + fr, fq * 8);
#define PG8_SA(b, h) (((b) * 2 + (h)) * HTB)
#define PG8_SB(b, h) ((4 + (b) * 2 + (h)) * HTB)
#define PG8_STAGE(bufoff, gbase, voff) do { _Pragma("unroll") for (int _i = 0; _i < 2; ++_i) \
        __builtin_amdgcn_global_load_lds((const unsigned*)((const char*)(gbase) + (voff)[_i]), (PG8_LAS unsigned*)(lds + (bufoff) + ldsw + _i * 8192), 16, 0, 0); } while (0)
#define PG8_LDA(dst, b, h) do { if constexpr (F8) { _Pragma("unroll") for (int m = 0; m < 4; ++m) dst##8[m] = __builtin_shufflevector(*(const PG8_LAS v4i_*)(lds + PG8_SA(b, h) + aoff + m * 2048), *(const PG8_LAS v4i_*)(lds + PG8_SA(b, h) + aoff + m * 2048 + 1024), 0, 1, 2, 3, 4, 5, 6, 7); } \
        else { _Pragma("unroll") for (int m = 0; m < 4; ++m) _Pragma("unroll") for (int k = 0; k < 2; ++k) dst[m][k] = *(const PG8_LAS bf16x8*)(lds + PG8_SA(b, h) + aoff + m * 2048 + k * 1024); } } while (0)
#define PG8_LDB(dst, b, h) do { if constexpr (F8) { _Pragma("unroll") for (int n = 0; n < 2; ++n) dst##8[n] = __builtin_shufflevector(*(const PG8_LAS v4i_*)(lds + PG8_SB(b, h) + boff + n * 2048), *(const PG8_LAS v4i_*)(lds + PG8_SB(b, h) + boff + n * 2048 + 1024), 0, 1, 2, 3, 4, 5, 6, 7); } \
        else { _Pragma("unroll") for (int n = 0; n < 2; ++n) _Pragma("unroll") for (int k = 0; k < 2; ++k) dst[n][k] = *(const PG8_LAS bf16x8*)(lds + PG8_SB(b, h) + boff + n * 2048 + k * 1024); } } while (0)
#define PG8_MMA(ai, bj, At, Bt) do { if constexpr (F8) __builtin_amdgcn_sched_barrier(0); __builtin_amdgcn_s_setprio(1); \
        if constexpr (F8) { _Pragma("unroll") for (int m = 0; m < 4; ++m) _Pragma("unroll") for (int n = 0; n < 2; ++n) \
            acc[ai][bj][m][n] = __builtin_amdgcn_mfma_scale_f32_16x16x128_f8f6f4(Bt##8[n], At##8[m], acc[ai][bj][m][n], 0, 0, 0, 0x7f7f7f7f, 0, 0x7f7f7f7f); } \
        else { _Pragma("unroll") for (int m = 0; m < 4; ++m) _Pragma("unroll") for (int n = 0; n < 2; ++n) _Pragma("unroll") for (int k = 0; k < 2; ++k) \
            acc[ai][bj][m][n] = __builtin_amdgcn_mfma_f32_16x16x32_bf16(Bt[n][k], At[m][k], acc[ai][bj][m][n], 0, 0, 0); } \
        __builtin_amdgcn_s_setprio(0); \
        if constexpr (F8) { _Pragma("unroll") for (int m = 0; m < 4; ++m) asm volatile("" : "+v"(acc[ai][bj][m][0]), "+v"(acc[ai][bj][m][1]));     \
            __builtin_amdgcn_sched_barrier(0); } } while (0)
#define PG8_WAIT_V(n) asm volatile("s_waitcnt vmcnt(" #n ")" ::: "memory")
#define PG8_WAIT_L(n) asm volatile("s_waitcnt lgkmcnt(" #n ")" ::: "memory")
#define PG8_BAR __builtin_amdgcn_s_barrier()
#define PG8_SCHED __builtin_amdgcn_sched_barrier(0)
    Unit cur, nxt; int ui = 0;
    if (!S.next(0, cur)) return;
    f32x4 acc[2][2][4][2];
#pragma unroll
    for (int a = 0; a < 2; ++a)
#pragma unroll
        for (int b = 0; b < 2; ++b)
#pragma unroll
            for (int m = 0; m < 4; ++m)
#pragma unroll
                for (int n = 0; n < 2; ++n) acc[a][b][m][n] = (f32x4){0.f, 0.f, 0.f, 0.f};
    typedef int v4i_ __attribute__((ext_vector_type(4))); typedef int v8i_ __attribute__((ext_vector_type(8)));
    bf16x8 At[4][2], B0[2][2], B1[2][2]; v8i_ At8[4], B08[2], B18[2];
    const char* cA = (const char*)g.A + (GATHER ? (size_t)0 : (size_t)cur.pm * tstep); const char* cB = (const char*)g.Bt + (size_t)cur.pn * tstep;
    if constexpr (GATHER) {
#pragma unroll
        for (int h = 0; h < 2; ++h)
#pragma unroll
            for (int i = 0; i < 2; ++i) { int r = g.rowsrc[cur.pm * BM + h * HALF + grow[i]]; r = r < 0 ? 0 : r; vC[h][i] = (unsigned)r * (unsigned)(K * 2) + gcol[i]; vN[h][i] = vC[h][i]; }
    }
#define PG8_STAGEA(bufoff, gbase, h, vsel) do { if constexpr (GATHER) { PG8_STAGE(bufoff, gbase, vsel[h]); } else { PG8_STAGE(bufoff, (gbase) + (h) * hstep, voffA); } } while (0)
    S.a_ready(cur);
    if constexpr (SP2) {
        PG8_STAGE(PG8_SB(0, 0), cB, voffB); PG8_STAGE(PG8_SB(0, 1), cB + hstep, voffB); PG8_STAGEA(PG8_SA(0, 0), cA, 0, vC); PG8_STAGEA(PG8_SA(0, 1), cA, 1, vC);
        if (wr == 1) PG8_BAR;
        PG8_WAIT_V(2); PG8_BAR;
        PG8_STAGE(PG8_SB(1, 0), cB + kstep, voffB); PG8_STAGEA(PG8_SA(1, 0), cA + kstep, 0, vC); PG8_STAGE(PG8_SB(1, 1), cB + hstep + kstep, voffB);
        PG8_WAIT_V(6); PG8_BAR;
    } else {
        PG8_STAGE(PG8_SB(0, 0), cB, voffB); PG8_STAGE(PG8_SA(0, 0), cA, voffA); PG8_STAGE(PG8_SB(0, 1), cB + hstep, voffB); PG8_STAGE(PG8_SA(0, 1), cA + hstep, voffA);
        if (wr == 1) PG8_BAR;
        PG8_WAIT_V(4); PG8_BAR;
        PG8_STAGE(PG8_SB(1, 0), cB + kstep, voffB); PG8_STAGE(PG8_SA(1, 0), cA + kstep, voffA); PG8_STAGE(PG8_SB(1, 1), cB + hstep + kstep, voffB);
        PG8_WAIT_V(6); PG8_BAR;
    }
    for (;;) {
        const bool has_next = S.next(ui + 1, nxt);
        const char* nA = (has_next && !GATHER) ? (const char*)g.A + (size_t)nxt.pm * tstep : cA; const char* nB = has_next ? (const char*)g.Bt + (size_t)nxt.pn * tstep : cB;
        if constexpr (GATHER) { if (has_next) {
#pragma unroll
            for (int h = 0; h < 2; ++h)
#pragma unroll
                for (int i = 0; i < 2; ++i) __builtin_amdgcn_global_load_lds((const unsigned*)(g.rowsrc + (nxt.pm * BM + h * HALF + grow[i])), (PG8_LAS unsigned*)(lds + GIDX_OFF + ((h * 2 + i) * 8 + wid) * 256), 4, 0, 0); } }
        for (int t = 0; t < nt; t += 2) {
            const bool last = (t == nt - 2);
            const char* a1 = cA + (size_t)(t + 1) * kstep;
            const char* a2 = last ? nA : cA + (size_t)(t + 2) * kstep; const char* b2 = last ? nB : cB + (size_t)(t + 2) * kstep;
            const char* a3 = a2 + kstep; const char* b3 = b2 + kstep;
            if (last && has_next) S.a_ready(nxt);
            unsigned vS[2][2];
            if constexpr (GATHER) {
                if (last && has_next) {
                    asm volatile("s_waitcnt vmcnt(8)" ::: "memory");
#pragma unroll
                    for (int h = 0; h < 2; ++h)
#pragma unroll
                        for (int i = 0; i < 2; ++i) { int r = *(const volatile PG8_LAS int*)(lds + GIDX_OFF + ((h * 2 + i) * 8 + wid) * 256 + lane * 4); r = r < 0 ? 0 : r; vN[h][i] = (unsigned)r * (unsigned)(K * 2) + gcol[i]; }
                }
#pragma unroll
                for (int h = 0; h < 2; ++h)
#pragma unroll
                    for (int i = 0; i < 2; ++i) vS[h][i] = (last && has_next) ? vN[h][i] : vC[h][i];
            }
            if constexpr (SP2) {
            PG8_LDB(B0, 0, 0); PG8_LDB(B1, 0, 1); PG8_SCHED; PG8_LDA(At, 0, 0); PG8_STAGEA(PG8_SA(1, 1), a1, 1, vC);
            PG8_WAIT_V(8); PG8_WAIT_L(0); PG8_BAR; PG8_MMA(0, 0, At, B0); PG8_MMA(0, 1, At, B1); PG8_BAR; PG8_SCHED;
            PG8_LDA(At, 0, 1); PG8_STAGE(PG8_SB(0, 0), b2, voffB); PG8_STAGE(PG8_SB(0, 1), b2 + hstep, voffB); PG8_STAGEA(PG8_SA(0, 0), a2, 0, vS);
            PG8_WAIT_V(8); PG8_WAIT_L(0); PG8_BAR; PG8_MMA(1, 0, At, B0); PG8_MMA(1, 1, At, B1); PG8_BAR; PG8_SCHED;
            PG8_LDB(B0, 1, 0); PG8_LDB(B1, 1, 1); PG8_SCHED; PG8_LDA(At, 1, 0); PG8_STAGEA(PG8_SA(0, 1), a2, 1, vS);
            PG8_WAIT_V(8); PG8_WAIT_L(0); PG8_BAR; PG8_MMA(0, 0, At, B0); PG8_MMA(0, 1, At, B1); PG8_BAR; PG8_SCHED;
            PG8_LDA(At, 1, 1); PG8_STAGE(PG8_SB(1, 0), b3, voffB); PG8_STAGE(PG8_SB(1, 1), b3 + hstep, voffB); PG8_STAGEA(PG8_SA(1, 0), a3, 0, vS);
            PG8_WAIT_V(8); PG8_WAIT_L(0); PG8_BAR; PG8_MMA(1, 0, At, B0); PG8_MMA(1, 1, At, B1); PG8_BAR; PG8_SCHED;
            } else {
            PG8_LDB(B0, 0, 0); PG8_SCHED; PG8_LDA(At, 0, 0); PG8_STAGE(PG8_SA(1, 1), a1 + hstep, voffA);
            PG8_WAIT_L(8); PG8_BAR; PG8_WAIT_L(0); PG8_MMA(0, 0, At, B0); PG8_BAR; PG8_SCHED;
            PG8_LDB(B1, 0, 1); PG8_STAGE(PG8_SB(0, 0), b2, voffB);
            PG8_BAR; PG8_WAIT_L(0); PG8_MMA(0, 1, At, B1); PG8_BAR;
            PG8_LDA(At, 0, 1); PG8_STAGE(PG8_SA(0, 0), a2, voffA);
            PG8_BAR; PG8_WAIT_L(0); PG8_MMA(1, 0, At, B0); PG8_BAR; PG8_SCHED;
            PG8_STAGE(PG8_SB(0, 1), b2 + hstep, voffB);
            PG8_WAIT_V(6); PG8_BAR; PG8_MMA(1, 1, At, B1); PG8_BAR;
            PG8_LDB(B0, 1, 0); PG8_SCHED; PG8_LDA(At, 1, 0); PG8_STAGE(PG8_SA(0, 1), a2 + hstep, voffA);
            PG8_WAIT_L(8); PG8_BAR; PG8_WAIT_L(0); PG8_MMA(0, 0, At, B0); PG8_BAR; PG8_SCHED;
            PG8_LDB(B1, 1, 1); PG8_STAGE(PG8_SB(1, 0), b3, voffB);
            PG8_BAR; PG8_WAIT_L(0); PG8_MMA(0, 1, At, B1); PG8_BAR;
            PG8_LDA(At, 1, 1); PG8_STAGE(PG8_SA(1, 0), a3, voffA);
            PG8_BAR; PG8_WAIT_L(0); PG8_MMA(1, 0, At, B0); PG8_BAR; PG8_SCHED;
            PG8_STAGE(PG8_SB(1, 1), b3 + hstep, voffB);
            PG8_WAIT_V(6); PG8_BAR; PG8_MMA(1, 1, At, B1); PG8_BAR;
            }
        }
        if constexpr (ALIGN_EPI) { if (wr == 0) PG8_BAR; }
        if constexpr (!Epi::AFTER_DRAIN) { E(acc, cur, wr, wc, fr, fq); S.done(cur); }
        if (!has_next) break;
        if constexpr (!Epi::CHAIN) {
#pragma unroll
        for (int a = 0; a < 2; ++a)
#pragma unroll
            for (int b = 0; b < 2; ++b)
#pragma unroll
                for (int m = 0; m < 4; ++m)
#pragma unroll
                    for (int n = 0; n < 2; ++n) acc[a][b][m][n] = (f32x4){0.f, 0.f, 0.f, 0.f};
        }
        cur = nxt; cA = nA; cB = nB; ++ui;
        if constexpr (GATHER) {
#pragma unroll
            for (int h = 0; h < 2; ++h)
#pragma unroll
                for (int i = 0; i < 2; ++i) vC[h][i] = vN[h][i]; }
        if constexpr (ALIGN_EPI) { if (wr == 1) PG8_BAR; }
    }
    PG8_WAIT_V(0);
    if constexpr (!ALIGN_EPI) { if (wr == 0) PG8_BAR; }
    PG8_BAR;
    if constexpr (Epi::AFTER_DRAIN) { E.fused(acc, cur, wr, wc, fr, fq, lds, wid, lane); S.done(cur); }
#undef PG8_SA
#undef PG8_SB
#undef PG8_STAGE
#undef PG8_STAGEA
#undef PG8_LDA
#undef PG8_LDB
#undef PG8_MMA
#undef PG8_WAIT_V
#undef PG8_WAIT_L
#undef PG8_BAR
#undef PG8_SCHED
}
}

namespace pg8 {
__device__ __forceinline__ void map_tile(int L, int nM, int nN, int& pm, int& pn) {
    const int nwg = nM * nN; int wgid = L;
    { const int q = nwg / NXCD, r = nwg % NXCD, xcd = wgid % NXCD, off = wgid / NXCD; wgid = (xcd < r ? xcd * (q + 1) : r * (q + 1) + (xcd - r) * q) + off; }
    const int nig = WGM * nN, gid = wgid / nig, fm = gid * WGM, gsz = (nM - fm) < WGM ? (nM - fm) : WGM;
    pm = fm + ((wgid % nig) % gsz); pn = (wgid % nig) / gsz;
}
struct PlainOrder {
    int nM, nN, G, c;
    __device__ __forceinline__ bool next(int i, Unit& u) const { const long L = (long)i * G + c; if (L >= (long)nM * nN) return false; map_tile((int)L, nM, nN, u.pm, u.pn); u.aux = u.pn; return true; }
    __device__ __forceinline__ void a_ready(const Unit&) const {}
    __device__ __forceinline__ void done(const Unit&) const {}
};
struct MergeOrder {
    int nM, G, c;
    __device__ __forceinline__ bool next(int i, Unit& u) const { const int tr = i / 3, n = i - 3 * tr; const long L = (long)tr * G + c; if (L >= (long)nM * 4) return false;
        int pm, pn; map_tile((int)L, nM, 4, pm, pn); u.pm = n * (R / 256) + pm; u.pn = n * 4 + pn; u.aux = n; return true; }
    __device__ __forceinline__ void a_ready(const Unit&) const {}
    __device__ __forceinline__ void done(const Unit&) const {}
};
struct MoeOrder {
    int PM, nN, G, c;
    __device__ __forceinline__ bool next(int i, Unit& u) const { const long L = (long)i * G + c; if (L >= (long)NE * PM * nN) return false;
        int pm, pn; map_tile((int)L, NE * PM, nN, pm, pn); const int e = pm / PM, p = pm - e * PM; u.pm = e * 17 + p; u.pn = e * nN + pn; u.aux = pn; return true; }
    __device__ __forceinline__ void a_ready(const Unit&) const {}
    __device__ __forceinline__ void done(const Unit&) const {}
};

__device__ __forceinline__ unsigned gate_q8x4(float a, float b, float c, float d) { const float sc = 255.9999f;
    return (unsigned)(a * sc) | ((unsigned)(b * sc) << 8) | ((unsigned)(c * sc) << 16) | ((unsigned)(d * sc) << 24); }
__device__ __forceinline__ float gate_c(unsigned w, int j) { return (float)((w >> (8 * j)) & 0xffu) + 0.5f; }
__device__ __forceinline__ float gate_dq(unsigned w, int j) { return (float)((w >> (8 * j)) & 0xffu) * 0.00390625f + 0.001953125f; }
struct EpiInProj {
    static constexpr bool PERM = false, AFTER_DRAIN = false, CHAIN = false;
    unsigned char* ws; const float *qn, *kn; unsigned* nrm;
    __device__ __forceinline__ void operator()(const f32x4 (&acc)[2][2][4][2], const Unit& u, int wr, int wc, int fr_, int fq_) const {
        int fr = fr_, fq = fq_; asm volatile("" : "+v"(fr), "+v"(fq));
        const int pn = u.pn;
        bf16_t* dst; int ld, colbase; bool kv = false, rope = false, gm = false; const float* gain = nullptr; float scale = 1.f; int act = 0, trk = -1; float nmx = 0.f;
        if (pn < 2)       { dst = (bf16_t*)(ws + WS_QA); ld = 512; colbase = pn * 256 + wc * 64; gain = qn; rope = true; scale = C2; }
        else if (pn == 2) { if (wc < 2) { dst = (bf16_t*)(ws + WS_KA); ld = 128; colbase = wc * 64; kv = true; gain = kn; rope = true; } else { dst = (bf16_t*)(ws + WS_VA); ld = 128; colbase = (wc - 2) * 64; kv = true; } }
        else if (pn < 5)  { dst = (bf16_t*)(ws + WS_XB); ld = 512; colbase = (pn - 3) * 256 + wc * 64; }
        else if (pn < 7)  { dst = (bf16_t*)(ws + WS_GB); ld = 512; colbase = (pn - 5) * 256 + wc * 64; act = 1; }
        else if (pn < 9)  { dst = (bf16_t*)(ws + WS_QC); ld = 512; colbase = (pn - 7) * 256 + wc * 64; rope = true; scale = C2; trk = 0; }
        else if (pn < 11) { dst = (bf16_t*)(ws + WS_KC); ld = 512; colbase = (pn - 9) * 256 + wc * 64; kv = true; rope = true; trk = 1; }
        else if (pn < 13) { dst = (bf16_t*)(ws + WS_VC); ld = 512; colbase = (pn - 11) * 256 + wc * 64; kv = true; }
        else              { dst = (bf16_t*)(ws + WS_GM); ld = 3072; colbase = (pn - 13) * 256 + wc * 32; act = 2; gm = true; }
#pragma unroll
        for (int ai = 0; ai < 2; ++ai)
#pragma unroll
            for (int m = 0; m < 4; ++m) {
                const int r = u.pm * BM + ai * HALF + wr * 64 + m * 16 + fr;
                f32x4 v[2][2];
#pragma unroll
                for (int bj = 0; bj < 2; ++bj)
#pragma unroll
                    for (int n = 0; n < 2; ++n) v[bj][n] = acc[ai][bj][m][n];
                if (gain) {
                    float ss = 0.f;
#pragma unroll
                    for (int bj = 0; bj < 2; ++bj)
#pragma unroll
                        for (int n = 0; n < 2; ++n) ss += (v[bj][n][0] * v[bj][n][0] + v[bj][n][1] * v[bj][n][1]) + (v[bj][n][2] * v[bj][n][2] + v[bj][n][3] * v[bj][n][3]);
                    ss += __shfl_xor(ss, 16); ss += __shfl_xor(ss, 32);
                    const float rinv = __builtin_amdgcn_rsqf(ss * (1.0f / 64.0f) + RMS_EPS);
#pragma unroll
                    for (int bj = 0; bj < 2; ++bj)
#pragma unroll
                        for (int n = 0; n < 2; ++n) v[bj][n] = v[bj][n] * rinv * *(const f32x4*)(gain + 32 * bj + 16 * n + 4 * fq);
                }
                if (rope && r < T) {
                    const int s = r & (SEQ - 1); const float pos[2] = {(float)(s >> 6), (float)(s & 63)};
#pragma unroll
                    for (int bj = 0; bj < 2; ++bj)
#pragma unroll
                        for (int j = 0; j < 4; ++j) {
                            const float invf = __builtin_amdgcn_exp2f(-(float)(4 * fq + j) * (13.287712379549449f / 16.0f)) * 0.15915494309189535f;
                            float rev = pos[bj] * invf; rev = rev - floorf(rev);
                            const float sn = __builtin_amdgcn_sinf(rev), cs = __builtin_amdgcn_cosf(rev);
                            const float x1 = v[bj][0][j], x2 = v[bj][1][j];
                            v[bj][0][j] = x1 * cs - x2 * sn; v[bj][1][j] = x2 * cs + x1 * sn;
                        }
                }
                if (trk >= 0) { float ss = 0.f;
#pragma unroll
                    for (int bj = 0; bj < 2; ++bj)
#pragma unroll
                        for (int n = 0; n < 2; ++n) ss += (v[bj][n][0] * v[bj][n][0] + v[bj][n][1] * v[bj][n][1]) + (v[bj][n][2] * v[bj][n][2] + v[bj][n][3] * v[bj][n][3]);
                    ss += __shfl_xor(ss, 16); ss += __shfl_xor(ss, 32); nmx = __builtin_fmaxf(nmx, ss); }
                size_t drow = (size_t)r;
                if (kv) { if (r < T) drow = (size_t)(r >> 13) * KVL + CTX + (r & (SEQ - 1)); else { const int jj = r - T; drow = (size_t)(jj >> 8) * KVL + (jj & 255); } }
                bf16_t* rowp = dst + drow * ld + colbase + 4 * fq;
                if (gm) {
                    unsigned char* gp = (unsigned char*)dst + drow * 3072 + colbase + 8 * fq;
#pragma unroll
                    for (int bj = 0; bj < 2; ++bj) { const f32x4 a0 = v[bj][0], a1 = v[bj][1];
                        v2u w; w.x = gate_q8x4(sigmoid_f(a0[0]), sigmoid_f(a0[1]), sigmoid_f(a0[2]), sigmoid_f(a0[3])); w.y = gate_q8x4(sigmoid_f(a1[0]), sigmoid_f(a1[1]), sigmoid_f(a1[2]), sigmoid_f(a1[3]));
                        *(v2u*)(gp + bj * HALF) = w; }
                } else
#pragma unroll
                for (int bj = 0; bj < 2; ++bj)
#pragma unroll
                    for (int n = 0; n < 2; ++n) {
                        f32x4 o = v[bj][n] * scale;
                        if (act == 1) { o[0] = gelu_tanh_f(o[0]); o[1] = gelu_tanh_f(o[1]); o[2] = gelu_tanh_f(o[2]); o[3] = gelu_tanh_f(o[3]); }
                        if (act == 2) { o[0] = sigmoid_f(o[0]); o[1] = sigmoid_f(o[1]); o[2] = sigmoid_f(o[2]); o[3] = sigmoid_f(o[3]); }
                        v2u w; w.x = cvt_pk_bf16(o[0], o[1]); w.y = cvt_pk_bf16(o[2], o[3]);
                        *(v2u*)(rowp + 32 * bj + 16 * n) = w;
                    }
                __builtin_amdgcn_sched_barrier(0);
            }
        if (trk >= 0) { nmx = __builtin_fmaxf(nmx, __shfl_xor(nmx, 1)); nmx = __builtin_fmaxf(nmx, __shfl_xor(nmx, 2)); nmx = __builtin_fmaxf(nmx, __shfl_xor(nmx, 4)); nmx = __builtin_fmaxf(nmx, __shfl_xor(nmx, 8));
            if (fr == 0 && fq == 0) (void)__hip_atomic_fetch_max(nrm + trk, __float_as_uint(nmx), __ATOMIC_RELAXED, __HIP_MEMORY_SCOPE_AGENT); }
    }
};

struct EpiMerge {
    static constexpr bool PERM = true, AFTER_DRAIN = false, CHAIN = true;
    const unsigned char* GMF; bf16_t* MM;
    __device__ __forceinline__ void operator()(f32x4 (&acc)[2][2][4][2], const Unit& u, int wr, int wc, int fr, int fq) const {
        const int nb = u.aux, pm = u.pm - nb * (R / 256), pn = u.pn - nb * 4;
        const unsigned char* gt = GMF + (size_t)(pm * BM + wr * 64 + fr) * 3072 + nb * 1024 + pn * BM + wc * 32 + 8 * fq;
        const int row0 = pm * BM + wr * 64 + fr, col0 = pn * BM + wc * 32 + 8 * fq;
        constexpr int PD = 6;
        v2u ga[PD], gb[PD];
#define MG_LOAD(k_, s_) do { const int ai_ = (k_) >> 3, m_ = ((k_) >> 1) & 3, bj_ = (k_) & 1; const unsigned char* q_ = gt + (size_t)(ai_ * HALF + m_ * 16) * 3072 + bj_ * HALF; \
            ga[s_] = *(const v2u*)q_; gb[s_] = nb < 2 ? *(const v2u*)(q_ + 1024) : (v2u){0u, 0u}; } while (0)
#pragma unroll
        for (int k = 0; k < PD; ++k) MG_LOAD(k, k);
#pragma unroll
        for (int k = 0; k < 16; ++k) { const int ai = k >> 3, m = (k >> 1) & 3, bj = k & 1, s = k % PD;
            const v2u gw = ga[s], hw = gb[s];
            asm volatile("" :: "v"(gw), "v"(hw));
            if (k + PD < 16) MG_LOAD(k + PD, s);
            f32x4 o0 = acc[ai][bj][m][0], o1 = acc[ai][bj][m][1];
            if (nb < 2) {
#pragma unroll
                for (int j = 0; j < 4; ++j) { o0[j] *= gate_c(gw.x, j) * __builtin_amdgcn_rcpf(gate_c(hw.x, j)); o1[j] *= gate_c(gw.y, j) * __builtin_amdgcn_rcpf(gate_c(hw.y, j)); }
                acc[ai][bj][m][0] = o0; acc[ai][bj][m][1] = o1;
            } else {
#pragma unroll
                for (int j = 0; j < 4; ++j) { o0[j] *= gate_dq(gw.x, j); o1[j] *= gate_dq(gw.y, j); }
                u32x4 w; w.x = cvt_pk_bf16(o0[0], o0[1]); w.y = cvt_pk_bf16(o0[2], o0[3]); w.z = cvt_pk_bf16(o1[0], o1[1]); w.w = cvt_pk_bf16(o1[2], o1[3]);
                *(u32x4*)(MM + (size_t)(row0 + ai * HALF + m * 16) * 1024 + col0 + bj * HALF) = w;
                acc[ai][bj][m][0] = (f32x4){0.f, 0.f, 0.f, 0.f}; acc[ai][bj][m][1] = (f32x4){0.f, 0.f, 0.f, 0.f}; }
        }
#undef MG_LOAD
    }
};

struct EpiF32 {
    static constexpr bool PERM = false, AFTER_DRAIN = false, CHAIN = false;
    float* C; int ldc;
    __device__ __forceinline__ void operator()(const f32x4 (&acc)[2][2][4][2], const Unit& u, int wr, int wc, int fr, int fq) const {
        const int row0 = u.pm * BM + wr * 64 + fr, col0 = u.pn * BM + wc * 32 + 4 * fq;
#pragma unroll
        for (int ai = 0; ai < 2; ++ai)
#pragma unroll
            for (int m = 0; m < 4; ++m) { float* rowp = C + (size_t)(row0 + ai * HALF + m * 16) * ldc + col0;
#pragma unroll
                for (int bj = 0; bj < 2; ++bj)
#pragma unroll
                    for (int n = 0; n < 2; ++n) *(f32x4*)(rowp + bj * HALF + n * 16) = acc[ai][bj][m][n]; }
    }
};

struct EpiGateUp {
    static constexpr bool PERM = true, AFTER_DRAIN = false, CHAIN = false;
    bf16_t* ACT;
    __device__ __forceinline__ void operator()(const f32x4 (&acc)[2][2][4][2], const Unit& u, int wr, int wc, int fr, int fq) const {
        const int row0 = u.pm * BM + wr * 64 + fr, col0 = u.aux * 128 + wc * 32 + 8 * fq;
#pragma unroll
        for (int ai = 0; ai < 2; ++ai)
#pragma unroll
            for (int m = 0; m < 4; ++m) { bf16_t* rowp = ACT + (size_t)(row0 + ai * HALF + m * 16) * FFP + col0;
                const f32x4 g0 = acc[ai][0][m][0], g1 = acc[ai][0][m][1], u0 = acc[ai][1][m][0], u1 = acc[ai][1][m][1];
                u32x4 w; w.x = cvt_pk_bf16(silu_f(g0[0]) * u0[0], silu_f(g0[1]) * u0[1]); w.y = cvt_pk_bf16(silu_f(g0[2]) * u0[2], silu_f(g0[3]) * u0[3]);
                w.z = cvt_pk_bf16(silu_f(g1[0]) * u1[0], silu_f(g1[1]) * u1[1]); w.w = cvt_pk_bf16(silu_f(g1[2]) * u1[2], silu_f(g1[3]) * u1[3]);
                *(u32x4*)rowp = w; }
    }
};

__device__ __forceinline__ float clamp448(float x) { return __builtin_fminf(__builtin_fmaxf(x, -448.0f), 448.0f); }
__device__ __forceinline__ unsigned pk_fp8x4(float a, float b, float c, float d) { int w = 0; w = __builtin_amdgcn_cvt_pk_fp8_f32(clamp448(a), clamp448(b), w, false); w = __builtin_amdgcn_cvt_pk_fp8_f32(clamp448(c), clamp448(d), w, true); return (unsigned)w; }
struct EpiGateUp8 {
    static constexpr bool PERM = true, AFTER_DRAIN = false, CHAIN = false;
    unsigned char* ACT; float descale;
    __device__ __forceinline__ void operator()(const f32x4 (&acc)[2][2][4][2], const Unit& u, int wr, int wc, int fr, int fq) const {
        const int row0 = u.pm * BM + wr * 64 + fr, col0 = u.aux * 128 + wc * 32 + 8 * fq;
#pragma unroll
        for (int ai = 0; ai < 2; ++ai)
#pragma unroll
            for (int m = 0; m < 4; ++m) { unsigned char* rowp = ACT + (size_t)(row0 + ai * HALF + m * 16) * FFP + col0;
                const f32x4 g0 = acc[ai][0][m][0] * descale, g1 = acc[ai][0][m][1] * descale, u0 = acc[ai][1][m][0] * descale, u1 = acc[ai][1][m][1] * descale;
                v2u w; w.x = pk_fp8x4(silu_f(g0[0]) * u0[0], silu_f(g0[1]) * u0[1], silu_f(g0[2]) * u0[2], silu_f(g0[3]) * u0[3]);
                w.y = pk_fp8x4(silu_f(g1[0]) * u1[0], silu_f(g1[1]) * u1[1], silu_f(g1[2]) * u1[2], silu_f(g1[3]) * u1[3]);
                *(v2u*)rowp = w; }
    }
};

struct EpiGate8 {
    static constexpr bool PERM = false, AFTER_DRAIN = false, CHAIN = false;
    unsigned char* GM; float descale;
    __device__ __forceinline__ void operator()(const f32x4 (&acc)[2][2][4][2], const Unit& u, int wr, int wc, int fr, int fq) const {
        const int row0 = u.pm * BM + wr * 64 + fr, col0 = u.pn * BM + wc * 32 + 8 * fq;
#pragma unroll
        for (int ai = 0; ai < 2; ++ai)
#pragma unroll
            for (int m = 0; m < 4; ++m) { unsigned char* rowp = GM + (size_t)(row0 + ai * HALF + m * 16) * 3072 + col0;
#pragma unroll
                for (int bj = 0; bj < 2; ++bj) { const f32x4 a0 = acc[ai][bj][m][0], a1 = acc[ai][bj][m][1];
                    const float ce = -1.4426950408889634f * descale, cq = 1.0f / 255.999f;
                    unsigned q0[4], q1[4];
#pragma unroll
                    for (int j = 0; j < 4; ++j) { q0[j] = (unsigned)__builtin_amdgcn_rcpf(__builtin_fmaf(__builtin_amdgcn_exp2f(a0[j] * ce), cq, cq)); q1[j] = (unsigned)__builtin_amdgcn_rcpf(__builtin_fmaf(__builtin_amdgcn_exp2f(a1[j] * ce), cq, cq)); }
                    v2u w; w.x = q0[0] | (q0[1] << 8) | (q0[2] << 16) | (q0[3] << 24); w.y = q1[0] | (q1[1] << 8) | (q1[2] << 16) | (q1[3] << 24);
                    *(v2u*)(rowp + bj * HALF) = w; }
                __builtin_amdgcn_sched_barrier(0); }
    }
};

struct EpiBf16Out {
    static constexpr bool PERM = true, AFTER_DRAIN = false, CHAIN = false;
    bf16_t* O; int ldc; float scale;
    __device__ __forceinline__ void operator()(const f32x4 (&acc)[2][2][4][2], const Unit& u, int wr, int wc, int fr, int fq) const {
        const int row0 = u.pm * BM + wr * 64 + fr, col0 = u.aux * BM + wc * 32 + 8 * fq;
#pragma unroll
        for (int ai = 0; ai < 2; ++ai)
#pragma unroll
            for (int m = 0; m < 4; ++m) { bf16_t* rowp = O + (size_t)(row0 + ai * HALF + m * 16) * ldc + col0;
#pragma unroll
                for (int bj = 0; bj < 2; ++bj) { const f32x4 v0 = acc[ai][bj][m][0] * scale, v1 = acc[ai][bj][m][1] * scale;
                    u32x4 w; w.x = cvt_pk_bf16(v0[0], v0[1]); w.y = cvt_pk_bf16(v0[2], v0[3]); w.z = cvt_pk_bf16(v1[0], v1[1]); w.w = cvt_pk_bf16(v1[2], v1[3]);
                    *(u32x4*)(rowp + bj * HALF) = w; } }
    }
};
}
namespace attn_body {
using bf16=__hip_bfloat16;
using bf16x8=__attribute__((ext_vector_type(8)))short;
using s16x4=__attribute__((ext_vector_type(4)))short;
using f32x16=__attribute__((ext_vector_type(16)))float;
using u32x4=__attribute__((ext_vector_type(4)))unsigned;
constexpr int D=64;
constexpr int NW=8,QBLK=32,QB=QBLK*NW,KVBLK=64;
constexpr int ATTN_UNIT_ROWS=QB;
__device__ __forceinline__ int crow(int r,int hi){return (r&3)+8*(r>>2)+4*hi;}
#define SBAR() __builtin_amdgcn_sched_barrier(0)
constexpr int NSLOT=3, SLOTB=8192;
constexpr int LDS_K=0, LDS_V=NSLOT*SLOTB, LDS_WS=2*NSLOT*SLOTB, LDS_OST=LDS_WS+NW*64*4, LDS_BYTES=LDS_OST+NW*4096;
__device__ __forceinline__ void glds16(const void*gsrc,unsigned lds_dst){unsigned keep;
  asm volatile("s_mov_b32 %0, m0\n\ts_mov_b32 m0, %2\n\ts_nop 0\n\tglobal_load_lds_dwordx4 %1, off\n\ts_mov_b32 m0, %0":"=&s"(keep):"v"(gsrc),"s"(lds_dst):"memory");}
__device__ __forceinline__ float max3f(float a,float b,float c){float r;asm("v_max3_f32 %0, %1, %2, %3":"=v"(r):"v"(a),"v"(b),"v"(c));return r;}
__device__ __forceinline__ float max2f(float a,float b){float r;asm("v_max_f32_e32 %0, %1, %2":"=v"(r):"v"(a),"v"(b));return r;}
__device__ __forceinline__ float fadd_s(float a,float b){float r;asm("v_add_f32_e32 %0, %1, %2":"=v"(r):"v"(a),"v"(b));return r;}
__device__ __forceinline__ float fsub_s(float a,float b){float r;asm("v_sub_f32_e32 %0, %1, %2":"=v"(r):"v"(a),"v"(b));return r;}
typedef float f32x2_t __attribute__((ext_vector_type(2))); typedef __bf16 bf16x2_t __attribute__((ext_vector_type(2)));
__device__ __forceinline__ unsigned cvtpk_s(float lo,float hi){f32x2_t v={lo,hi};bf16x2_t b=__builtin_convertvector(v,bf16x2_t);return __builtin_bit_cast(unsigned,b);}
#define WAIT_BAR(N) asm volatile("s_waitcnt vmcnt(" #N ") lgkmcnt(0)\n\ts_barrier":::"memory")

__device__ __forceinline__ void qkt(f32x16&p0,f32x16&p1,const char*Kslot,const bf16x8*qr,const f32x16&negm,int r32,int hi){
  const char*kb=Kslot+hi*1024+r32*16;
  #pragma unroll
  for(int d0=0;d0<4;++d0){
    const bf16x8 b0=*reinterpret_cast<const bf16x8*>(kb+d0*2048);
    const bf16x8 b1=*reinterpret_cast<const bf16x8*>(kb+d0*2048+512);
    if(d0==0){p0=__builtin_amdgcn_mfma_f32_32x32x16_bf16(b0,qr[0],negm,0,0,0);p1=__builtin_amdgcn_mfma_f32_32x32x16_bf16(b1,qr[0],negm,0,0,0);}
    else{p0=__builtin_amdgcn_mfma_f32_32x32x16_bf16(b0,qr[d0],p0,0,0,0);p1=__builtin_amdgcn_mfma_f32_32x32x16_bf16(b1,qr[d0],p1,0,0,0);}}
}
typedef __attribute__((address_space(3))) const char* lds_cptr;
typedef short v4i16_t __attribute__((ext_vector_type(4)));
__device__ __forceinline__ void kload8(bf16x8*kf,lds_cptr kp){
  kf[0]=*(const __attribute__((address_space(3))) bf16x8*)(kp);      kf[1]=*(const __attribute__((address_space(3))) bf16x8*)(kp+512);
  kf[2]=*(const __attribute__((address_space(3))) bf16x8*)(kp+2048); kf[3]=*(const __attribute__((address_space(3))) bf16x8*)(kp+2560);
  kf[4]=*(const __attribute__((address_space(3))) bf16x8*)(kp+4096); kf[5]=*(const __attribute__((address_space(3))) bf16x8*)(kp+4608);
  kf[6]=*(const __attribute__((address_space(3))) bf16x8*)(kp+6144); kf[7]=*(const __attribute__((address_space(3))) bf16x8*)(kp+6656);
}
__device__ __forceinline__ void kload2(bf16x8*kf,lds_cptr kp,int j){ kf[2*j]=*(const __attribute__((address_space(3))) bf16x8*)(kp+j*2048); kf[2*j+1]=*(const __attribute__((address_space(3))) bf16x8*)(kp+j*2048+512); }
__device__ __forceinline__ s16x4 vtr(lds_cptr p){ return __builtin_bit_cast(s16x4,__builtin_amdgcn_ds_read_tr16_b64_v4i16((__attribute__((address_space(3))) v4i16_t*)p)); }
__device__ __forceinline__ float rowmax(const f32x16&p0,const f32x16&p1){
  float a=max3f(p0[0],p0[1],p1[0]),b=max3f(p0[2],p0[3],p1[1]);a=max3f(a,p1[2],p1[3]);
  #pragma unroll
  for(int r=4;r<16;r+=4){a=max3f(a,p0[r],p0[r+1]);b=max3f(b,p0[r+2],p0[r+3]);a=max3f(a,p1[r],p1[r+1]);b=max3f(b,p1[r+2],p1[r+3]);}
  const float m=max2f(a,b);
  auto rr=__builtin_amdgcn_permlane32_swap(__float_as_uint(m),__float_as_uint(m),false,false);
  return max2f(__uint_as_float(rr[0]),__uint_as_float(rr[1]));
}
__device__ __forceinline__ void pv(f32x16*o,int vb,bf16x8 pa0,bf16x8 pa1,bf16x8 pa2,bf16x8 pa3){
  #pragma unroll
  for(int d0=0;d0<2;++d0){s16x4 lo[4],hi[4];
    #pragma unroll
    for(int ks=0;ks<4;++ks){
      asm volatile("ds_read_b64_tr_b16 %0,%1 offset:%c2":"=&v"(lo[ks]):"v"(vb),"i"(d0*4096+ks*1024):"memory");
      asm volatile("ds_read_b64_tr_b16 %0,%1 offset:%c2":"=&v"(hi[ks]):"v"(vb),"i"(d0*4096+ks*1024+512):"memory");}
    asm volatile("s_waitcnt lgkmcnt(0)":::"memory");SBAR();
    #define PK(k) (bf16x8){lo[k][0],lo[k][1],lo[k][2],lo[k][3],hi[k][0],hi[k][1],hi[k][2],hi[k][3]}
    o[d0]=__builtin_amdgcn_mfma_f32_32x32x16_bf16(pa0,PK(0),o[d0],0,0,0);
    o[d0]=__builtin_amdgcn_mfma_f32_32x32x16_bf16(pa1,PK(1),o[d0],0,0,0);
    o[d0]=__builtin_amdgcn_mfma_f32_32x32x16_bf16(pa2,PK(2),o[d0],0,0,0);
    o[d0]=__builtin_amdgcn_mfma_f32_32x32x16_bf16(pa3,PK(3),o[d0],0,0,0);
    #undef PK
  }
}

#ifndef ATTN_STORE16
#define ATTN_STORE16(p,v) (*(u32x4*)(p)=(v))
#endif
template<int THRL,bool NOMAX=false> __device__ __forceinline__ void attn_unit(const bf16*Qu,int qp,const bf16*__restrict__ Kh,int kp,const bf16*__restrict__ Vh,int vp,bf16*Ou,int op,int NT,char*shm,int tid_in){
  int tid_=tid_in; asm volatile("":"+v"(tid_));
  const int tid=tid_,lane=tid&63,r32=lane&31,hi=lane>>5; const int wid=__builtin_amdgcn_readfirstlane(tid>>6);
  const bf16*Qw=Qu+(long)(wid*QBLK)*qp;
  const unsigned lds0=(unsigned)(uintptr_t)shm;
  float*wsf=(float*)(shm+LDS_WS)+wid*64;
  const bf16*ksrc=Kh+(long)lane*kp+wid*8;
  const bf16*vsrc=Vh+(long)(16*(wid&3)+(lane>>2))*vp+(wid>>2)*32+(lane&3)*8;
  const unsigned kdst=lds0+LDS_K+wid*1024, vdst=lds0+LDS_V+wid*1024;
  #define DMA_K(t,slot) glds16(ksrc+(long)(t)*KVBLK*kp,(unsigned)__builtin_amdgcn_readfirstlane(kdst+(slot)))
  #define DMA_V(t,slot) glds16(vsrc+(long)(t)*KVBLK*vp,(unsigned)__builtin_amdgcn_readfirstlane(vdst+(slot)))
  const int vb0=(int)(lds0+LDS_V)+((lane>>4)&1)*32+(lane&3)*8+(4*hi+((lane&15)>>2))*64;
  const char*Kbase=shm+LDS_K; bf16x8 kf[8];
  const lds_cptr shm3=(lds_cptr)shm; const lds_cptr kp0=shm3+LDS_K+hi*1024+r32*16; const lds_cptr vp0=shm3+LDS_V+((lane>>4)&1)*32+(lane&3)*8+(4*hi+((lane&15)>>2))*64;
  DMA_K(0,0);DMA_V(0,0);DMA_K(1,SLOTB);
  bf16x8 qr[4];
  #pragma unroll
  for(int d0=0;d0<4;++d0)qr[d0]=*reinterpret_cast<const bf16x8*>(&Qw[(long)r32*qp+d0*16+hi*8]);
  float mhat=0.f,l_reg=0.f;f32x16 o[2];o[0]=f32x16{};o[1]=f32x16{};f32x16 negm=f32x16{};asm volatile("":"+v"(negm));
  #define CMASK(P0,P1,t) do{}while(0)
  bool resc=false;
  #define START(P0,P1) do{ resc=false; if constexpr(!NOMAX){ const float rm=rowmax(P0,P1); \
    { const float dl=rm; mhat=fadd_s(mhat,dl); \
      _Pragma("unroll") for(int r=0;r<16;++r){P0[r]=fsub_s(P0[r],dl);P1[r]=fsub_s(P1[r],dl);} \
      _Pragma("unroll") for(int r=0;r<16;++r)negm[r]=-mhat; asm volatile("":"+v"(negm)); } } \
    _Pragma("unroll") for(int r=0;r<16;++r)P0[r]=__builtin_amdgcn_exp2f(P0[r]); }while(0)
  #define RESC() do{ if(resc){ asm volatile("s_waitcnt lgkmcnt(0)":::"memory"); \
      _Pragma("unroll") for(int d_=0;d_<2;++d_) _Pragma("unroll") for(int r=0;r<16;++r)o[d_][r]*=wsf[crow(r,hi)]; } }while(0)
  f32x16 pA0,pA1,pB0,pB1;
  int sl_prev=0,sl_cur=0,sl_next=SLOTB;
  #define ROT() do{sl_prev=sl_cur;sl_cur=sl_next;sl_next=(sl_next==(NSLOT-1)*SLOTB)?0:sl_next+SLOTB;}while(0)
  DMA_K(2,2*SLOTB);
  WAIT_BAR(3);
  qkt(pA0,pA1,Kbase,qr,negm,r32,hi);asm volatile("s_nop 15\n\ts_nop 7":"+v"(pA0),"+v"(pA1));CMASK(pA0,pA1,0);
  START(pA0,pA1);
  _Pragma("unroll") for(int r=0;r<16;++r)pA1[r]=__builtin_amdgcn_exp2f(pA1[r]);
  WAIT_BAR(0);
  DMA_K(3,0);DMA_V(1,SLOTB);
  ROT();
  kload8(kf,kp0+sl_cur);
  WAIT_BAR(2);
  s16x4 vlo[8],vhi[8]; u32x4 pw0,pw1,pw2,pw3;
  #define PKW(P,B) cvtpk_s(P[B],P[B+1])
  #define PAF(k) __builtin_bit_cast(bf16x8,pw##k)
  #define VFR(i) (bf16x8){vlo[i][0],vlo[i][1],vlo[i][2],vlo[i][3],vhi[i][0],vhi[i][1],vhi[i][2],vhi[i][3]}
  #define PIN(x) asm volatile("":"+v"(x))
  #define MX3(a,b,c) __builtin_fmaxf(__builtin_fmaxf((a),(b)),(c))
  #define GAPA(MF,A0,A1,A2,A3,W0,W1,PW) do{ MF; sacc+=A0; sacc+=A1; sacc+=A2; sacc+=A3; PIN(sacc); W0; W1; PIN(PW); SBAR(); }while(0)
  #define EX(v) __builtin_amdgcn_exp2f(v)
  #define GAPB(MF,X,B) do{ MF; X[B]=EX(X[B]); X[B+1]=EX(X[B+1]); X[B+2]=EX(X[B+2]); X[B+3]=EX(X[B+3]); PIN(X); SBAR(); }while(0)
  #define VRD(i) do{ vlo[i]=vtr(vp_+(((i)>>2)*4096+((i)&3)*1024)); vhi[i]=vtr(vp_+(((i)>>2)*4096+((i)&3)*1024+512)); }while(0)
  #define KRD(G,j) do{ if(G){ kload2(kf,kp0+sl_next,j); SBAR(); } }while(0)
  #define STEP(C0,C1,P0,P1,t,GK,GV,GL) do{ SBAR(); \
    const lds_cptr vp_=vp0+sl_prev; \
    VRD(0); SBAR(); float sacc=(P0[0]+P0[1]); \
    GAPA(C0=__builtin_amdgcn_mfma_f32_32x32x16_bf16(kf[0],qr[0],negm,0,0,0), P0[2],P0[3],P0[4],P0[5],     pw0[0]=PKW(P0,0), pw0[1]=PKW(P0,2), pw0); \
    VRD(4); SBAR(); GAPA(C1=__builtin_amdgcn_mfma_f32_32x32x16_bf16(kf[1],qr[0],negm,0,0,0), P0[6],P0[7],P0[8],P0[9],     pw0[2]=PKW(P0,4), pw0[3]=PKW(P0,6), pw0); \
    VRD(1); SBAR(); GAPA(C0=__builtin_amdgcn_mfma_f32_32x32x16_bf16(kf[2],qr[1],C0,0,0,0),   P0[10],P0[11],P0[12],P0[13], pw1[0]=PKW(P0,8), pw1[1]=PKW(P0,10), pw1); \
    VRD(5); SBAR(); GAPA(C1=__builtin_amdgcn_mfma_f32_32x32x16_bf16(kf[3],qr[1],C1,0,0,0),   P0[14],P0[15],P1[0],P1[1],   pw1[2]=PKW(P0,12),pw1[3]=PKW(P0,14), pw1); \
    VRD(2); SBAR(); GAPA(C0=__builtin_amdgcn_mfma_f32_32x32x16_bf16(kf[4],qr[2],C0,0,0,0),   P1[2],P1[3],P1[4],P1[5],     pw2[0]=PKW(P1,0), pw2[1]=PKW(P1,2), pw2); \
    VRD(6); SBAR(); GAPA(C1=__builtin_amdgcn_mfma_f32_32x32x16_bf16(kf[5],qr[2],C1,0,0,0),   P1[6],P1[7],P1[8],P1[9],     pw2[2]=PKW(P1,4), pw2[3]=PKW(P1,6), pw2); \
    VRD(3); SBAR(); GAPA(C0=__builtin_amdgcn_mfma_f32_32x32x16_bf16(kf[6],qr[3],C0,0,0,0),   P1[10],P1[11],P1[12],P1[13], pw3[0]=PKW(P1,8), pw3[1]=PKW(P1,10), pw3); \
    VRD(7); SBAR(); GAPA(C1=__builtin_amdgcn_mfma_f32_32x32x16_bf16(kf[7],qr[3],C1,0,0,0),   P1[14],P1[15],0.f,0.f,       pw3[2]=PKW(P1,12),pw3[3]=PKW(P1,14), pw3); \
    l_reg+=sacc; \
    if(GK){DMA_K((t)+3,sl_cur);} if(GV){DMA_V((t)+1,sl_next);} \
    CMASK(C0,C1,t); \
    if constexpr(!NOMAX){ float a=MX3(C0[0],C0[1],C1[0]),b=MX3(C0[2],C0[3],C1[1]); a=MX3(a,C1[2],C1[3]); \
      _Pragma("unroll") for(int r=4;r<16;r+=4){a=MX3(a,C0[r],C0[r+1]);b=MX3(b,C0[r+2],C0[r+3]);a=MX3(a,C1[r],C1[r+1]);b=MX3(b,C1[r+2],C1[r+3]);} \
      float rm=__builtin_fmaxf(a,b); { auto rr=__builtin_amdgcn_permlane32_swap(__float_as_uint(rm),__float_as_uint(rm),false,false); rm=__builtin_fmaxf(__uint_as_float(rr[0]),__uint_as_float(rr[1])); } \
      resc=false; \
      if(__builtin_expect(__any(rm>(float)THRL),0)){ const float dl=__builtin_fmaxf(rm,0.f); mhat+=dl; \
        _Pragma("unroll") for(int r=0;r<16;++r){C0[r]-=dl;C1[r]-=dl;} \
        _Pragma("unroll") for(int r=0;r<16;++r)negm[r]=-mhat; asm volatile("":"+v"(negm)); \
        const float f=__builtin_amdgcn_exp2f(-dl); l_reg*=f; if(hi==0)wsf[r32]=f; resc=true; } } \
    SBAR(); \
    GAPB(o[0]=__builtin_amdgcn_mfma_f32_32x32x16_bf16(PAF(0),VFR(0),o[0],0,0,0), C0,0); \
    GAPB(o[1]=__builtin_amdgcn_mfma_f32_32x32x16_bf16(PAF(0),VFR(4),o[1],0,0,0), C0,4); \
    KRD(GL,0); GAPB(o[0]=__builtin_amdgcn_mfma_f32_32x32x16_bf16(PAF(1),VFR(1),o[0],0,0,0), C0,8); \
    KRD(GL,1); GAPB(o[1]=__builtin_amdgcn_mfma_f32_32x32x16_bf16(PAF(1),VFR(5),o[1],0,0,0), C0,12); \
    KRD(GL,2); GAPB(o[0]=__builtin_amdgcn_mfma_f32_32x32x16_bf16(PAF(2),VFR(2),o[0],0,0,0), C1,0); \
    KRD(GL,3); GAPB(o[1]=__builtin_amdgcn_mfma_f32_32x32x16_bf16(PAF(2),VFR(6),o[1],0,0,0), C1,4); \
    GAPB(o[0]=__builtin_amdgcn_mfma_f32_32x32x16_bf16(PAF(3),VFR(3),o[0],0,0,0), C1,8); \
    GAPB(o[1]=__builtin_amdgcn_mfma_f32_32x32x16_bf16(PAF(3),VFR(7),o[1],0,0,0), C1,12); \
    }while(0)
  if(NOMAX&&wid>=4)__builtin_amdgcn_s_setprio(1);
  int t=1;
  #undef CMASK
  #define CMASK(P0,P1,t) do{}while(0)
  for(;t+5<NT;t+=2){
    STEP(pB0,pB1,pA0,pA1,t,true,true,true);     WAIT_BAR(2); RESC(); ROT();
    STEP(pA0,pA1,pB0,pB1,t+1,true,true,true);   WAIT_BAR(2); RESC(); ROT();
  }
  #undef CMASK
  #define CMASK(P0,P1,t) do{}while(0)
  #define ENDW(tt) do{ if((tt)+3<NT){WAIT_BAR(2);} else if((tt)+2<NT){WAIT_BAR(1);} else {WAIT_BAR(0);} }while(0)
  for(;t+1<NT;t+=2){
    STEP(pB0,pB1,pA0,pA1,t,(t+3<NT),(t+1<NT),(t+1<NT));       ENDW(t);   RESC(); ROT();
    STEP(pA0,pA1,pB0,pB1,t+1,(t+4<NT),(t+2<NT),(t+2<NT));     ENDW(t+1); RESC(); ROT();
  }
  STEP(pB0,pB1,pA0,pA1,NT-1,false,false,false); RESC();
  if(NOMAX)__builtin_amdgcn_s_setprio(0);
  { float sacc=pB0[0]+pB0[1]; _Pragma("unroll") for(int r=2;r<16;++r)sacc+=pB0[r]; _Pragma("unroll") for(int r=0;r<16;++r)sacc+=pB1[r]; l_reg+=sacc;
    pw0=(u32x4){PKW(pB0,0),PKW(pB0,2),PKW(pB0,4),PKW(pB0,6)};pw1=(u32x4){PKW(pB0,8),PKW(pB0,10),PKW(pB0,12),PKW(pB0,14)};pw2=(u32x4){PKW(pB1,0),PKW(pB1,2),PKW(pB1,4),PKW(pB1,6)};pw3=(u32x4){PKW(pB1,8),PKW(pB1,10),PKW(pB1,12),PKW(pB1,14)};
    SBAR(); pv(o,vb0+sl_cur,PAF(0),PAF(1),PAF(2),PAF(3)); }
  #undef PKW
  #undef PAF
  #undef VFR
  #undef PIN
  #undef MX3
  #undef GAPA
  #undef GAPB
  #undef EX
  #undef VRD
  #undef KRD
  #undef STEP
  #undef ENDW
  {auto rr=__builtin_amdgcn_permlane32_swap(__float_as_uint(l_reg),__float_as_uint(l_reg),false,false);l_reg=__uint_as_float(rr[0])+__uint_as_float(rr[1]);}
  if(hi==0)wsf[32+r32]=l_reg;asm volatile("s_waitcnt lgkmcnt(0)":::"memory");
  float rli[16];
  #pragma unroll
  for(int r=0;r<16;++r)rli[r]=__builtin_amdgcn_rcpf(wsf[32+crow(r,hi)]);
  bf16*Ow=Ou+(long)(wid*QBLK)*op;
  { bf16*stg=(bf16*)(shm+LDS_OST)+wid*2048;
    #pragma unroll
    for(int r=0;r<16;++r){const int orow=crow(r,hi);
      #pragma unroll
      for(int d0=0;d0<2;++d0)stg[orow*64+d0*32+r32]=__float2bfloat16(o[d0][r]*rli[r]);}
    asm volatile("s_waitcnt lgkmcnt(0)":::"memory");
    #pragma unroll
    for(int i=0;i<4;++i){const int row=i*8+(lane>>3),ch=lane&7; const u32x4 v=*(const u32x4*)(stg+row*64+ch*8); ATTN_STORE16(Ow+(long)row*op+ch*8,v);} }
  asm volatile("s_waitcnt lgkmcnt(0)\n\ts_barrier":::"memory");
  #undef DMA_K
  #undef DMA_V
  #undef CMASK
  #undef START
  #undef RESC
  #undef ROT
}
constexpr int V2_LDS_K=0, V2_LDS_V=3*8192, V2_LDS_WS=V2_LDS_V+3*16384, V2_LDS_OST=V2_LDS_WS+NW*64*4, V2_LDS_BYTES=V2_LDS_OST+NW*4096;
__device__ __forceinline__ void qkt0(f32x16&p0,f32x16&p1,const char*Kslot,const bf16x8*qr,int r32,int hi){
  const char*kb=Kslot+hi*1024+r32*16; const f32x16 z=f32x16{};
  #pragma unroll
  for(int d0=0;d0<4;++d0){
    const bf16x8 b0=*reinterpret_cast<const bf16x8*>(kb+d0*2048);
    const bf16x8 b1=*reinterpret_cast<const bf16x8*>(kb+d0*2048+512);
    if(d0==0){p0=__builtin_amdgcn_mfma_f32_32x32x16_bf16(b0,qr[0],z,0,0,0);p1=__builtin_amdgcn_mfma_f32_32x32x16_bf16(b1,qr[0],z,0,0,0);}
    else{p0=__builtin_amdgcn_mfma_f32_32x32x16_bf16(b0,qr[d0],p0,0,0,0);p1=__builtin_amdgcn_mfma_f32_32x32x16_bf16(b1,qr[d0],p1,0,0,0);}}
}
__device__ __forceinline__ void pv4(f32x16*o,int vb,bf16x8 pa0,bf16x8 pa1,bf16x8 pa2,bf16x8 pa3){
  #pragma unroll
  for(int d0=0;d0<4;++d0){s16x4 lo[4],hi[4];
    #pragma unroll
    for(int ks=0;ks<4;++ks){
      asm volatile("ds_read_b64_tr_b16 %0,%1 offset:%c2":"=&v"(lo[ks]):"v"(vb),"i"(d0*4096+ks*1024):"memory");
      asm volatile("ds_read_b64_tr_b16 %0,%1 offset:%c2":"=&v"(hi[ks]):"v"(vb),"i"(d0*4096+ks*1024+512):"memory");}
    asm volatile("s_waitcnt lgkmcnt(0)":::"memory");SBAR();
    #define PK(k) (bf16x8){lo[k][0],lo[k][1],lo[k][2],lo[k][3],hi[k][0],hi[k][1],hi[k][2],hi[k][3]}
    o[d0]=__builtin_amdgcn_mfma_f32_32x32x16_bf16(pa0,PK(0),o[d0],0,0,0);
    o[d0]=__builtin_amdgcn_mfma_f32_32x32x16_bf16(pa1,PK(1),o[d0],0,0,0);
    o[d0]=__builtin_amdgcn_mfma_f32_32x32x16_bf16(pa2,PK(2),o[d0],0,0,0);
    o[d0]=__builtin_amdgcn_mfma_f32_32x32x16_bf16(pa3,PK(3),o[d0],0,0,0);
    #undef PK
  }
}
template<int THRL,bool NOMAX=false> __device__ __forceinline__ void attn_unit_v128(const bf16*Qu,int qp,const bf16*__restrict__ Kh,int kp,const bf16*__restrict__ Vh,int vp,bf16*Ou,int op,int NT,char*shm,int tid_in){
  int tid_=tid_in; asm volatile("":"+v"(tid_));
  const int tid=tid_,lane=tid&63,r32=lane&31,hi=lane>>5; const int wid=__builtin_amdgcn_readfirstlane(tid>>6);
  const bf16*Qw=Qu+(long)(wid*QBLK)*qp;
  const unsigned lds0=(unsigned)(uintptr_t)shm;
  float*wsf=(float*)(shm+V2_LDS_WS)+wid*64;
  const bf16*ksrc=Kh+(long)lane*kp+wid*8;
  const bf16*vsrc=Vh+(long)(16*(wid&3)+(lane>>2))*vp+(wid>>2)*32+(lane&3)*8;
  const unsigned kdst=lds0+V2_LDS_K+wid*1024, vdst=lds0+V2_LDS_V+wid*1024;
  #define DMA_K(t,slot) glds16(ksrc+(long)(t)*KVBLK*kp,(unsigned)__builtin_amdgcn_readfirstlane(kdst+(slot)))
  #define DMA_V(t,slot) do{ glds16(vsrc+(long)(t)*KVBLK*vp,(unsigned)__builtin_amdgcn_readfirstlane(vdst+2*(slot))); glds16(vsrc+64+(long)(t)*KVBLK*vp,(unsigned)__builtin_amdgcn_readfirstlane(vdst+2*(slot)+8192)); }while(0)
  const int vb0=(int)(lds0+V2_LDS_V)+((lane>>4)&1)*32+(lane&3)*8+(4*hi+((lane&15)>>2))*64;
  const char*Kbase=shm+V2_LDS_K; bf16x8 kf[8];
  const lds_cptr shm3=(lds_cptr)shm; const lds_cptr kp0=shm3+V2_LDS_K+hi*1024+r32*16; const lds_cptr vp0=shm3+V2_LDS_V+((lane>>4)&1)*32+(lane&3)*8+(4*hi+((lane&15)>>2))*64;
  DMA_K(0,0);DMA_V(0,0);DMA_K(1,SLOTB);
  bf16x8 qr[4];
  #pragma unroll
  for(int d0=0;d0<4;++d0)qr[d0]=*reinterpret_cast<const bf16x8*>(&Qw[(long)r32*qp+d0*16+hi*8]);
  float mhat=0.f,l_reg=0.f;f32x16 o[4];o[0]=f32x16{};o[1]=f32x16{};o[2]=f32x16{};o[3]=f32x16{};
  const f32x16 zero16=f32x16{};
  bool resc=false;
  #define START(P0,P1) do{ resc=false; if constexpr(NOMAX){ _Pragma("unroll") for(int r=0;r<16;++r){P0[r]=__builtin_amdgcn_exp2f(P0[r]);} } \
    else { const float rm=rowmax(P0,P1); mhat=rm; _Pragma("unroll") for(int r=0;r<16;++r){P0[r]=__builtin_amdgcn_exp2f(fsub_s(P0[r],mhat));} } }while(0)
  #define RESC() do{ if(resc){ asm volatile("s_waitcnt lgkmcnt(0)":::"memory"); \
      _Pragma("unroll") for(int d_=0;d_<4;++d_) _Pragma("unroll") for(int r=0;r<16;++r)o[d_][r]*=wsf[crow(r,hi)]; } }while(0)
  f32x16 pA0,pA1,pB0,pB1;
  int sl_prev=0,sl_cur=0,sl_next=SLOTB;
  #define ROT() do{sl_prev=sl_cur;sl_cur=sl_next;sl_next=(sl_next==(NSLOT-1)*SLOTB)?0:sl_next+SLOTB;}while(0)
  DMA_K(2,2*SLOTB);
  WAIT_BAR(3);
  qkt0(pA0,pA1,Kbase,qr,r32,hi);asm volatile("s_nop 15\n\ts_nop 7":"+v"(pA0),"+v"(pA1));
  START(pA0,pA1);
  if constexpr(NOMAX){ _Pragma("unroll") for(int r=0;r<16;++r)pA1[r]=__builtin_amdgcn_exp2f(pA1[r]); } else { _Pragma("unroll") for(int r=0;r<16;++r)pA1[r]=__builtin_amdgcn_exp2f(fsub_s(pA1[r],mhat)); }
  WAIT_BAR(0);
  DMA_K(3,0);DMA_V(1,SLOTB);
  ROT();
  kload8(kf,kp0+sl_cur);
  WAIT_BAR(3);
  s16x4 vwl[5],vwh[5]; u32x4 pw0,pw1,pw2,pw3;
  #define PKW(P,B) cvtpk_s(P[B],P[B+1])
  #define PAF(k) __builtin_bit_cast(bf16x8,pw##k)
  #define VWF(s) (bf16x8){vwl[s][0],vwl[s][1],vwl[s][2],vwl[s][3],vwh[s][0],vwh[s][1],vwh[s][2],vwh[s][3]}
  #define PIN(x) asm volatile("":"+v"(x))
  #define MX3(a,b,c) __builtin_fmaxf(__builtin_fmaxf((a),(b)),(c))
  #define GAPA(MF,A0,A1,A2,A3,W0,W1,PW) do{ MF; sacc+=A0; sacc+=A1; sacc+=A2; sacc+=A3; PIN(sacc); W0; W1; PIN(PW); SBAR(); }while(0)
  #define EXS(v) (NOMAX?__builtin_amdgcn_exp2f(v):__builtin_amdgcn_exp2f((v)-mhat))
  #define GAPB(MF,X,B) do{ MF; X[B]=EXS(X[B]); X[B+1]=EXS(X[B+1]); PIN(X); SBAR(); }while(0)
  #define VRD(f,s) do{ vwl[s]=vtr(vp_+(((f)>>2)*4096+((f)&3)*1024)); vwh[s]=vtr(vp_+(((f)>>2)*4096+((f)&3)*1024+512)); }while(0)
  #define KRD(G,j) do{ if(G){ kload2(kf,kp0+sl_next,j); SBAR(); } }while(0)
  #define PVM(i) o[(i)&3]=__builtin_amdgcn_mfma_f32_32x32x16_bf16(PAF_SEL((i)>>2),VWF((i)%5),o[(i)&3],0,0,0)
  #define PAF_SEL(k) ((k)==0?PAF(0):(k)==1?PAF(1):(k)==2?PAF(2):PAF(3))
  #define VNEXT(i) do{ if((i)+5<16){ VRD((((i)+5)>>2)+4*(((i)+5)&3),(i)%5); SBAR(); } }while(0)
  #define STEP(C0,C1,P0,P1,t,GK,GV,GL) do{ SBAR(); \
    const lds_cptr vp_=vp0+2*sl_prev; \
    float sacc=(P0[0]+P0[1]); \
    GAPA(C0=__builtin_amdgcn_mfma_f32_32x32x16_bf16(kf[0],qr[0],zero16,0,0,0), P0[2],P0[3],P0[4],P0[5],     pw0[0]=PKW(P0,0), pw0[1]=PKW(P0,2), pw0); \
    GAPA(C1=__builtin_amdgcn_mfma_f32_32x32x16_bf16(kf[1],qr[0],zero16,0,0,0), P0[6],P0[7],P0[8],P0[9],     pw0[2]=PKW(P0,4), pw0[3]=PKW(P0,6), pw0); \
    GAPA(C0=__builtin_amdgcn_mfma_f32_32x32x16_bf16(kf[2],qr[1],C0,0,0,0),   P0[10],P0[11],P0[12],P0[13], pw1[0]=PKW(P0,8), pw1[1]=PKW(P0,10), pw1); \
    VRD(0,0); SBAR(); GAPA(C1=__builtin_amdgcn_mfma_f32_32x32x16_bf16(kf[3],qr[1],C1,0,0,0),   P0[14],P0[15],P1[0],P1[1],   pw1[2]=PKW(P0,12),pw1[3]=PKW(P0,14), pw1); \
    VRD(4,1); SBAR(); GAPA(C0=__builtin_amdgcn_mfma_f32_32x32x16_bf16(kf[4],qr[2],C0,0,0,0),   P1[2],P1[3],P1[4],P1[5],     pw2[0]=PKW(P1,0), pw2[1]=PKW(P1,2), pw2); \
    VRD(8,2); SBAR(); GAPA(C1=__builtin_amdgcn_mfma_f32_32x32x16_bf16(kf[5],qr[2],C1,0,0,0),   P1[6],P1[7],P1[8],P1[9],     pw2[2]=PKW(P1,4), pw2[3]=PKW(P1,6), pw2); \
    VRD(12,3); SBAR(); GAPA(C0=__builtin_amdgcn_mfma_f32_32x32x16_bf16(kf[6],qr[3],C0,0,0,0),   P1[10],P1[11],P1[12],P1[13], pw3[0]=PKW(P1,8), pw3[1]=PKW(P1,10), pw3); \
    VRD(1,4); SBAR(); GAPA(C1=__builtin_amdgcn_mfma_f32_32x32x16_bf16(kf[7],qr[3],C1,0,0,0),   P1[14],P1[15],0.f,0.f,       pw3[2]=PKW(P1,12),pw3[3]=PKW(P1,14), pw3); \
    l_reg+=sacc; \
    if(GK){DMA_K((t)+3,sl_cur);} if(GV){DMA_V((t)+1,sl_next);} \
    if constexpr(!NOMAX){ float a=MX3(C0[0],C0[1],C1[0]),b=MX3(C0[2],C0[3],C1[1]); a=MX3(a,C1[2],C1[3]); \
      _Pragma("unroll") for(int r=4;r<16;r+=4){a=MX3(a,C0[r],C0[r+1]);b=MX3(b,C0[r+2],C0[r+3]);a=MX3(a,C1[r],C1[r+1]);b=MX3(b,C1[r+2],C1[r+3]);} \
      float rm=__builtin_fmaxf(a,b); { auto rr=__builtin_amdgcn_permlane32_swap(__float_as_uint(rm),__float_as_uint(rm),false,false); rm=__builtin_fmaxf(__uint_as_float(rr[0]),__uint_as_float(rr[1])); } \
      resc=false; const float rel=rm-mhat; \
      if(__builtin_expect(__any(rel>(float)THRL),0)){ const float dl=__builtin_fmaxf(rel,0.f); mhat+=dl; \
        const float f=__builtin_amdgcn_exp2f(-dl); l_reg*=f; if(hi==0)wsf[r32]=f; resc=true; } } \
    SBAR(); \
    GAPB(PVM(0),C0,0);  VNEXT(0); \
    GAPB(PVM(1),C0,2);  VNEXT(1); \
    GAPB(PVM(2),C0,4);  VNEXT(2); \
    GAPB(PVM(3),C0,6);  VNEXT(3); \
    KRD(GL,0); GAPB(PVM(4),C0,8);  VNEXT(4); \
    GAPB(PVM(5),C0,10); VNEXT(5); \
    GAPB(PVM(6),C0,12); VNEXT(6); \
    KRD(GL,1); GAPB(PVM(7),C0,14); VNEXT(7); \
    GAPB(PVM(8),C1,0);  VNEXT(8); \
    GAPB(PVM(9),C1,2);  VNEXT(9); \
    KRD(GL,2); GAPB(PVM(10),C1,4); VNEXT(10); \
    GAPB(PVM(11),C1,6); \
    GAPB(PVM(12),C1,8); \
    KRD(GL,3); GAPB(PVM(13),C1,10); \
    GAPB(PVM(14),C1,12); \
    GAPB(PVM(15),C1,14); \
    }while(0)
  if(NOMAX&&wid>=4)__builtin_amdgcn_s_setprio(1);
  int t=1;
  for(;t+5<NT;t+=2){
    STEP(pB0,pB1,pA0,pA1,t,true,true,true);     WAIT_BAR(3); RESC(); ROT();
    STEP(pA0,pA1,pB0,pB1,t+1,true,true,true);   WAIT_BAR(3); RESC(); ROT();
  }
  #define ENDW(tt) do{ if((tt)+3<NT){WAIT_BAR(3);} else if((tt)+2<NT){WAIT_BAR(2);} else {WAIT_BAR(0);} }while(0)
  for(;t+1<NT;t+=2){
    STEP(pB0,pB1,pA0,pA1,t,(t+3<NT),(t+1<NT),(t+1<NT));       ENDW(t);   RESC(); ROT();
    STEP(pA0,pA1,pB0,pB1,t+1,(t+4<NT),(t+2<NT),(t+2<NT));     ENDW(t+1); RESC(); ROT();
  }
  STEP(pB0,pB1,pA0,pA1,NT-1,false,false,false); RESC();
  if(NOMAX)__builtin_amdgcn_s_setprio(0);
  { float sacc=pB0[0]+pB0[1]; _Pragma("unroll") for(int r=2;r<16;++r)sacc+=pB0[r]; _Pragma("unroll") for(int r=0;r<16;++r)sacc+=pB1[r]; l_reg+=sacc;
    pw0=(u32x4){PKW(pB0,0),PKW(pB0,2),PKW(pB0,4),PKW(pB0,6)};pw1=(u32x4){PKW(pB0,8),PKW(pB0,10),PKW(pB0,12),PKW(pB0,14)};pw2=(u32x4){PKW(pB1,0),PKW(pB1,2),PKW(pB1,4),PKW(pB1,6)};pw3=(u32x4){PKW(pB1,8),PKW(pB1,10),PKW(pB1,12),PKW(pB1,14)};
    SBAR(); pv4(o,vb0+2*sl_cur,PAF(0),PAF(1),PAF(2),PAF(3)); }
  #undef PKW
  #undef PAF
  #undef VWF
  #undef PIN
  #undef MX3
  #undef GAPA
  #undef GAPB
  #undef EXS
  #undef VRD
  #undef KRD
  #undef PVM
  #undef PAF_SEL
  #undef VNEXT
  #undef STEP
  #undef ENDW
  {auto rr=__builtin_amdgcn_permlane32_swap(__float_as_uint(l_reg),__float_as_uint(l_reg),false,false);l_reg=__uint_as_float(rr[0])+__uint_as_float(rr[1]);}
  if(hi==0)wsf[32+r32]=l_reg;asm volatile("s_waitcnt lgkmcnt(0)":::"memory");
  float rli[16];
  #pragma unroll
  for(int r=0;r<16;++r)rli[r]=__builtin_amdgcn_rcpf(wsf[32+crow(r,hi)]);
  bf16*Ow=Ou+(long)(wid*QBLK)*op;
  { bf16*stg=(bf16*)(shm+V2_LDS_OST)+wid*2048;
    #pragma unroll
    for(int rd=0;rd<2;++rd){
      #pragma unroll
      for(int r=0;r<16;++r){const int orow=crow(r,hi);
        #pragma unroll
        for(int d0=0;d0<2;++d0)stg[orow*64+d0*32+r32]=__float2bfloat16(o[2*rd+d0][r]*rli[r]);}
      asm volatile("s_waitcnt lgkmcnt(0)":::"memory");
      #pragma unroll
      for(int i=0;i<4;++i){const int row=i*8+(lane>>3),ch=lane&7; const u32x4 v=*(const u32x4*)(stg+row*64+ch*8); ATTN_STORE16(Ow+(long)row*op+rd*64+ch*8,v);}
      asm volatile("s_waitcnt lgkmcnt(0)":::"memory"); } }
  asm volatile("s_waitcnt lgkmcnt(0)\n\ts_barrier":::"memory");
  #undef DMA_K
  #undef DMA_V
  #undef START
  #undef RESC
  #undef ROT
}
#undef SBAR
#undef WAIT_BAR
}
#define XB_TMO      128
#define XB_XCNT(j)  (256  + 64 * (j))
#define XB_XSUB(j)  (1280 + 64 * (j))
#define XB_XGEN(j)  (2304 + 64 * (j))
#define XB_TOP      3328
#define XB_TOPGEN   3392
#define XCD_BAR_WORDS 3456
#define XB_SPIN_CAP (1u << 18)

__device__ __forceinline__ unsigned xb_ld(unsigned* p)              { return __hip_atomic_load(p, __ATOMIC_RELAXED, __HIP_MEMORY_SCOPE_AGENT); }
__device__ __forceinline__ unsigned xb_add(unsigned* p, unsigned v) { return __hip_atomic_fetch_add(p, v, __ATOMIC_RELAXED, __HIP_MEMORY_SCOPE_AGENT); }
__device__ __forceinline__ unsigned xb_xcc_id() { return (unsigned)__builtin_amdgcn_s_getreg((3 << 11) | 20) & 0xFu; }
#define XB_SPIN(cond, bar) do { unsigned _sp = 0; while (cond) { __builtin_amdgcn_s_sleep(1); \
    if ((++_sp & 255u) == 0u) { if (xb_ld(&(bar)[XB_TMO])) break; if (_sp > XB_SPIN_CAP) { atomicAdd(&(bar)[XB_TMO], 1u); break; } } } } while (0)

struct XcdBarrier {
    unsigned* bar; unsigned x;
    volatile LAS unsigned* st;
};

__device__ __forceinline__ XcdBarrier xcd_barrier_post(unsigned* bar, volatile LAS unsigned* st, int tid) {
    XcdBarrier b; b.bar = bar; b.x = xb_xcc_id(); b.st = st;
    if (tid == 0) (void)xb_add(&bar[XB_XCNT(b.x)], 1u);
    return b;
}
__device__ __forceinline__ void xcd_barrier_complete(unsigned* bar, unsigned x, unsigned& nloc, unsigned& nx) {
    const unsigned G = gridDim.x * gridDim.y * gridDim.z;
    unsigned sum, cnt, mine, sp = 0u;
    for (;;) {
        sum = 0u; cnt = 0u; mine = 0u;
#pragma unroll
        for (unsigned j = 0; j < 16; ++j) { const unsigned c = xb_ld(&bar[XB_XCNT(j)]); sum += c; cnt += (c > 0u) ? 1u : 0u; mine = (j == x) ? c : mine; }
        if (sum == G) break;
        __builtin_amdgcn_s_sleep(1);
        if ((++sp & 255u) == 0u) { if (xb_ld(&bar[XB_TMO])) break; if (sp > XB_SPIN_CAP) { atomicAdd(&bar[XB_TMO], 1u); break; } }
    }
    nloc = mine > 0u ? mine : 1u; nx = cnt > 0u ? cnt : 1u;
}

__device__ __forceinline__ void xcd_barrier(const XcdBarrier& b, int tid) {
    asm volatile("s_waitcnt vmcnt(0)" ::: "memory");
    __syncthreads();
    if (tid == 0) {
        unsigned* bar = b.bar;
        __builtin_amdgcn_s_waitcnt(0);
        unsigned nloc = b.st[0], nx = b.st[1];
        if (nloc == 0u) { xcd_barrier_complete(bar, b.x, nloc, nx); b.st[0] = nloc; b.st[1] = nx; }
        const unsigned old = xb_add(&bar[XB_XSUB(b.x)], 1u);
        const unsigned gen = old / nloc;
        if (old + 1u == (gen + 1u) * nloc) {
            __builtin_amdgcn_fence(__ATOMIC_RELEASE, "agent");
            asm volatile("s_waitcnt vmcnt(0)" ::: "memory");
            const unsigned og = xb_add(&bar[XB_TOP], 1u);
            const unsigned tg = og / nx;
            if (og + 1u == (tg + 1u) * nx) xb_add(&bar[XB_TOPGEN], 1u);
            else XB_SPIN(xb_ld(&bar[XB_TOPGEN]) == tg, bar);
            __builtin_amdgcn_fence(__ATOMIC_ACQUIRE, "agent");
            xb_add(&bar[XB_XGEN(b.x)], 1u);
            asm volatile("s_waitcnt vmcnt(0)" ::: "memory");
        } else {
            XB_SPIN(xb_ld(&bar[XB_XGEN(b.x)]) == gen, bar);
            __builtin_amdgcn_fence(__ATOMIC_ACQUIRE, "agent");
            asm volatile("s_waitcnt vmcnt(0)" ::: "memory");
        }
    }
    __syncthreads();
}

struct Ctx { LAS unsigned char* lds; int tid, lane, wave, G, vcu; unsigned char* ws; };
struct Args { const float* in[28]; float* out; unsigned char* ws; int ph_lo, ph_hi, rep_mask, pad; };
typedef const __attribute__((address_space(4))) Args* CArgs;
__device__ __forceinline__ const float* inp(CArgs a, int i) { return (const float*)(GAS const float*)a->in[i]; }
enum { I_X = 0, I_C, I_CTX, I_CCTX, I_WADA, I_BADA, I_WIN, I_AQN, I_AKN, I_CONVW, I_CONVB, I_LWA, I_LBA, I_LWX, I_LBX, I_LLAM, I_DLAM, I_DSUB, I_WBR, I_WOUT, I_LN1G, I_LN1B, I_WR, I_WG, I_WU, I_WDN, I_LN2G, I_LN2B };

__device__ __forceinline__ void tr_item64(const float* W, int ldw, int k0, int n0, bf16* dst0, bf16* dst1, int pitch, LAS bf16* scr, int lane, bool permd = false) {
    f32x4 v[16];
    const float* src = W + (size_t)(k0 + (lane >> 4)) * ldw + n0 + 4 * (lane & 15);
#pragma unroll
    for (int i = 0; i < 16; ++i) v[i] = *(const f32x4*)(src + (size_t)(4 * i) * ldw);
#pragma unroll
    for (int i = 0; i < 16; ++i) { const unsigned p0 = cvt_pk_bf16(v[i][0], v[i][1]), p1 = cvt_pk_bf16(v[i][2], v[i][3]);
        LAS unsigned* q = (LAS unsigned*)(scr + (4 * i + (lane >> 4)) * 66 + 4 * (lane & 15)); q[0] = p0; q[1] = p1; }
    LDS_WAIT(); asm volatile("" ::: "memory");
    const int c = lane & 7;
#pragma unroll
    for (int j = 0; j < 8; ++j) { const int n = (lane >> 3) + 8 * j; const LAS bf16* t = scr + (8 * c) * 66 + n;
        v4u o; o.x = (unsigned)t[0] | ((unsigned)t[66] << 16); o.y = (unsigned)t[2 * 66] | ((unsigned)t[3 * 66] << 16);
        o.z = (unsigned)t[4 * 66] | ((unsigned)t[5 * 66] << 16); o.w = (unsigned)t[6 * 66] | ((unsigned)t[7 * 66] << 16);
        const int nl = n & 31, nr = permd ? (16 * ((nl >> 2) & 1) + 4 * (nl >> 3) + (nl & 3)) : nl;
        bf16* d = ((j < 4) ? dst0 : dst1) + (size_t)nr * pitch;
        *(GAS v4u*)(d + 8 * c) = o; }
    LDS_WAIT(); asm volatile("" ::: "memory");
}

__device__ __forceinline__ void tr_item64_f8(const float* W, int ldw, int k0, int n0, unsigned char* dst0, unsigned char* dst1, int pitch, float scale, LAS bf16* scr, int lane, bool permd = false) {
    f32x4 v[16];
    const float* src = W + (size_t)(k0 + (lane >> 4)) * ldw + n0 + 4 * (lane & 15);
#pragma unroll
    for (int i = 0; i < 16; ++i) v[i] = *(const f32x4*)(src + (size_t)(4 * i) * ldw);
#pragma unroll
    for (int i = 0; i < 16; ++i) { const unsigned p0 = cvt_pk_bf16(v[i][0], v[i][1]), p1 = cvt_pk_bf16(v[i][2], v[i][3]);
        LAS unsigned* q = (LAS unsigned*)(scr + (4 * i + (lane >> 4)) * 66 + 4 * (lane & 15)); q[0] = p0; q[1] = p1; }
    LDS_WAIT(); asm volatile("" ::: "memory");
    const int c = lane & 3;
#pragma unroll
    for (int j = 0; j < 4; ++j) { const int n = (lane >> 2) + 16 * j; const LAS bf16* t = scr + (16 * c) * 66 + n;
        float f[16];
#pragma unroll
        for (int q = 0; q < 16; ++q) f[q] = __uint_as_float((unsigned)t[q * 66] << 16) * scale;
        v4u o; o.x = pg8::pk_fp8x4(f[0], f[1], f[2], f[3]); o.y = pg8::pk_fp8x4(f[4], f[5], f[6], f[7]); o.z = pg8::pk_fp8x4(f[8], f[9], f[10], f[11]); o.w = pg8::pk_fp8x4(f[12], f[13], f[14], f[15]);
        const int nl8 = n & 31, nr8 = permd ? (16 * ((nl8 >> 2) & 1) + 4 * (nl8 >> 3) + (nl8 & 3)) : nl8;
        unsigned char* d = ((j < 2) ? dst0 : dst1) + (size_t)nr8 * pitch;
        *(GAS v4u*)(d + 16 * c) = o; }
    LDS_WAIT(); asm volatile("" ::: "memory");
}

struct CvItem { const float* src; unsigned voff; int ldw; unsigned char* d0; unsigned char* d1; int pitch; float scale; };
__device__ __forceinline__ void cv_load(f32x4 (&v)[16], const CvItem& c) {
#pragma unroll
    for (int i = 0; i < 16; ++i) v[i] = *(const f32x4*)((const char*)uni(c.src + (size_t)(4 * i) * c.ldw) + c.voff);
}
__device__ __forceinline__ void cv_finish(const f32x4 (&v)[16], const CvItem& ci, LAS bf16* scr, int lane) {
#pragma unroll
    for (int i = 0; i < 16; ++i) { const unsigned p0 = cvt_pk_bf16(v[i][0], v[i][1]), p1 = cvt_pk_bf16(v[i][2], v[i][3]);
        LAS unsigned* q = (LAS unsigned*)(scr + (4 * i + (lane >> 4)) * 66 + 4 * (lane & 15)); q[0] = p0; q[1] = p1; }
    LDS_WAIT(); asm volatile("" ::: "memory");
    const int c = lane & 3;
#pragma unroll
    for (int j = 0; j < 4; ++j) { const int n = (lane >> 2) + 16 * j; const LAS bf16* t = scr + (16 * c) * 66 + n;
        float f[16];
#pragma unroll
        for (int q = 0; q < 16; ++q) f[q] = __uint_as_float((unsigned)t[q * 66] << 16) * ci.scale;
        v4u o; o.x = pg8::pk_fp8x4(f[0], f[1], f[2], f[3]); o.y = pg8::pk_fp8x4(f[4], f[5], f[6], f[7]); o.z = pg8::pk_fp8x4(f[8], f[9], f[10], f[11]); o.w = pg8::pk_fp8x4(f[12], f[13], f[14], f[15]);
        unsigned char* d = (j < 2) ? ci.d0 + (size_t)n * ci.pitch : ci.d1 + (size_t)(n - 32) * ci.pitch;
        *(GAS v4u*)(d + 16 * c) = o; }
    LDS_WAIT(); asm volatile("" ::: "memory");
}
__device__ __forceinline__ void cv_pack(const f32x4 (&v)[16], unsigned (&pk)[32]) {
#pragma unroll
    for (int i = 0; i < 16; ++i) { pk[2 * i] = cvt_pk_bf16(v[i][0], v[i][1]); pk[2 * i + 1] = cvt_pk_bf16(v[i][2], v[i][3]); }
}
__device__ __forceinline__ void cv_finish_p(const unsigned (&pk)[32], const CvItem& ci, LAS bf16* scr, int lane) {
#pragma unroll
    for (int i = 0; i < 16; ++i) { LAS unsigned* q = (LAS unsigned*)(scr + (4 * i + (lane >> 4)) * 66 + 4 * (lane & 15)); q[0] = pk[2 * i]; q[1] = pk[2 * i + 1]; }
    LDS_WAIT(); asm volatile("" ::: "memory");
    const int c = lane & 3;
#pragma unroll
    for (int j = 0; j < 4; ++j) { const int n = (lane >> 2) + 16 * j; const LAS bf16* t = scr + (16 * c) * 66 + n;
        float f[16];
#pragma unroll
        for (int q = 0; q < 16; ++q) f[q] = __uint_as_float((unsigned)t[q * 66] << 16) * ci.scale;
        v4u o; o.x = pg8::pk_fp8x4(f[0], f[1], f[2], f[3]); o.y = pg8::pk_fp8x4(f[4], f[5], f[6], f[7]); o.z = pg8::pk_fp8x4(f[8], f[9], f[10], f[11]); o.w = pg8::pk_fp8x4(f[12], f[13], f[14], f[15]);
        unsigned char* d = (j < 2) ? ci.d0 + (size_t)n * ci.pitch : ci.d1 + (size_t)(n - 32) * ci.pitch;
        *(GAS v4u*)(d + 16 * c) = o; }
    LDS_WAIT(); asm volatile("" ::: "memory");
}
__device__ __forceinline__ void cv_pack8(const f32x4 (&v)[16], float scale, unsigned (&P)[4][4]) {
#pragma unroll
    for (int j = 0; j < 4; ++j)
#pragma unroll
        for (int g = 0; g < 4; ++g) P[j][g] = pg8::pk_fp8x4(v[4 * g][j] * scale, v[4 * g + 1][j] * scale, v[4 * g + 2][j] * scale, v[4 * g + 3][j] * scale);
}
__device__ __forceinline__ void cv_store8(const unsigned (&P)[4][4], const CvItem& ci, int lane) {
    const int n = 4 * (lane & 15) + (lane >> 4);
    unsigned char* d = (n < 32) ? ci.d0 + (size_t)n * ci.pitch : ci.d1 + (size_t)(n - 32) * ci.pitch;
#pragma unroll
    for (int g = 0; g < 4; ++g) {
        const auto a = __builtin_amdgcn_permlane16_swap(P[0][g], P[1][g], false, false); const auto b = __builtin_amdgcn_permlane16_swap(P[2][g], P[3][g], false, false);
        const auto c = __builtin_amdgcn_permlane32_swap(a[0], b[0], false, false); const auto e = __builtin_amdgcn_permlane32_swap(a[1], b[1], false, false);
        const unsigned q0 = c[0], q2 = c[1], q1 = e[0], q3 = e[1];
        const unsigned t0 = __builtin_amdgcn_perm(q1, q0, 0x05010400u), t1 = __builtin_amdgcn_perm(q1, q0, 0x07030602u), t2 = __builtin_amdgcn_perm(q3, q2, 0x05010400u), t3 = __builtin_amdgcn_perm(q3, q2, 0x07030602u);
        v4u o; o.x = __builtin_amdgcn_perm(t2, t0, 0x05040100u); o.y = __builtin_amdgcn_perm(t2, t0, 0x07060302u); o.z = __builtin_amdgcn_perm(t3, t1, 0x05040100u); o.w = __builtin_amdgcn_perm(t3, t1, 0x07060302u);
        *(GAS v4u*)(d + 16 * g) = o; }
}
constexpr int CV_ITEMS = 3 * 11008, CV_IN_LRU = 0, CV_IN_ATT = 16;
__device__ __forceinline__ CvItem cv_make(CArgs a, unsigned char* ws, int l, int it, int lane) {
    CvItem c; const int which = it / 11008, r = it % 11008, e = r / 688, q = r % 688;
    if (which < 2) { const int kb = q / 43, nb = q % 43, n0 = nb * 64, k0 = kb * 64;
        const float* W = inp(a, which == 0 ? I_WG : I_WU) + ((size_t)(l * NE + e) * D) * FF;
        const int drow = e * 5632 + (n0 >> 7) * 256 + (n0 & 127) + which * 128; unsigned char* d0 = ws + WS_WGU + (size_t)drow * D + k0;
        c.src = W + (size_t)k0 * FF + n0; c.voff = (unsigned)((lane >> 4) * FF + 4 * (lane & 15)) * 4u; c.ldw = FF; c.d0 = d0; c.d1 = d0 + (size_t)32 * D; c.pitch = D; c.scale = WSC_GU; }
    else { const int kb = q / 16, nb = q % 16, n0 = nb * 64, k0 = kb * 64;
        const float* W = inp(a, I_WDN) + ((size_t)(l * NE + e) * FF) * D; unsigned char* d0 = ws + WS_WD + ((size_t)e * D + n0) * FFP + k0;
        c.src = W + (size_t)k0 * D + n0; c.voff = (unsigned)((lane >> 4) * D + 4 * (lane & 15)) * 4u; c.ldw = D; c.d0 = d0; c.d1 = d0 + (size_t)32 * FFP; c.pitch = FFP; c.scale = WSC_D; }
    return c;
}

__device__ __forceinline__ void ph_prologue(const Ctx& X, CArgs a) {
    float* MOD = (float*)(X.ws + WS_MOD);
    if ((int)blockIdx.x < 384) {
        LAS float* SV = (LAS float*)X.lds;
        LAS float* RED = (LAS float*)(X.lds + 5 * 1024 * 4);
        for (int i = X.tid; i < 5 * 1024; i += 512) { const int v = i >> 10, k = i & 1023; const float cv = v < 4 ? inp(a, I_C)[v * 1024 + k] : inp(a, I_CCTX)[k]; SV[i] = silu_f(cv); }
        __syncthreads();
        for (int it = blockIdx.x; it < 384; it += X.G) {
            const int l = it / 192, n0 = (it % 192) * 32, kg = X.tid >> 5, cn = X.tid & 31;
            const float* W = inp(a, I_WADA) + (size_t)l * 1024 * 6144 + n0 + cn;
            float acc[5] = {0.f, 0.f, 0.f, 0.f, 0.f};
#pragma unroll 16
            for (int k = kg; k < 1024; k += 16) { const float w = W[(size_t)k * 6144];
#pragma unroll
                for (int v = 0; v < 5; ++v) acc[v] += SV[v * 1024 + k] * w; }
#pragma unroll
            for (int v = 0; v < 5; ++v) RED[(kg * 5 + v) * 32 + cn] = acc[v];
            __syncthreads();
            if (X.tid < 160) { const int v = X.tid >> 5; float s = 0.f;
                for (int q = 0; q < 16; ++q) s += RED[(q * 5 + v) * 32 + cn];
                MOD[(l * 5 + v) * 6144 + n0 + cn] = s + inp(a, I_BADA)[l * 6144 + n0 + cn]; }
            __syncthreads();
        }
    }
    LAS bf16* scr = (LAS bf16*)(X.lds + 32768 + X.wave * 8448);
    const int gw = X.vcu * NWAVES + X.wave, NGW = X.G * NWAVES;
    bf16* WIN = (bf16*)(X.ws + WS_WIN); bf16* WBR = (bf16*)(X.ws + WS_WBR); bf16* WOUT = (bf16*)(X.ws + WS_WOUT);
    for (int it = gw; it < 3200 + 768 + 512; it += NGW) {
        if (it < 3200) { const int l = it / 1600, r = it % 1600, kb = r / 100, nb = r % 100, n0 = nb * 64, k0 = kb * 64;
            const int tile = n0 >> 8, wc = (n0 & 255) >> 6, drow = tile * 256 + 32 * wc;
            bf16* d0 = WIN + (size_t)l * DIN * D + (size_t)drow * D + k0;
            if (n0 < 3328) tr_item64(inp(a, I_WIN) + (size_t)l * D * DIN, DIN, k0, n0, d0, d0 + (size_t)128 * D, D, scr, X.lane);
            else { unsigned char* e0 = (unsigned char*)(WIN + (size_t)l * DIN * D + (size_t)3328 * D) + (size_t)(n0 - 3328) * D + k0;
                tr_item64_f8(inp(a, I_WIN) + (size_t)l * D * DIN, DIN, k0, n0, e0, e0 + (size_t)32 * D, D, WSC_GU, scr, X.lane, true); } }
        else if (it < 3200 + 768) { const int q = it - 3200, ln = q / 128, r = q % 128, kb = r / 16, nb = r % 16, n0 = nb * 64, k0 = kb * 64;
            bf16* d0 = WBR + (size_t)ln * 1024 * 512 + (size_t)n0 * 512 + k0;
            tr_item64(inp(a, I_WBR) + (size_t)ln * 512 * 1024, 1024, k0, n0, d0, d0 + (size_t)32 * 512, 512, scr, X.lane); }
        else { const int q = it - 3968, l = q / 256, r = q % 256, kb = r / 16, nb = r % 16, n0 = nb * 64, k0 = kb * 64;
            bf16* d0 = WOUT + (size_t)l * D * D + (size_t)n0 * D + k0;
            tr_item64(inp(a, I_WOUT) + (size_t)l * D * D, D, k0, n0, d0, d0 + (size_t)32 * D, D, scr, X.lane); }
    }
    bf16* LW = (bf16*)(X.ws + WS_LRUW);
    for (int i = gw * 64 + X.lane; i < 2 * 2 * 2 * 8 * 4096; i += NGW * 64) {
        const int k = i & 63, n = (i >> 6) & 63, g = (i >> 12) & 7, gate = (i >> 15) & 1, d = (i >> 16) & 1, l = i >> 17;
        const float* src = gate ? inp(a, I_LWX) : inp(a, I_LWA);
        const float w = src[((((size_t)l * 2 + d) * 8 + g) * 64 + k) * 64 + n];
        LW[i] = (bf16)(cvt_pk_bf16(w, 0.f) & 0xffffu);
    }
}

__device__ __forceinline__ const float* xrow_ptr(CArgs a, unsigned char* ws, int l, int r) {
    if (l == 0) return r < T ? inp(a, I_X) + (size_t)r * D : inp(a, I_CTX) + (size_t)(r - T) * D;
    return (const float*)(ws + WS_X2) + (size_t)r * D;
}
__device__ __forceinline__ const float* mod_ptr(unsigned char* ws, int l, int r) { const int v = r < T ? (r >> 13) : 4; return (const float*)(ws + WS_MOD) + (size_t)(l * 5 + v) * 6144; }

__device__ __forceinline__ void ph_make_xh0(const Ctx& X, CArgs a) {
    const int gw = X.vcu * NWAVES + X.wave, NGW = X.G * NWAVES;
    bf16* XH = (bf16*)(X.ws + WS_SA);
    for (int r0 = gw * 4; r0 < R; r0 += NGW * 4) {
        const float* md = mod_ptr(X.ws, 0, r0);
        f32x4 x[4][4];
#pragma unroll
        for (int q = 0; q < 4; ++q) { const float* xr = xrow_ptr(a, X.ws, 0, r0 + q);
#pragma unroll
            for (int j = 0; j < 4; ++j) x[q][j] = *(const f32x4*)(xr + 4 * X.lane + 256 * j); }
#pragma unroll
        for (int j = 0; j < 4; ++j) { const int c = 4 * X.lane + 256 * j; const f32x4 sh = *(const f32x4*)(md + c), sc = *(const f32x4*)(md + 1024 + c) + 1.0f;
#pragma unroll
            for (int q = 0; q < 4; ++q) { const f32x4 h = x[q][j] * sc + sh; v2u w; w.x = cvt_pk_bf16(h[0], h[1]); w.y = cvt_pk_bf16(h[2], h[3]);
                *(v2u*)(XH + (size_t)(r0 + q) * D + c) = w; *(unsigned*)(X.ws + WS_XH8 + (size_t)(r0 + q) * D + c) = pg8::pk_fp8x4(h[0], h[1], h[2], h[3]); } }
    }
}

__device__ __forceinline__ f32x2 lru_comp(f32x2 first, f32x2 second) { return (f32x2){first.x * second.x, second.x * first.y + second.y}; }
template <int PASS> __device__ __forceinline__ void ph_lru(const Ctx& X, CArgs a, int l, bool need_ctx) {
    LAS float* U = (LAS float*)X.lds;
    LAS f32x2* WAG = (LAS f32x2*)(X.lds + 34816);
    LAS float* PRE = (LAS float*)(X.lds + 34816 + 8192);
    LAS f32x2* CAR = (LAS f32x2*)(X.lds + 34816 + 8192 + 4096);
    LAS v4u* BW = (LAS v4u*)(X.lds + 51200);
    LAS float* CW = (LAS float*)(X.lds + 51200 + 32768);
    unsigned char* wsl = X.ws;
#define LRU_WS(off) (wsl + (off))
#define XB ((const bf16*)LRU_WS(WS_XB))
#define GB ((const bf16*)LRU_WS(WS_GB))
#define YB ((bf16*)LRU_WS(WS_BR) + (size_t)R * 512)
#define LW ((const bf16*)LRU_WS(WS_LRUW) + (size_t)l * 2 * 2 * 8 * 4096)
#define AGG ((f32x2*)LRU_WS(WS_AGG))
#define LBQ ((v4u*)LRU_WS(WS_MM32))
    const int w = X.wave;
    int tid_o = X.tid; asm volatile("" : "+v"(tid_o));
    int quad = (tid_o & 63) >> 4, l16 = tid_o & 15, tt = tid_o >> 2, c16 = (tid_o & 3) * 16;
    int gcur = -1; float cba[2][4], cbx[2][4], csp[2][4];
#define LRU_ITEM(it_, b_, sc_, g_) const int b_ = (it_) / 528, sc_ = ((it_) % 528) >> 3, g_ = (it_) & 7
#define LRU_LOADX(dst, it_) do { LRU_ITEM(it_, b__, sc__, g__); const int slo = sc__ < 2 ? T + b__ * CTX : b__ * SEQ, sln = sc__ < 2 ? CTX : SEQ, tq = (sc__ < 2 ? sc__ * 128 : (sc__ - 2) * 128) + tt - 2; \
        _Pragma("unroll") for (int j = 0; j < 4; ++j) { const int t = tq + j; const bool ok = t >= 0 && t < sln; const bf16* p = XB + (size_t)(slo + (ok ? t : 0)) * 512 + g__ * 64 + c16; \
            dst[j][0] = ok ? *(const v4u*)p : (v4u){0u, 0u, 0u, 0u}; dst[j][1] = ok ? *(const v4u*)(p + 8) : (v4u){0u, 0u, 0u, 0u}; } } while (0)
    v4u xc[4][2];
    int item = blockIdx.x;
    while (item < NB * 66 * 8 && PASS == 2 && !need_ctx && ((item % 528) >> 3) < 2) item += X.G;
    if (PASS == 1 && item < NB * 66 * 8) LRU_LOADX(xc, item);
    int cvk = 0;
    while (item < NB * 66 * 8) {
        LRU_ITEM(item, b, sc, g);
        { unsigned long long w_ = (unsigned long long)X.ws; asm volatile("" : "+s"(w_)); wsl = (unsigned char*)(GAS unsigned char*)w_; }
        asm volatile("" : "+v"(tid_o)); quad = (tid_o & 63) >> 4; l16 = tid_o & 15; tt = tid_o >> 2; c16 = (tid_o & 3) * 16;
        int nitem = item + X.G;
        f32x4 cvv[16]; CvItem cvi; const bool cvh = PASS == 2 && cvk < CV_IN_LRU;
        while (nitem < NB * 66 * 8 && PASS == 2 && !need_ctx && ((nitem % 528) >> 3) < 2) nitem += X.G;
        const int seqlo = sc < 2 ? T + b * CTX : b * SEQ, t0 = sc < 2 ? sc * 128 : (sc - 2) * 128;
        if (PASS == 1 && g != gcur) {
            __syncthreads();
            CArgs a2 = a; asm volatile("" : "+s"(a2));
            const bf16* lw_ = LW;
            for (int i = X.tid; i < 2048; i += 512) { const int slot = i >> 6, ln = i & 63, ks = slot & 1, nt = (slot >> 1) & 3, dg = slot >> 3;
                BW[i] = *(const v4u*)(lw_ + ((size_t)(dg * 8 + g) * 64 + nt * 16 + (ln & 15)) * 64 + ks * 32 + 8 * (ln >> 4)); }
            if (X.tid < 320) { const int j = X.tid >> 6, ch = X.tid & 63; CW[X.tid] = j < 4 ? inp(a2, I_CONVW)[(l * 4 + j) * 512 + g * 64 + ch] : inp(a2, I_CONVB)[l * 512 + g * 64 + ch]; }
#pragma unroll
            for (int d = 0; d < 2; ++d)
#pragma unroll
                for (int nt = 0; nt < 4; ++nt) { const int ch = g * 64 + nt * 16 + l16;
                    cba[d][nt] = inp(a2, I_LBA)[(l * 2 + d) * 512 + ch]; cbx[d][nt] = inp(a2, I_LBX)[(l * 2 + d) * 512 + ch];
                    const float el = fast_exp(-inp(a2, I_LLAM)[(l * 2 + d) * 512 + ch]);
                    csp[d][nt] = el < 0.03f ? el * (1.0f - el * (0.5f - el * (0.33333334f - el * 0.25f))) : __builtin_amdgcn_logf(1.0f + el) * 0.6931471805599453f; }
            gcur = g;
            __syncthreads();
        }
        if (PASS == 2) {
        { const int dc = tid_o & 127, d = dc >> 6, ch = dc & 63, sg = tid_o >> 7;
          const f32x2* ag = AGG + (size_t)(b * 2 + d) * 66 * 512 + g * 64 + ch;
          const int npos = d == 0 ? sc : (sc == 1 ? 0 : (sc == 0 ? 1 : 67 - sc));
          f32x2 qv[17];
#pragma unroll
          for (int k = 0; k < 17; ++k) { const int p = sg * 17 + k; const int c = d == 0 ? p : (p == 0 ? 1 : (p == 1 ? 0 : 67 - p));
              qv[k] = p < npos ? ag[(size_t)c * 512] : (f32x2){1.f, 0.f}; }
          f32x2 part = {1.f, 0.f};
#pragma unroll
          for (int k = 0; k < 17; ++k) part = lru_comp(part, qv[k]);
          CAR[sg * 128 + dc] = part; }
        }
        if (PASS == 1) { float u[16];
#pragma unroll
          for (int k = 0; k < 16; k += 4) { const f32x4 bvv = *(const LAS f32x4*)(CW + 256 + c16 + k); u[k] = bvv[0]; u[k + 1] = bvv[1]; u[k + 2] = bvv[2]; u[k + 3] = bvv[3]; }
#pragma unroll
          for (int j = 0; j < 4; ++j) { const unsigned xw[8] = {xc[j][0].x, xc[j][0].y, xc[j][0].z, xc[j][0].w, xc[j][1].x, xc[j][1].y, xc[j][1].z, xc[j][1].w};
#pragma unroll
              for (int k = 0; k < 16; k += 4) { const f32x4 wv = *(const LAS f32x4*)(CW + j * 64 + c16 + k);
                  u[k] += wv[0] * bf_lo(xw[k >> 1]); u[k + 1] += wv[1] * bf_hi(xw[k >> 1]); u[k + 2] += wv[2] * bf_lo(xw[(k >> 1) + 1]); u[k + 3] += wv[3] * bf_hi(xw[(k >> 1) + 1]); } }
#pragma unroll
          for (int k = 0; k < 16; k += 4) *(LAS f32x4*)(U + tt * 68 + c16 + k) = (f32x4){u[k], u[k + 1], u[k + 2], u[k + 3]}; }
        if (PASS == 1 && nitem < NB * 66 * 8) LRU_LOADX(xc, nitem);
        const int rowb = seqlo + t0 + 16 * w + 4 * quad;
        unsigned short gbq[4][4];
        if (PASS == 2) {
#pragma unroll
            for (int nt = 0; nt < 4; ++nt)
#pragma unroll
                for (int i = 0; i < 4; ++i) gbq[nt][i] = GB[(size_t)(rowb + i) * 512 + g * 64 + nt * 16 + l16]; }
        v4u lbq[8];
        if (PASS == 2) {
#pragma unroll
            for (int k = 0; k < 8; ++k) lbq[k] = LBQ[((size_t)item * 8 + k) * 512 + tid_o]; }
        if (cvh) { cvi = cv_make(a, X.ws, l, (X.vcu * NWAVES + w) + cvk * (X.G * NWAVES), tid_o & 63); cv_load(cvv, cvi); }
        if (PASS == 1) __syncthreads();
        float av[2][4][4], bv[2][4][4];
        if (PASS == 1) {
        bf16x8 af[2];
#pragma unroll
        for (int ks = 0; ks < 2; ++ks) { const LAS float* up = U + (16 * w + l16) * 68 + ks * 32 + 8 * quad; const f32x4 p0 = *(const LAS f32x4*)up, p1 = *(const LAS f32x4*)(up + 4);
            v4u pk; pk.x = cvt_pk_bf16(p0[0], p0[1]); pk.y = cvt_pk_bf16(p0[2], p0[3]); pk.z = cvt_pk_bf16(p1[0], p1[1]); pk.w = cvt_pk_bf16(p1[2], p1[3]); af[ks] = __builtin_bit_cast(bf16x8, pk); }
#pragma unroll
        for (int d = 0; d < 2; ++d)
#pragma unroll
            for (int nt = 0; nt < 4; ++nt) {
                f32x4 cr = {0.f, 0.f, 0.f, 0.f}, ci = {0.f, 0.f, 0.f, 0.f};
#pragma unroll
                for (int ks = 0; ks < 2; ++ks) {
                    const bf16x8 br = __builtin_bit_cast(bf16x8, BW[((((d * 2 + 0) * 4 + nt) * 2 + ks) << 6) + (tid_o & 63)]);
                    const bf16x8 bi = __builtin_bit_cast(bf16x8, BW[((((d * 2 + 1) * 4 + nt) * 2 + ks) << 6) + (tid_o & 63)]);
                    cr = __builtin_amdgcn_mfma_f32_16x16x32_bf16(af[ks], br, cr, 0, 0, 0);
                    ci = __builtin_amdgcn_mfma_f32_16x16x32_bf16(af[ks], bi, ci, 0, 0, 0);
                }
                const float ba = cba[d][nt], bx = cbx[d][nt], sp = csp[d][nt];
                unsigned pkw[4];
#pragma unroll
                for (int i = 0; i < 4; ++i) {
                    const float uu = U[(16 * w + 4 * quad + i) * 68 + nt * 16 + l16];
                    const float rr = sigmoid_f(cr[i] + ba), ii = sigmoid_f(ci[i] + bx);
                    const float la = -8.0f * rr * sp, x2 = 2.0f * la;
                    const float om = x2 > -0.25f ? -x2 * (1.0f + x2 * (0.5f + x2 * (0.16666667f + x2 * (0.041666668f + x2 * (0.008333334f + x2 * 0.0013888889f))))) : 1.0f - fast_exp(x2);
                    av[d][nt][i] = fast_exp(la); bv[d][nt][i] = __builtin_amdgcn_sqrtf(om) * (ii * uu);
                    pkw[i] = (unsigned)__builtin_bit_cast(unsigned short, (_Float16)la) | cvt_pk_bf16(0.f, bv[d][nt][i]);
                }
                LBQ[((size_t)item * 8 + d * 4 + nt) * 512 + tid_o] = (v4u){pkw[0], pkw[1], pkw[2], pkw[3]};
            }
        } else {
#pragma unroll
        for (int d = 0; d < 2; ++d)
#pragma unroll
            for (int nt = 0; nt < 4; ++nt) { const v4u q4 = lbq[d * 4 + nt]; const unsigned qq[4] = {q4.x, q4.y, q4.z, q4.w};
#pragma unroll
                for (int i = 0; i < 4; ++i) { av[d][nt][i] = fast_exp((float)__builtin_bit_cast(_Float16, (unsigned short)(qq[i] & 0xffffu))); bv[d][nt][i] = __uint_as_float(qq[i] & 0xffff0000u); } }
        }
        f32x2 seg[2][4];
#pragma unroll
        for (int nt = 0; nt < 4; ++nt) {
            { float A = 1.f, H = 0.f;
#pragma unroll
              for (int i = 0; i < 4; ++i) { H = av[0][nt][i] * H + bv[0][nt][i]; A *= av[0][nt][i]; } seg[0][nt] = (f32x2){A, H}; }
            { float A = 1.f, H = 0.f;
#pragma unroll
              for (int i = 3; i >= 0; --i) { H = av[1][nt][i] * H + bv[1][nt][i]; A *= av[1][nt][i]; } seg[1][nt] = (f32x2){A, H}; }
        }
#pragma unroll
        for (int d = 0; d < 2; ++d)
#pragma unroll
            for (int nt = 0; nt < 4; ++nt) {
                f32x2 tot = seg[d][nt];
#pragma unroll
                for (int off = 16; off <= 32; off <<= 1) {
                    const f32x2 o = (f32x2){__shfl_xor(tot.x, off), __shfl_xor(tot.y, off)};
                    const bool me_low = (X.lane & off) == 0;
                    const bool me_first = (d == 0) ? me_low : !me_low;
                    tot = me_first ? lru_comp(tot, o) : lru_comp(o, tot);
                }
                if (quad == 0) WAG[(d * 8 + w) * 64 + nt * 16 + l16] = tot;
            }
        __syncthreads();
        if (PASS == 1) {
            if (X.tid < 128) { const int d = X.tid >> 6, ch = X.tid & 63; f32x2 tot = (f32x2){1.f, 0.f};
                for (int q = 0; q < 8; ++q) { const int ww = d == 0 ? q : 7 - q; tot = lru_comp(tot, WAG[(d * 8 + ww) * 64 + ch]); }
                AGG[((size_t)(b * 2 + d) * 66 + sc) * 512 + g * 64 + ch] = tot; }
            __syncthreads();
        } else {
            if (X.tid < 128) { const int d = X.tid >> 6, ch = X.tid & 63; float st = 0.f;
#pragma unroll
                for (int sg = 0; sg < 4; ++sg) { const f32x2 q = CAR[sg * 128 + X.tid]; st = q.x * st + q.y; }
                for (int q = 0; q < 8; ++q) { const int ww = d == 0 ? q : 7 - q; PRE[(d * 8 + ww) * 64 + ch] = st; const f32x2 t2 = WAG[(d * 8 + ww) * 64 + ch]; st = t2.x * st + t2.y; } }
            __syncthreads();
#pragma unroll
            for (int nt = 0; nt < 4; ++nt) {
                float y[4];
                { float s = PRE[(0 * 8 + w) * 64 + nt * 16 + l16];
#pragma unroll
                  for (int q = 0; q < 4; ++q) { const float A = __shfl(seg[0][nt].x, q * 16 + l16), H = __shfl(seg[0][nt].y, q * 16 + l16); if (q < quad) s = A * s + H; }
#pragma unroll
                  for (int i = 0; i < 4; ++i) { s = av[0][nt][i] * s + bv[0][nt][i]; y[i] = s; } }
                { float s = PRE[(1 * 8 + w) * 64 + nt * 16 + l16];
#pragma unroll
                  for (int q = 3; q >= 0; --q) { const float A = __shfl(seg[1][nt].x, q * 16 + l16), H = __shfl(seg[1][nt].y, q * 16 + l16); if (q > quad) s = A * s + H; }
#pragma unroll
                  for (int i = 3; i >= 0; --i) { s = av[1][nt][i] * s + bv[1][nt][i]; y[i] += s; } }
                const int ch = g * 64 + nt * 16 + l16;
#pragma unroll
                for (int i = 0; i < 4; ++i) { const size_t o = (size_t)(rowb + i) * 512 + ch; const float gbv = __uint_as_float((unsigned)gbq[nt][i] << 16);
                    YB[o] = (bf16)(cvt_pk_bf16(y[i] * gbv, 0.f) & 0xffffu); }
            }
            __syncthreads();
        }
        if (cvh) { cv_finish(cvv, cvi, (LAS bf16*)(X.lds + 51200 + w * 8448), tid_o & 63); ++cvk; }
        item = nitem;
    }
    for (; PASS == 2 && cvk < CV_IN_LRU; ++cvk) {
        const CvItem ci = cv_make(a, X.ws, l, (X.vcu * NWAVES + w) + cvk * (X.G * NWAVES), tid_o & 63); f32x4 v[16]; cv_load(v, ci); cv_finish(v, ci, (LAS bf16*)(X.lds + 51200 + w * 8448), tid_o & 63); }
#undef LRU_ITEM
#undef LRU_LOADX
#undef LRU_WS
#undef XB
#undef GB
#undef YB
#undef LW
#undef AGG
#undef LBQ
}

__device__ __forceinline__ void ph_diff_combine(const Ctx& X, CArgs a, int l, int nrows) {
    const int gw = X.vcu * NWAVES + X.wave, NGW = X.G * NWAVES;
    const float lam_init = l == 0 ? 0.2f : 0.35550906759096926f;
    const float* dl = inp(a, I_DLAM) + l * 256;
    const float s1 = wave_sum(dl[X.lane] * dl[64 + X.lane]), s2 = wave_sum(dl[128 + X.lane] * dl[192 + X.lane]);
    const float lam = expf(s1) - expf(s2) + lam_init;
    const bf16* DO0 = (const bf16*)(X.ws + WS_DO); const bf16* DO1 = DO0 + (size_t)R * 512; bf16* YC = (bf16*)(X.ws + WS_BR) + (size_t)2 * R * 512;
    const float* sub = inp(a, I_DSUB) + l * 128 + (8 * X.lane & 127);
    const f32x4 g0 = *(const f32x4*)sub, g1 = *(const f32x4*)(sub + 4);
    const float post = 1.0f - lam_init;
    for (int r = gw; r < nrows; r += NGW) {
        const v4u p = *(const v4u*)(DO0 + (size_t)r * 512 + 8 * X.lane), q = *(const v4u*)(DO1 + (size_t)r * 512 + 8 * X.lane);
        float v[8] = {bf_lo(p.x) - lam * bf_lo(q.x), bf_hi(p.x) - lam * bf_hi(q.x), bf_lo(p.y) - lam * bf_lo(q.y), bf_hi(p.y) - lam * bf_hi(q.y),
                      bf_lo(p.z) - lam * bf_lo(q.z), bf_hi(p.z) - lam * bf_hi(q.z), bf_lo(p.w) - lam * bf_lo(q.w), bf_hi(p.w) - lam * bf_hi(q.w)};
        float ss = 0.f;
#pragma unroll
        for (int k = 0; k < 8; ++k) ss += v[k] * v[k];
        ss += __shfl_xor(ss, 1); ss += __shfl_xor(ss, 2); ss += __shfl_xor(ss, 4); ss += __shfl_xor(ss, 8);
        const float rinv = __builtin_amdgcn_rsqf(ss * (1.0f / 128.0f) + RMS_EPS) * post;
        v4u o; o.x = cvt_pk_bf16(v[0] * rinv * g0[0], v[1] * rinv * g0[1]); o.y = cvt_pk_bf16(v[2] * rinv * g0[2], v[3] * rinv * g0[3]);
        o.z = cvt_pk_bf16(v[4] * rinv * g1[0], v[5] * rinv * g1[1]); o.w = cvt_pk_bf16(v[6] * rinv * g1[2], v[7] * rinv * g1[3]);
        *(v4u*)(YC + (size_t)r * 512 + 8 * X.lane) = o;
    }
}

__device__ __forceinline__ void ph_ln1_router(const Ctx& X, CArgs a, int l, int nrows) {
    const int gw = X.vcu * NWAVES + X.wave, NGW = X.G * NWAVES;
    LAS float* WR = (LAS float*)X.lds;
    for (int i = X.tid; i < 16 * 1024; i += 512) { const int c = i >> 4, e = i & 15; WR[e * 1024 + c] = inp(a, I_WR)[(size_t)l * 1024 * 16 + i]; }
    __syncthreads();
    const bf16* O16 = (const bf16*)(X.ws + WS_GM); float* X1 = (float*)(X.ws + WS_X1); unsigned char* H2 = X.ws + WS_SA; float* AFF = (float*)(X.ws + WS_AFF);
    const float* lg = uni(inp(a, I_LN1G) + l * D); const float* lb = uni(inp(a, I_LN1B) + l * D);
    f32x4 xn[2][4]; v2u on[2][4];
#define LN1_FETCH(rr_) do { unsigned lp_ = 4u * (unsigned)X.lane; asm volatile("" : "+v"(lp_)); \
        const float* p0_ = uni(xrow_ptr(a, X.ws, l, (rr_))); const float* p1_ = uni(xrow_ptr(a, X.ws, l, (rr_) + 1)); const bf16* po_ = uni(O16 + (size_t)(rr_) * D); \
        _Pragma("unroll") for (int j = 0; j < 4; ++j) { xn[0][j] = *(const f32x4*)(p0_ + (lp_ + 256u * j)); xn[1][j] = *(const f32x4*)(p1_ + (lp_ + 256u * j)); } \
        _Pragma("unroll") for (int j = 0; j < 4; ++j) { on[0][j] = *(const v2u*)(po_ + (lp_ + 256u * j)); on[1][j] = *(const v2u*)(po_ + (lp_ + 1024u + 256u * j)); } } while (0)
    if (gw * 2 < nrows) LN1_FETCH(gw * 2);
    for (int r0 = gw * 2; r0 < nrows; r0 += NGW * 2) {
        const float* md = uni(mod_ptr(X.ws, l, r0));
        unsigned l4 = 4u * (unsigned)X.lane; asm volatile("" : "+v"(l4));
        float* x1p = uni(X1 + (size_t)r0 * D); unsigned char* h2p = uni(H2 + (size_t)r0 * D);
        f32x4 v[2][4]; float s[2] = {0.f, 0.f};
#pragma unroll
        for (int j = 0; j < 4; ++j) { v[0][j] = xn[0][j]; v[1][j] = xn[1][j]; }
#pragma unroll
        for (int j = 0; j < 4; ++j) { const f32x4 g1 = *(const f32x4*)(md + (l4 + 2048u + 256u * j));
#pragma unroll
            for (int q = 0; q < 2; ++q) { const v2u ow = on[q][j]; const f32x4 of = {bf_lo(ow.x), bf_hi(ow.x), bf_lo(ow.y), bf_hi(ow.y)};
                v[q][j] = v[q][j] * DN_ALPHA + g1 * of;
                s[q] += (v[q][j][0] + v[q][j][1]) + (v[q][j][2] + v[q][j][3]); } }
        float mean[2], rstd[2];
#pragma unroll
        for (int q = 0; q < 2; ++q) mean[q] = wave_sum(s[q]) * (1.0f / D);
#pragma unroll
        for (int q = 0; q < 2; ++q) { float qq = 0.f;
#pragma unroll
            for (int j = 0; j < 4; ++j) { v[q][j] = v[q][j] - mean[q]; qq += (v[q][j][0] * v[q][j][0] + v[q][j][1] * v[q][j][1]) + (v[q][j][2] * v[q][j][2] + v[q][j][3] * v[q][j][3]); }
            s[q] = qq; }
#pragma unroll
        for (int q = 0; q < 2; ++q) rstd[q] = 1.0f / sqrtf(wave_sum(s[q]) * (1.0f / D) + LN_EPS);
#pragma unroll
        for (int j = 0; j < 4; ++j) { const unsigned c = l4 + 256u * j;
            const f32x4 g4 = *(const f32x4*)(lg + c), b4 = *(const f32x4*)(lb + c), sc4 = *(const f32x4*)(md + (c + 4096u)) + 1.0f, sh4 = *(const f32x4*)(md + (c + 3072u));
#pragma unroll
            for (int q = 0; q < 2; ++q) { const f32x4 y = v[q][j] * rstd[q] * g4 + b4;
                *(f32x4*)(x1p + (c + 1024u * q)) = y;
                const f32x4 h = y * sc4 + sh4; v[q][j] = h;
                *(unsigned*)(h2p + (c + 1024u * q)) = pg8::pk_fp8x4(h[0], h[1], h[2], h[3]); } }
        __builtin_amdgcn_sched_barrier(0);
        if (r0 + NGW * 2 < nrows) LN1_FETCH(r0 + NGW * 2);
        __builtin_amdgcn_sched_barrier(0);
        float lgt[2][16];
#pragma unroll
        for (int q = 0; q < 2; ++q) {
            unsigned cq = l4; asm volatile("" : "+v"(cq));
#pragma unroll
            for (int e = 0; e < 16; ++e) lgt[q][e] = 0.f;
#pragma unroll
            for (int j = 0; j < 4; ++j)
#pragma unroll
                for (int e = 0; e < 16; ++e) { const f32x4 wr = *(const LAS f32x4*)(WR + e * 1024 + cq + 256u * j);
                    lgt[q][e] += (v[q][j][0] * wr[0] + v[q][j][1] * wr[1]) + (v[q][j][2] * wr[2] + v[q][j][3] * wr[3]);
                    asm volatile("" : "+v"(lgt[q][e]));
                    if ((e & 7) == 7) __builtin_amdgcn_sched_barrier(0); }
        }
#pragma unroll
        for (int q = 0; q < 2; ++q) {
            float k8[8], k4[4], k2[2], k1;
            { const bool hi = (X.lane & 32) != 0;
#pragma unroll
              for (int e = 0; e < 8; ++e) { const float send = hi ? lgt[q][e] : lgt[q][e + 8], keep = hi ? lgt[q][e + 8] : lgt[q][e]; k8[e] = keep + __shfl_xor(send, 32); } }
            { const bool hi = (X.lane & 16) != 0;
#pragma unroll
              for (int e = 0; e < 4; ++e) { const float send = hi ? k8[e] : k8[e + 4], keep = hi ? k8[e + 4] : k8[e]; k4[e] = keep + __shfl_xor(send, 16); } }
            { const bool hi = (X.lane & 8) != 0;
#pragma unroll
              for (int e = 0; e < 2; ++e) { const float send = hi ? k4[e] : k4[e + 2], keep = hi ? k4[e + 2] : k4[e]; k2[e] = keep + __shfl_xor(send, 8); } }
            { const bool hi = (X.lane & 4) != 0; const float send = hi ? k2[0] : k2[1], keep = hi ? k2[1] : k2[0]; k1 = keep + __shfl_xor(send, 4); }
            k1 += __shfl_xor(k1, 2); k1 += __shfl_xor(k1, 1);
            float mx = k1;
            mx = fmaxf(mx, __shfl_xor(mx, 32)); mx = fmaxf(mx, __shfl_xor(mx, 16)); mx = fmaxf(mx, __shfl_xor(mx, 8)); mx = fmaxf(mx, __shfl_xor(mx, 4));
            const float ex = expf(k1 - mx); float den = ex;
            den += __shfl_xor(den, 32); den += __shfl_xor(den, 16); den += __shfl_xor(den, 8); den += __shfl_xor(den, 4);
            const int eidx = ((X.lane >> 5) & 1) * 8 + ((X.lane >> 4) & 1) * 4 + ((X.lane >> 3) & 1) * 2 + ((X.lane >> 2) & 1);
            if ((X.lane & 3) == 0) AFF[(size_t)(r0 + q) * 16 + eidx] = ex / den;
        }
    }
#undef LN1_FETCH
    __syncthreads();
}

__device__ __forceinline__ void ph_topk_convert(const Ctx& X, CArgs a, int l, bool need_ctx) {
    LAS unsigned* HIST = (LAS unsigned*)X.lds;
    LAS unsigned* SH = HIST + 256;
    const float* AFF = (const float*)(X.ws + WS_AFF); int* SLOT = (int*)(X.ws + WS_SLOT); int* SRC = (int*)(X.ws + WS_SRC);
    const int nitems = need_ctx ? 128 : 64;
    for (int it = blockIdx.x; it < nitems; it += X.G) {
        const bool isc = it >= 64; const int q = it & 63, b = q >> 4, e = q & 15;
        const int n = isc ? CTX : SEQ, cap = isc ? CAPC : CAP, rbase = isc ? T + b * CTX : b * SEQ;
        unsigned key[16];
#pragma unroll
        for (int i = 0; i < 16; ++i) { const int t = i * 512 + X.tid; key[i] = t < n ? __float_as_uint(AFF[(size_t)(rbase + t) * 16 + e]) : 0u; }
        unsigned prefix = 0u, need = (unsigned)cap;
        for (int pass = 0; pass < 4; ++pass) {
            const int shift = 24 - 8 * pass;
            if (X.tid < 256) HIST[X.tid] = 0u;
            __syncthreads();
            if (pass == 0) {
#pragma unroll
                for (int i = 0; i < 16; ++i) { bool act = (i * 512 + X.tid) < n; const unsigned bin = key[i] >> 24;
#pragma unroll
                    for (int rep = 0; rep < 4; ++rep) { const unsigned long long am = __ballot(act);
                        if (am != 0ull) { const int leader = __builtin_ctzll(am); const unsigned vv = (unsigned)__builtin_amdgcn_readlane((int)bin, leader); const unsigned long long mm = __ballot(act && bin == vv);
                            if (X.lane == leader) __hip_atomic_fetch_add(&HIST[vv], (unsigned)__popcll(mm), __ATOMIC_RELAXED, __HIP_MEMORY_SCOPE_WORKGROUP);
                            act = act && bin != vv; } }
                    if (act) __hip_atomic_fetch_add(&HIST[bin], 1u, __ATOMIC_RELAXED, __HIP_MEMORY_SCOPE_WORKGROUP); }
            } else {
#pragma unroll
            for (int i = 0; i < 16; ++i) { const bool ok = ((key[i] >> (shift + 8)) == (prefix >> (shift + 8)));
                if (ok && (i * 512 + X.tid) < n) __hip_atomic_fetch_add(&HIST[(key[i] >> shift) & 255u], 1u, __ATOMIC_RELAXED, __HIP_MEMORY_SCOPE_WORKGROUP); }
            }
            __syncthreads();
            if (X.wave == 0) {
                const unsigned c0 = HIST[4 * X.lane], c1 = HIST[4 * X.lane + 1], c2 = HIST[4 * X.lane + 2], c3 = HIST[4 * X.lane + 3];
                const unsigned s = c0 + c1 + c2 + c3; unsigned suf = s;
#pragma unroll
                for (int off = 1; off < 64; off <<= 1) { const unsigned o = __shfl_down(suf, off); if (X.lane + off < 64) suf += o; }
                const unsigned above = suf - s;
                if (above < need && need <= above + s) {
                    unsigned cum = above; int bin;
                    if (need <= cum + c3) bin = 3; else { cum += c3; if (need <= cum + c2) bin = 2; else { cum += c2; if (need <= cum + c1) bin = 1; else { cum += c1; bin = 0; } } }
                    SH[0] = prefix | ((unsigned)(4 * X.lane + bin) << shift); SH[1] = need - cum;
                }
            }
            __syncthreads();
            prefix = SH[0]; need = SH[1];
            __syncthreads();
        }
        const unsigned K = prefix;
        const int niter = isc ? 1 : 16;
        LAS unsigned* CNT = SH + 32;
#pragma unroll
        for (int i = 0; i < 16; ++i) { if (i < niter) { const int t = i * 512 + X.tid; const bool valid = t < n;
            const unsigned long long mg = __ballot(valid && key[i] > K), me = __ballot(valid && key[i] == K);
            if (X.lane == 0) CNT[i * 8 + X.wave] = (unsigned)__popcll(mg) | ((unsigned)__popcll(me) << 16); } }
        __syncthreads();
        if (X.wave == 0) { const int ne = niter * 8;
            const unsigned c0 = 2 * X.lane < ne ? CNT[2 * X.lane] : 0u, c1 = 2 * X.lane + 1 < ne ? CNT[2 * X.lane + 1] : 0u;
            const unsigned sm = c0 + c1; unsigned inc = sm;
#pragma unroll
            for (int off = 1; off < 64; off <<= 1) { const unsigned o = __shfl_up(inc, off); if (X.lane >= off) inc += o; }
            const unsigned exc = inc - sm;
            if (2 * X.lane < ne) CNT[2 * X.lane] = exc;
            if (2 * X.lane + 1 < ne) CNT[2 * X.lane + 1] = exc + c0; }
        __syncthreads();
#pragma unroll
        for (int i = 0; i < 16; ++i) { if (i < niter) { const int t = i * 512 + X.tid; const bool valid = t < n;
            const bool gt = valid && key[i] > K, eq = valid && key[i] == K;
            const unsigned long long mg = __ballot(gt), me = __ballot(eq);
            const unsigned long long lower = (1ull << X.lane) - 1ull;
            const unsigned bs = CNT[i * 8 + X.wave];
            const unsigned ngt = (bs & 0xffffu) + (unsigned)__popcll(mg & lower), neq = (bs >> 16) + (unsigned)__popcll(me & lower);
            const bool sel = gt || (eq && neq < need);
            const unsigned pos = ngt + (neq < need ? neq : need);
            if (valid) { SLOT[(size_t)(rbase + t) * 16 + e] = sel ? (int)pos : -1;
                if (sel) SRC[e * EROWS + (isc ? 4096 + b * CAPC : b * CAP) + (int)pos] = rbase + t; } } }
        __syncthreads();
    }
    if (need_ctx) { const int gt = blockIdx.x * 512 + X.tid; if (gt < NE * 128) SRC[(gt >> 7) * EROWS + 4224 + (gt & 127)] = -1; }
    LAS bf16* scr = (LAS bf16*)(X.lds + 32768 + X.wave * 8448);
    const int gw = X.vcu * NWAVES + X.wave, NGW = X.G * NWAVES;
    unsigned char* WGU = X.ws + WS_WGU; unsigned char* WD = X.ws + WS_WD;
    __syncthreads();
    for (int it = gw + CV_IN_ATT * NGW; it < CV_ITEMS; it += NGW) {
        const CvItem ci = cv_make(a, X.ws, l, it, X.lane); f32x4 v[16]; unsigned P[4][4]; cv_load(v, ci); cv_pack8(v, ci.scale, P); cv_store8(P, ci, X.lane); }
    unsigned zz = 0u; asm volatile("" : "+v"(zz)); const v4u zero4 = {zz, zz, zz, zz};
    for (int i = gw * 64 + X.lane; i < NE * 128 * 64; i += NGW * 64) {
        const int e = i >> 13, rr = (i >> 6) & 127, pc = i & 63; const int row = e * 5632 + 21 * 256 + (rr >> 6) * 128 + 64 + (rr & 63);
        *(v4u*)(WGU + (size_t)row * D + pc * 16) = zero4; }
    for (int i = gw * 64 + X.lane; i < NE * 1024 * 4; i += NGW * 64) {
        const int rowi = i >> 2, pc = i & 3; *(v4u*)(WD + (size_t)rowi * FFP + FF + pc * 16) = zero4; }
}

__device__ __forceinline__ void ph_gather(const Ctx& X, bool need_ctx) {
    const int gw = X.vcu * NWAVES + X.wave, NGW = X.G * NWAVES;
    const int* SRC = (const int*)(X.ws + WS_SRC); const unsigned char* H2 = X.ws + WS_SA; unsigned char* XG = X.ws + WS_XG;
    const int per_e = need_ctx ? EROWS : 4096;
    for (int i0 = gw * 8; i0 < NE * per_e; i0 += NGW * 8) {
        const int e = i0 / per_e, q0 = i0 - e * per_e, mr0 = e * EROWS + q0;
        int src[8]; v4u v0[8];
#pragma unroll
        for (int q = 0; q < 8; ++q) src[q] = SRC[mr0 + q];
#pragma unroll
        for (int q = 0; q < 8; ++q) { v0[q] = (v4u){0u, 0u, 0u, 0u}; if (src[q] >= 0) v0[q] = *(const v4u*)(H2 + (size_t)src[q] * D + 16 * X.lane); }
#pragma unroll
        for (int q = 0; q < 8; ++q) *(v4u*)(XG + (size_t)(mr0 + q) * D + 16 * X.lane) = v0[q];
    }
}

__device__ __forceinline__ void ph_ln2(const Ctx& X, CArgs a, int l, int nrows) {
    const int gw = X.vcu * NWAVES + X.wave, NGW = X.G * NWAVES;
    const float* X1 = (const float*)(X.ws + WS_X1); const float* AFF = (const float*)(X.ws + WS_AFF); const int* SLOT = (const int*)(X.ws + WS_SLOT);
    const bf16* EO = (const bf16*)(X.ws + WS_EO); float* X2 = (float*)(X.ws + WS_X2); bf16* XH = (bf16*)(X.ws + WS_SA);
    const float* lg = inp(a, I_LN2G) + l * D; const float* lb = inp(a, I_LN2B) + l * D;
    int slv_n = -1; float afv_n = 0.f; f32x4 xn[2][4];
#define LN2_FETCH(rr_) do { unsigned lp_ = 4u * (unsigned)X.lane; asm volatile("" : "+v"(lp_)); \
        slv_n = X.lane < 32 ? SLOT[(size_t)(rr_) * 16 + X.lane] : -1; afv_n = X.lane < 32 ? AFF[(size_t)(rr_) * 16 + X.lane] : 0.f; \
        _Pragma("unroll") for (int q = 0; q < 2; ++q) _Pragma("unroll") for (int j = 0; j < 4; ++j) xn[q][j] = *(const f32x4*)(X1 + (size_t)((rr_) + q) * D + (lp_ + 256u * j)); } while (0)
    if (gw * 2 < nrows) LN2_FETCH(gw * 2);
    for (int r0 = gw * 2; r0 < nrows; r0 += NGW * 2) {
        const float* md = mod_ptr(X.ws, l, r0);
        const bool isc = r0 >= T; const int b = isc ? (r0 - T) >> 8 : r0 >> 13;
        const int slv = slv_n; const float afv = afv_n;
        f32x4 v[2][4], mo[2][4];
#pragma unroll
        for (int q = 0; q < 2; ++q)
#pragma unroll
            for (int j = 0; j < 4; ++j) { v[q][j] = xn[q][j]; mo[q][j] = (f32x4){0.f, 0.f, 0.f, 0.f}; }
        const unsigned long long bal = __ballot(slv >= 0);
        unsigned msk[2] = {(unsigned)(bal & 0xffffull), (unsigned)((bal >> 16) & 0xffffull)};
        const size_t rb = (size_t)(isc ? 4096 + b * CAPC : b * CAP);
        while ((msk[0] | msk[1]) != 0u) {
            v2u wv[2][4][4]; float af[2][4];
#pragma unroll
            for (int q = 0; q < 2; ++q) { unsigned m = msk[q];
#pragma unroll
                for (int k = 0; k < 4; ++k) { const bool has = m != 0u; const int e = has ? __builtin_ctz(m) : 0; m = has ? (m & (m - 1u)) : 0u;
                    int sl = 0; float aq = 0.f;
                    if (has) { sl = __builtin_amdgcn_readlane(slv, q * 16 + e); aq = __builtin_bit_cast(float, __builtin_amdgcn_readlane(__builtin_bit_cast(int, afv), q * 16 + e)); }
                    af[q][k] = aq; const size_t er = (size_t)e * EROWS + rb + sl;
#pragma unroll
                    for (int j = 0; j < 4; ++j) wv[q][k][j] = *(const v2u*)(EO + er * D + 4 * X.lane + 256 * j); }
                msk[q] = m; }
#pragma unroll
            for (int q = 0; q < 2; ++q)
#pragma unroll
                for (int k = 0; k < 4; ++k)
#pragma unroll
                    for (int j = 0; j < 4; ++j) { const v2u w2 = wv[q][k][j]; const float aq = af[q][k];
                        mo[q][j][0] += aq * bf_lo(w2.x); mo[q][j][1] += aq * bf_hi(w2.x); mo[q][j][2] += aq * bf_lo(w2.y); mo[q][j][3] += aq * bf_hi(w2.y); }
        }
        __builtin_amdgcn_sched_barrier(0);
        if (r0 + NGW * 2 < nrows) LN2_FETCH(r0 + NGW * 2);
        __builtin_amdgcn_sched_barrier(0);
        float s[2] = {0.f, 0.f}, mean[2], rstd[2];
#pragma unroll
        for (int q = 0; q < 2; ++q)
#pragma unroll
            for (int j = 0; j < 4; ++j) { const int c = 4 * X.lane + 256 * j;
                v[q][j] = v[q][j] * DN_ALPHA + *(const f32x4*)(md + 5120 + c) * mo[q][j];
                s[q] += (v[q][j][0] + v[q][j][1]) + (v[q][j][2] + v[q][j][3]); }
#pragma unroll
        for (int q = 0; q < 2; ++q) mean[q] = wave_sum(s[q]) * (1.0f / D);
#pragma unroll
        for (int q = 0; q < 2; ++q) { float qq = 0.f;
#pragma unroll
            for (int j = 0; j < 4; ++j) { v[q][j] = v[q][j] - mean[q]; qq += (v[q][j][0] * v[q][j][0] + v[q][j][1] * v[q][j][1]) + (v[q][j][2] * v[q][j][2] + v[q][j][3] * v[q][j][3]); }
            s[q] = qq; }
#pragma unroll
        for (int q = 0; q < 2; ++q) rstd[q] = 1.0f / sqrtf(wave_sum(s[q]) * (1.0f / D) + LN_EPS);
        const float* md1 = (const float*)(X.ws + WS_MOD) + (size_t)(1 * 5 + (isc ? 4 : b)) * 6144;
#pragma unroll
        for (int j = 0; j < 4; ++j) { const int c = 4 * X.lane + 256 * j; const f32x4 g4 = *(const f32x4*)(lg + c), b4 = *(const f32x4*)(lb + c);
#pragma unroll
            for (int q = 0; q < 2; ++q) { const f32x4 y = v[q][j] * rstd[q] * g4 + b4;
                if (l == 0) { *(f32x4*)(X2 + (size_t)(r0 + q) * D + c) = y;
                    const f32x4 h = y * (*(const f32x4*)(md1 + 1024 + c) + 1.0f) + *(const f32x4*)(md1 + c);
                    v2u wv; wv.x = cvt_pk_bf16(h[0], h[1]); wv.y = cvt_pk_bf16(h[2], h[3]); *(v2u*)(XH + (size_t)(r0 + q) * D + c) = wv;
                    *(unsigned*)(X.ws + WS_XH8 + (size_t)(r0 + q) * D + c) = pg8::pk_fp8x4(h[0], h[1], h[2], h[3]); }
                else *(f32x4*)((float*)(GAS float*)a->out + (size_t)(r0 + q) * D + c) = y; } }
    }
#undef LN2_FETCH
}
__device__ __forceinline__ void ph_attention(const Ctx& X, CArgs a, int l, unsigned char* lds_generic, bool need_ctx) {
    using attn_body::attn_unit; using attn_body::attn_unit_v128; typedef attn_body::bf16 abf;
    const abf* QA = (const abf*)(X.ws + WS_QA); const abf* KA = (const abf*)(X.ws + WS_KA); const abf* VA = (const abf*)(X.ws + WS_VA);
    const abf* QC = (const abf*)(X.ws + WS_QC); const abf* KC = (const abf*)(X.ws + WS_KC); const abf* VC = (const abf*)(X.ws + WS_VC);
    abf* YA = (abf*)(X.ws + WS_BR); abf* DO = (abf*)(X.ws + WS_DO);
    const int nunits = 2048 + (need_ctx ? 64 : 0);
    int cvk = CV_IN_LRU; const int gwc = X.vcu * NWAVES + X.wave, ngwc = X.G * NWAVES;
    bool nomax; { float gq = fabsf(inp(a, I_AQN)[l * 64 + X.lane]), gk = fabsf(inp(a, I_AKN)[l * 64 + X.lane]);
#pragma unroll
        for (int o = 1; o < 64; o <<= 1) { gq = fmaxf(gq, __shfl_xor(gq, o)); gk = fmaxf(gk, __shfl_xor(gk, o)); }
        const float bound = 64.0f * C2 * gq * gk * 1.02f;
        nomax = __builtin_amdgcn_readfirstlane((int)(bound < 40.0f)) != 0; }
    bool nomaxd; { const unsigned* nw = (const unsigned*)(X.ws + WS_CTL) + CW_NRM + 2 * l;
        const float mq = __uint_as_float(__hip_atomic_load(nw, __ATOMIC_RELAXED, __HIP_MEMORY_SCOPE_AGENT)), mk = __uint_as_float(__hip_atomic_load(nw + 1, __ATOMIC_RELAXED, __HIP_MEMORY_SCOPE_AGENT));
        const float boundd = C2 * sqrtf(mq * mk) * 1.02f;
        nomaxd = __builtin_amdgcn_readfirstlane((int)(boundd < 60.0f && mq > 0.0f && mk > 0.0f)) != 0; }
#define ATT_CV() do { if (cvk < CV_IN_ATT) { const bool two_ = cvk + 1 < CV_IN_ATT; \
        CvItem c0_ = cv_make(a, X.ws, l, gwc + cvk * ngwc, X.lane); f32x4 v_[16]; unsigned pk_[4][4]; cv_load(v_, c0_); cv_pack8(v_, c0_.scale, pk_); \
        asm volatile("" ::: "memory"); __builtin_amdgcn_sched_barrier(0); \
        CvItem c1_ = c0_; if (two_) { c1_ = cv_make(a, X.ws, l, gwc + (cvk + 1) * ngwc, X.lane); cv_load(v_, c1_); } \
        __builtin_amdgcn_sched_barrier(0); cv_store8(pk_, c0_, X.lane); \
        if (two_) { cv_pack8(v_, c1_.scale, pk_); cv_store8(pk_, c1_, X.lane); } cvk += 2; } } while (0)
    for (int U = X.vcu; U < nunits; U += X.G) {
        const bool isd = (U >= 1024 && U < 2048) || U >= 2048 + 32;
        if (!isd) { int b, h, NT; size_t qrow;
            if (U < 1024) { const int qb = U & 31; h = (U >> 5) & 7; b = U >> 8; qrow = (size_t)b * SEQ + qb * 256; NT = KVL / 64; }
            else { const int V = U - 2048; h = V & 7; b = V >> 3; qrow = (size_t)T + b * CTX; NT = CTX / 64; }
            if (nomax) attn_unit<8, true>(QA + qrow * 512 + h * 64, 512, KA + (size_t)b * KVL * 128 + (h >> 2) * 64, 128, VA + (size_t)b * KVL * 128 + (h >> 2) * 64, 128, YA + qrow * 512 + h * 64, 512, NT, (char*)lds_generic + RING_OFF, X.tid);
            else attn_unit<8, false>(QA + qrow * 512 + h * 64, 512, KA + (size_t)b * KVL * 128 + (h >> 2) * 64, 128, VA + (size_t)b * KVL * 128 + (h >> 2) * 64, 128, YA + qrow * 512 + h * 64, 512, NT, (char*)lds_generic + RING_OFF, X.tid);
        } else { int b, hj, NT; size_t qrow;
            if (U < 2048) { const int V = U - 1024, qb = V & 31; hj = (V >> 5) & 7; b = V >> 8; qrow = (size_t)b * SEQ + qb * 256; NT = KVL / 64; }
            else { const int V = U - 2080; hj = V & 7; b = V >> 3; qrow = (size_t)T + b * CTX; NT = CTX / 64; }
            const int hc = hj >> 1, j = hj & 1;
            if (nomaxd) attn_unit_v128<8, true>(QC + qrow * 512 + hj * 64, 512, KC + (size_t)b * KVL * 512 + hj * 64, 512, VC + (size_t)b * KVL * 512 + hc * 128, 512, DO + (size_t)j * R * 512 + qrow * 512 + hc * 128, 512, NT, (char*)lds_generic + RING_OFF, X.tid);
            else attn_unit_v128<8, false>(QC + qrow * 512 + hj * 64, 512, KC + (size_t)b * KVL * 512 + hj * 64, 512, VC + (size_t)b * KVL * 512 + hc * 128, 512, DO + (size_t)j * R * 512 + qrow * 512 + hc * 128, 512, NT, (char*)lds_generic + RING_OFF, X.tid);
        }
        ATT_CV();
    }
    while (cvk < CV_IN_ATT) ATT_CV();
#undef ATT_CV
}

__device__ __forceinline__ bool grid_bar_fn(const XcdBarrier& bar, int tid) { XcdBarrier b2_ = bar; asm volatile("" : "+s"(b2_.x)); xcd_barrier(b2_, tid); return true; }
constexpr int PH_PER_LAYER = 12, N_PHASES = 2 + DEPTH * PH_PER_LAYER;
__global__ void __launch_bounds__(NWAVES * 64, 2) fwd_kernel(Args args) {
    extern __shared__ __attribute__((aligned(16))) unsigned char lds[];
    Ctx X;
    const int wave0 = __builtin_amdgcn_readfirstlane((int)threadIdx.x >> 6);
#define MK_TID() ({ int l_; asm volatile("v_mbcnt_lo_u32_b32 %0, -1, 0\n\tv_mbcnt_hi_u32_b32 %0, -1, %0" : "=v"(l_)); (wave0 << 6) | l_; })
    X.lds = (LAS unsigned char*)lds; X.tid = MK_TID(); X.lane = X.tid & 63; X.wave = wave0;
    X.G = gridDim.x; { const int bx = blockIdx.x; X.vcu = (X.G % 8 == 0) ? (bx % 8) * (X.G / 8) + bx / 8 : bx; }
    X.ws = args.ws;
    gu32* ctl = (gu32*)(args.ws + WS_CTL);
    volatile LAS unsigned* MISC = (volatile LAS unsigned*)(X.lds + MISC_OFF);
    for (int u = X.tid; u < (LDS_BYTES - LDSCTL_OFF) / 4; u += NWAVES * 64) ((LAS unsigned*)(X.lds + LDSCTL_OFF))[u] = 0u;
    __syncthreads();
#if MK_PER_PHASE
#define GRID_BAR() do { } while (0)
#else
    XcdBarrier bar = xcd_barrier_post((unsigned*)(ctl + CW_BAR), MISC + 8, X.tid);
#define GRID_BAR() ((void)grid_bar_fn(bar, MK_TID()))
#endif
#if MK_PER_PHASE
    const int lo = args.ph_lo, hi = args.ph_hi;
#endif
    CArgs A = (CArgs)__builtin_amdgcn_kernarg_segment_ptr(); int bx_ = (int)blockIdx.x;
#define OPQ() do { int t_ = MK_TID(); asm volatile("" : "+v"(t_)); X.tid = t_; X.lane = t_ & 63; X.wave = wave0; unsigned long long w_ = (unsigned long long)args.ws; asm volatile("" : "+s"(w_)); X.ws = (unsigned char*)(GAS unsigned char*)w_; A = (CArgs)__builtin_amdgcn_kernarg_segment_ptr(); asm volatile("" : "+s"(A)); bx_ = (int)blockIdx.x; asm volatile("" : "+s"(bx_)); } while (0)
#if MK_PER_PHASE
#define IN(k) (lo <= (k) && (k) < hi)
#else
#define IN(k) true
#endif
#ifdef MK_REP_MASK
#define REP(k) for (int rep_ = 0; rep_ <= ((MK_REP_MASK >> (k)) & 1); ++rep_) if (rep_ ? grid_bar_fn(bar, MK_TID()) : true)
#else
#define REP(k)
#endif
#define SEAM(k) do { if (IN(k) && IN((k) + 1)) GRID_BAR(); } while (0)
#define SA ((pg8::bf16_t*)(X.ws + WS_SA))

    REP(12) { if (IN(0)) { OPQ(); ph_prologue(X, A); } } SEAM(0);
    REP(13) { if (IN(1)) { OPQ(); ph_make_xh0(X, A); } } SEAM(1);

    for (int l = 0; l < DEPTH; ++l) {
        const int P = 2 + l * PH_PER_LAYER; const bool need_ctx = l < DEPTH - 1; const int nrows = need_ctx ? R : T;
        REP(0) { if (IN(P + 0)) { OPQ();
            { pg8::Gemm g{SA, (const pg8::bf16_t*)(X.ws + WS_WIN) + (size_t)l * DIN * D, R, 3328, D, nullptr};
              pg8::PlainOrder S{R / 256, 13, X.G, bx_};
              pg8::EpiInProj E{X.ws, inp(A, I_AQN) + l * 64, inp(A, I_AKN) + l * 64, (unsigned*)(X.ws + WS_CTL) + CW_NRM + 2 * l};
              pg8::gemm_phase<pg8::EpiInProj, pg8::PlainOrder, true, true>(X.lds + RING_OFF, g, S, E, X.tid); }
            OPQ();
            { pg8::Gemm g{(const pg8::bf16_t*)(X.ws + WS_XH8), (const pg8::bf16_t*)(X.ws + WS_WIN) + (size_t)l * DIN * D + (size_t)3328 * D, R, 3072, D / 2, nullptr};
              pg8::PlainOrder S{R / 256, 12, X.G, X.G - 1 - bx_};
              pg8::EpiGate8 E{X.ws + WS_GM, 1.0f / WSC_GU};
              pg8::gemm_phase<pg8::EpiGate8, pg8::PlainOrder, true, true, true>(X.lds + RING_OFF, g, S, E, X.tid); }
        } }
        SEAM(P + 0);
        REP(1) { if (IN(P + 1)) { OPQ(); ph_lru<1>(X, A, l, need_ctx); } }
#if MK_PER_PHASE
        SEAM(P + 1);
#endif
        REP(2) { if (IN(P + 2)) { OPQ(); ph_attention(X, A, l, lds, need_ctx); } } SEAM(P + 2);
        REP(3) { if (IN(P + 3)) { OPQ(); ph_lru<2>(X, A, l, need_ctx); ph_diff_combine(X, A, l, nrows); } } SEAM(P + 3);
        REP(4) { if (IN(P + 4)) { OPQ();
            pg8::Gemm g{(const pg8::bf16_t*)(X.ws + WS_BR), (const pg8::bf16_t*)(X.ws + WS_WBR) + (size_t)l * 3 * 1024 * 512, 3 * R, 3 * 1024, 512, nullptr};
            pg8::MergeOrder S{nrows / 256, X.G, bx_};
            pg8::EpiMerge E{(const unsigned char*)(X.ws + WS_GM), SA};
            pg8::gemm_phase<pg8::EpiMerge, pg8::MergeOrder, true, true>(X.lds + RING_OFF, g, S, E, X.tid);
        } }
        SEAM(P + 4);
        REP(5) { if (IN(P + 5)) { OPQ();
            pg8::Gemm g{SA, (const pg8::bf16_t*)(X.ws + WS_WOUT) + (size_t)l * D * D, R, D, D, nullptr};
            pg8::PlainOrder S{nrows / 256, 4, X.G, bx_};
            pg8::EpiBf16Out E{(pg8::bf16_t*)(X.ws + WS_GM), D, 1.0f};
            pg8::gemm_phase<pg8::EpiBf16Out, pg8::PlainOrder, true, true>(X.lds + RING_OFF, g, S, E, X.tid);
        } }
        SEAM(P + 5);
        REP(6) { if (IN(P + 6)) { OPQ(); ph_ln1_router(X, A, l, nrows); } } SEAM(P + 6);
        REP(7) { if (IN(P + 7)) { OPQ(); ph_topk_convert(X, A, l, need_ctx); } } do { if (IN(P + 7) && IN(P + 9)) GRID_BAR(); } while (0);
        REP(9) { if (IN(P + 9)) { OPQ();
            pg8::Gemm g{(const pg8::bf16_t*)(X.ws + WS_SA), (const pg8::bf16_t*)(X.ws + WS_WGU), MROWS, NE * 5632, D / 2, (const int*)(X.ws + WS_SRC)};
            pg8::MoeOrder S{need_ctx ? 17 : 16, 22, X.G, bx_};
            pg8::EpiGateUp8 E{X.ws + WS_ACT, 1.0f / WSC_GU};
            pg8::gemm_phase<pg8::EpiGateUp8, pg8::MoeOrder, true, true, true, true>(X.lds + RING_OFF, g, S, E, X.tid);
        } }
        SEAM(P + 9);
        REP(10) { if (IN(P + 10)) { OPQ();
            pg8::Gemm g{(const pg8::bf16_t*)(X.ws + WS_ACT), (const pg8::bf16_t*)(X.ws + WS_WD), MROWS, NE * 1024, FFP / 2, nullptr};
            pg8::MoeOrder S{need_ctx ? 17 : 16, 4, X.G, bx_};
            pg8::EpiBf16Out E{(pg8::bf16_t*)(X.ws + WS_EO), D, 1.0f / WSC_D};
            pg8::gemm_phase<pg8::EpiBf16Out, pg8::MoeOrder, true, true, true>(X.lds + RING_OFF, g, S, E, X.tid);
        } }
        SEAM(P + 10);
        REP(11) { if (IN(P + 11)) { OPQ(); ph_ln2(X, A, l, nrows); } }
        if (l + 1 < DEPTH) SEAM(P + 11);
    }
#undef IN
#undef MK_TID
#undef REP
#undef SA
#undef OPQ
#undef SEAM
#undef GRID_BAR
}

extern "C" void kernel_launch(void* const* d_in, const int* in_sizes, int n_in, void* d_out, int out_size, void* d_ws, size_t ws_size, hipStream_t stream) {
    static int grid = 0;
    if (grid == 0) {
        if (n_in != 28 || out_size != T * D || ws_size < WS_END) { fprintf(stderr, "kernel_launch: unexpected shapes: n_in %d out %d ws %zu (need %zu)\n", n_in, out_size, ws_size, (size_t)WS_END); grid = -1; return; }
        int dev = 0, cus = 0, per_cu = 0;
        if (hipGetDevice(&dev) != hipSuccess || hipDeviceGetAttribute(&cus, hipDeviceAttributeMultiprocessorCount, dev) != hipSuccess) { grid = -1; return; }
        if (hipFuncSetAttribute((const void*)fwd_kernel, hipFuncAttributeMaxDynamicSharedMemorySize, LDS_BYTES) != hipSuccess) { fprintf(stderr, "kernel_launch: hipFuncSetAttribute failed\n"); grid = -1; return; }
        if (hipOccupancyMaxActiveBlocksPerMultiprocessor(&per_cu, (const void*)fwd_kernel, NWAVES * 64, LDS_BYTES) != hipSuccess || per_cu < 1)
            fprintf(stderr, "kernel_launch: occupancy query reports %d workgroups per CU\n", per_cu);
        (void)hipGetLastError();
        grid = cus;
    }
    if (grid < 0) return;
    if (hipMemsetAsync((char*)d_ws + WS_CTL, 0, CTL_BYTES, stream) != hipSuccess) return;
    Args a{};
    for (int i = 0; i < 28; ++i) a.in[i] = (const float*)d_in[i];
    a.out = (float*)d_out; a.ws = (unsigned char*)d_ws;
#if MK_PER_PHASE
    for (int p = 0; p < N_PHASES; ++p) { a.ph_lo = p; a.ph_hi = p + 1; hipLaunchKernelGGL(fwd_kernel, dim3(grid), dim3(NWAVES * 64), LDS_BYTES, stream, a); }
#else
    a.ph_lo = 0; a.ph_hi = N_PHASES;
    hipLaunchKernelGGL(fwd_kernel, dim3(grid), dim3(NWAVES * 64), LDS_BYTES, stream, a);
#endif
    const hipError_t le = hipPeekAtLastError();
    if (le != hipSuccess) fprintf(stderr, "kernel_launch: launch failed: %s\n", hipGetErrorName(le));
}
```
